# Optimizing an MI355X kernel written in HIP

```python
import jax, jax.numpy as jnp
from jax import lax
import numpy as np

D_MODEL = 1024
BATCH = 8
SEQ = 4096
DEPTH = 1

D_RNN = 1024
RNN_HEADS = 16
RNN_HEAD_DIM = D_RNN // RNN_HEADS
CONV_WIDTH = 4
LRU_C = 8.0
HEAD_DIM = 64
HEADS_PER_GROUP = 8
DILATED_GROUPS = ((128, 1), (512, 4), (2048, 16))
N_ATT_HEADS = HEADS_PER_GROUP * len(DILATED_GROUPS)
D_ATT = N_ATT_HEADS * HEAD_DIM
D_ATT_OUT = HEADS_PER_GROUP * HEAD_DIM
NUM_BUCKETS = 32
MAX_DISTANCE = 2048
N_EXPERTS = 256
TOP_K = 8
N_EXPERT_GROUPS = 8
TOPK_GROUPS = 4
EXPERTS_PER_GROUP = N_EXPERTS // N_EXPERT_GROUPS
D_EXPERT = 256
D_SHARED = 256
ROUTED_SCALE = 2.5
EXPERT_BLOCK = 128
DEEPNORM_ALPHA = (2 * DEPTH) ** 0.25
DEEPNORM_BETA = (8 * DEPTH) ** -0.25
LN_EPS = 1e-5
IN_SPLITS = (D_RNN, D_RNN, D_ATT, D_ATT, D_ATT, D_MODEL, D_MODEL)
D_IN = sum(IN_SPLITS)

kernel_name = 'hybrid_rglru_dilated_attn_moe_deepnorm'


def _layer_norm(x, g, b):
    xf = x.astype(jnp.float32)
    mu = xf.mean(-1, keepdims=True)
    var = jnp.square(xf - mu).mean(-1, keepdims=True)
    return ((xf - mu) * lax.rsqrt(var + LN_EPS) * g.astype(jnp.float32) + b.astype(jnp.float32)).astype(x.dtype)


def _causal_depthwise_conv(x, w, b):
    y = lax.conv_general_dilated(
        x, w[:, None, :].astype(x.dtype), window_strides=(1,),
        padding=((CONV_WIDTH - 1, 0),), dimension_numbers=('NWC', 'WIO', 'NWC'),
        feature_group_count=x.shape[-1])
    return y + b.astype(x.dtype)


def _rg_lru(xc, w_a, b_a, w_i, b_i, lam):
    B, S, _ = xc.shape
    xh = xc.astype(jnp.float32).reshape(B, S, RNN_HEADS, RNN_HEAD_DIM)
    r = jax.nn.sigmoid(jnp.einsum('bshi,hij->bshj', xh, w_a.astype(jnp.float32)) + b_a.astype(jnp.float32))
    i = jax.nn.sigmoid(jnp.einsum('bshi,hij->bshj', xh, w_i.astype(jnp.float32)) + b_i.astype(jnp.float32))
    log_a = -LRU_C * r * jax.nn.softplus(-lam.astype(jnp.float32)).reshape(RNN_HEADS, RNN_HEAD_DIM)
    a = jnp.exp(log_a)
    u = jnp.sqrt(-jnp.expm1(2.0 * log_a)) * (i * xh)

    def combine(c1, c2):
        a1, b1 = c1
        a2, b2 = c2
        return a1 * a2, a2 * b1 + b2

    _, h = lax.associative_scan(combine, (a, u), axis=1)
    return h.reshape(B, S, D_RNN)


def _t5_bucket(dist):
    max_exact = NUM_BUCKETS // 2
    d = np.maximum(dist, 1).astype(np.float64)
    large = max_exact + (np.log(d / max_exact) / np.log(MAX_DISTANCE / max_exact)
                         * (NUM_BUCKETS - max_exact)).astype(np.int64)
    large = np.minimum(large, NUM_BUCKETS - 1)
    return np.where(dist < max_exact, dist, large).astype(np.int32)


def _dilated_group(q, k, v, table, window, dilation):
    B, S, H, hd = q.shape
    n_steps = window // dilation
    blk = n_steps
    L = S // dilation
    nb = -(-L // blk)
    Lp = nb * blk

    def to_blocks(t):
        t = t.reshape(B, L, dilation, H, hd).transpose(0, 2, 1, 3, 4)
        t = jnp.pad(t, ((0, 0), (0, 0), (0, Lp - L), (0, 0), (0, 0)))
        return t.reshape(B, dilation, nb, blk, H, hd).astype(jnp.float32)

    def with_prev(t):
        prev = jnp.pad(t[:, :, :-1], ((0, 0), (0, 0), (1, 0), (0, 0), (0, 0), (0, 0)))
        return jnp.concatenate([prev, t], axis=3)

    qb = to_blocks(q) * (hd ** -0.5)
    kb = with_prev(to_blocks(k))
    vb = with_prev(to_blocks(v))

    qi = np.arange(blk)[:, None]
    ki = np.arange(2 * blk)[None, :]
    rel = qi + blk - ki
    in_window = (rel >= 0) & (rel <= n_steps)
    key_exists = (np.arange(nb)[:, None, None] * blk + ki[None] - blk) >= 0
    mask = in_window[None] & key_exists
    bucket = _t5_bucket(np.clip(rel, 0, None) * dilation)
    bias = jnp.transpose(table.astype(jnp.float32)[bucket], (2, 0, 1))

    s = jnp.einsum('brnqhd,brnkhd->brnhqk', qb, kb) + bias
    s = jnp.where(mask[None, None, :, None], s, -jnp.inf)
    m = s.max(-1)
    p = jnp.exp(s - m[..., None])
    l = p.sum(-1)
    o = jnp.einsum('brnhqk,brnkhd->brnqhd', p, vb)

    def from_blocks(t):
        rest = t.shape[4:]
        t = t.reshape((B, dilation, Lp) + rest)[:, :, :L]
        return jnp.swapaxes(t, 1, 2).reshape((B, S) + rest)

    m = from_blocks(jnp.swapaxes(m, 3, 4))
    l = from_blocks(jnp.swapaxes(l, 3, 4))
    return from_blocks(o), m, l


def _mixer(x, w_in, b_in, conv_w, conv_b, w_rg_a, b_rg_a, w_rg_i, b_rg_i, lru_lambda,
           w_proj_rnn, w_proj_att, rel_bias, w_out):
    B, S, _ = x.shape
    proj = jnp.einsum('bsd,de->bse', x, w_in) + b_in
    split_at = [int(c) for c in np.cumsum(IN_SPLITS)[:-1]]
    xr, gr, q, k, v, g_rnn, g_att = jnp.split(proj, split_at, axis=-1)

    xc = _causal_depthwise_conv(xr, conv_w, conv_b)
    h = _rg_lru(xc, w_rg_a, b_rg_a, w_rg_i, b_rg_i, lru_lambda)
    y_rnn = (h * jax.nn.gelu(gr.astype(jnp.float32))).astype(x.dtype)

    q = q.reshape(B, S, N_ATT_HEADS, HEAD_DIM)
    k = k.reshape(B, S, N_ATT_HEADS, HEAD_DIM)
    v = v.reshape(B, S, N_ATT_HEADS, HEAD_DIM)
    outs, maxes, dens = [], [], []
    for g, (window, dilation) in enumerate(DILATED_GROUPS):
        hs = slice(g * HEADS_PER_GROUP, (g + 1) * HEADS_PER_GROUP)
        o_g, m_g, l_g = _dilated_group(q[:, :, hs], k[:, :, hs], v[:, :, hs], rel_bias[:, hs], window, dilation)
        outs.append(o_g)
        maxes.append(m_g)
        dens.append(l_g)
    o = jnp.stack(outs)
    m = jnp.stack(maxes)
    l = jnp.stack(dens)
    w_g = jnp.exp(m - m.max(0))
    y_att = (w_g[..., None] * o).sum(0) / (w_g * l).sum(0)[..., None]
    y_att = y_att.reshape(B, S, D_ATT_OUT).astype(x.dtype)

    merged = (jax.nn.sigmoid(g_rnn) * jnp.einsum('bsr,rd->bsd', y_rnn, w_proj_rnn)
              + jax.nn.sigmoid(g_att) * jnp.einsum('bsa,ad->bsd', y_att, w_proj_att))
    return jnp.einsum('bsd,de->bse', merged, w_out)


def _moe(x2d, w_router, router_bias, w_exp_gate, w_exp_up, w_exp_down, w_sh_gate, w_sh_up, w_sh_down):
    T, D = x2d.shape
    scores = jax.nn.sigmoid(jnp.einsum('td,de->te', x2d.astype(jnp.float32), w_router.astype(jnp.float32)))
    sel = scores + router_bias.astype(jnp.float32)
    g_score = lax.top_k(sel.reshape(T, N_EXPERT_GROUPS, EXPERTS_PER_GROUP), 2)[0].sum(-1)
    _, g_idx = lax.top_k(g_score, TOPK_GROUPS)
    g_keep = (g_idx[:, :, None] == jnp.arange(N_EXPERT_GROUPS)).any(axis=1)
    sel = jnp.where(jnp.repeat(g_keep, EXPERTS_PER_GROUP, axis=1), sel, -jnp.inf)
    _, e_idx = lax.top_k(sel, TOP_K)
    gate = jnp.take_along_axis(scores, e_idx, axis=1)
    gate = gate / gate.sum(-1, keepdims=True) * ROUTED_SCALE

    A = T * TOP_K
    flat_e = e_idx.reshape(A)
    flat_tok = jnp.repeat(jnp.arange(T, dtype=jnp.int32), TOP_K)
    flat_w = gate.reshape(A)
    order = jnp.argsort(flat_e)
    se, stok, sw = flat_e[order], flat_tok[order], flat_w[order]
    counts = jnp.bincount(flat_e, length=N_EXPERTS)
    padded = (counts + EXPERT_BLOCK - 1) // EXPERT_BLOCK * EXPERT_BLOCK
    pad_end = jnp.cumsum(padded)
    start_sorted = jnp.cumsum(counts) - counts
    dest = (pad_end - padded)[se] + jnp.arange(A) - start_sorted[se]
    NB = -(-A // EXPERT_BLOCK) + N_EXPERTS
    tok_buf = jnp.zeros((NB * EXPERT_BLOCK,), jnp.int32).at[dest].set(stok)
    w_buf = jnp.zeros((NB * EXPERT_BLOCK,), jnp.float32).at[dest].set(sw)
    block_expert = jnp.minimum(
        jnp.searchsorted(pad_end // EXPERT_BLOCK, jnp.arange(NB), side='right'), N_EXPERTS - 1)

    def expert_block(args):
        tok, wt, e = args
        xb = x2d[tok]
        hdn = jax.nn.silu(xb @ w_exp_gate[e]) * (xb @ w_exp_up[e])
        return (hdn @ w_exp_down[e]) * wt[:, None].astype(xb.dtype)

    ys = lax.map(expert_block, (tok_buf.reshape(NB, EXPERT_BLOCK), w_buf.reshape(NB, EXPERT_BLOCK), block_expert))
    routed = jax.ops.segment_sum(ys.reshape(-1, D), tok_buf, num_segments=T)
    shared = (jax.nn.silu(x2d @ w_sh_gate) * (x2d @ w_sh_up)) @ w_sh_down
    return routed + shared


def setup_inputs(seed: int = 0) -> dict:
    key = jax.random.key(seed)
    ks = jax.random.split(key, 28)
    f32 = jnp.float32

    def nrm(k, shape, scale):
        return jax.random.normal(k, shape, f32) * scale

    x = nrm(ks[0], (BATCH, SEQ, D_MODEL), 1.0)
    w_in = nrm(ks[1], (DEPTH, D_MODEL, D_IN), D_MODEL ** -0.5)
    b_in = nrm(ks[2], (DEPTH, D_IN), 0.02)
    conv_w = nrm(ks[3], (DEPTH, CONV_WIDTH, D_RNN), CONV_WIDTH ** -0.5)
    conv_b = nrm(ks[4], (DEPTH, D_RNN), 0.02)
    w_rg_a = nrm(ks[5], (DEPTH, RNN_HEADS, RNN_HEAD_DIM, RNN_HEAD_DIM), RNN_HEAD_DIM ** -0.5)
    b_rg_a = nrm(ks[6], (DEPTH, RNN_HEADS, RNN_HEAD_DIM), 0.02)
    w_rg_i = nrm(ks[7], (DEPTH, RNN_HEADS, RNN_HEAD_DIM, RNN_HEAD_DIM), RNN_HEAD_DIM ** -0.5)
    b_rg_i = nrm(ks[8], (DEPTH, RNN_HEADS, RNN_HEAD_DIM), 0.02)
    a_c = jax.random.uniform(ks[9], (DEPTH, D_RNN), f32, 0.9, 0.999)
    base = a_c ** (1.0 / LRU_C)
    lru_lambda = jnp.log(base) - jnp.log1p(-base)
    w_proj_rnn = nrm(ks[10], (DEPTH, D_RNN, D_MODEL), D_RNN ** -0.5)
    w_proj_att = nrm(ks[11], (DEPTH, D_ATT_OUT, D_MODEL), D_ATT_OUT ** -0.5)
    rel_bias = nrm(ks[12], (NUM_BUCKETS, N_ATT_HEADS), 0.1)
    w_out = nrm(ks[13], (DEPTH, D_MODEL, D_MODEL), D_MODEL ** -0.5 * DEEPNORM_BETA)
    ln1_g = 1.0 + nrm(ks[14], (DEPTH, D_MODEL), 0.01)
    ln1_b = nrm(ks[15], (DEPTH, D_MODEL), 0.01)
    w_router = nrm(ks[16], (DEPTH, D_MODEL, N_EXPERTS), D_MODEL ** -0.5)
    router_bias = nrm(ks[17], (DEPTH, N_EXPERTS), 0.01)
    w_exp_gate = nrm(ks[18], (DEPTH, N_EXPERTS, D_MODEL, D_EXPERT), D_MODEL ** -0.5)
    w_exp_up = nrm(ks[19], (DEPTH, N_EXPERTS, D_MODEL, D_EXPERT), D_MODEL ** -0.5)
    w_exp_down = nrm(ks[20], (DEPTH, N_EXPERTS, D_EXPERT, D_MODEL), D_EXPERT ** -0.5 * DEEPNORM_BETA)
    w_sh_gate = nrm(ks[21], (DEPTH, D_MODEL, D_SHARED), D_MODEL ** -0.5)
    w_sh_up = nrm(ks[22], (DEPTH, D_MODEL, D_SHARED), D_MODEL ** -0.5)
    w_sh_down = nrm(ks[23], (DEPTH, D_SHARED, D_MODEL), D_SHARED ** -0.5 * DEEPNORM_BETA)
    ln2_g = 1.0 + nrm(ks[24], (DEPTH, D_MODEL), 0.01)
    ln2_b = nrm(ks[25], (DEPTH, D_MODEL), 0.01)
    return {'x': x, 'w_in': w_in, 'b_in': b_in, 'conv_w': conv_w, 'conv_b': conv_b,
            'w_rg_a': w_rg_a, 'b_rg_a': b_rg_a, 'w_rg_i': w_rg_i, 'b_rg_i': b_rg_i,
            'lru_lambda': lru_lambda, 'w_proj_rnn': w_proj_rnn, 'w_proj_att': w_proj_att,
            'rel_bias': rel_bias, 'w_out': w_out, 'ln1_g': ln1_g, 'ln1_b': ln1_b,
            'w_router': w_router, 'router_bias': router_bias, 'w_exp_gate': w_exp_gate,
            'w_exp_up': w_exp_up, 'w_exp_down': w_exp_down, 'w_sh_gate': w_sh_gate,
            'w_sh_up': w_sh_up, 'w_sh_down': w_sh_down, 'ln2_g': ln2_g, 'ln2_b': ln2_b}


def reference(x, w_in, b_in, conv_w, conv_b, w_rg_a, b_rg_a, w_rg_i, b_rg_i, lru_lambda,
              w_proj_rnn, w_proj_att, rel_bias, w_out, ln1_g, ln1_b, w_router, router_bias,
              w_exp_gate, w_exp_up, w_exp_down, w_sh_gate, w_sh_up, w_sh_down, ln2_g, ln2_b):
    B, S, D = x.shape
    for i in range(DEPTH):
        mix = _mixer(x, w_in[i], b_in[i], conv_w[i], conv_b[i], w_rg_a[i], b_rg_a[i], w_rg_i[i],
                     b_rg_i[i], lru_lambda[i], w_proj_rnn[i], w_proj_att[i], rel_bias, w_out[i])
        x = _layer_norm(DEEPNORM_ALPHA * x + mix, ln1_g[i], ln1_b[i])
        ffn = _moe(x.reshape(B * S, D), w_router[i], router_bias[i], w_exp_gate[i], w_exp_up[i],
                   w_exp_down[i], w_sh_gate[i], w_sh_up[i], w_sh_down[i])
        x = _layer_norm(DEEPNORM_ALPHA * x + ffn.reshape(B, S, D), ln2_g[i], ln2_b[i])
    return x
```

```cpp
#include <hip/hip_runtime.h>
#include <cstdio>
#include <cstdint>
#include <cmath>

#ifndef N_LAUNCHES
#define N_LAUNCHES 13
#endif

#define GAS __attribute__((address_space(1)))
#define LAS __attribute__((address_space(3)))
typedef unsigned short bf16;
typedef float f32x2 __attribute__((ext_vector_type(2)));
typedef float f32x4 __attribute__((ext_vector_type(4)));
typedef float f32x16 __attribute__((ext_vector_type(16)));
typedef short bf16x8 __attribute__((ext_vector_type(8)));
typedef short bf16x4 __attribute__((ext_vector_type(4)));
typedef unsigned u32x4 __attribute__((ext_vector_type(4)));
typedef unsigned u32x2 __attribute__((ext_vector_type(2)));

constexpr int NB = 8, SEQ = 4096, T = NB * SEQ, D = 1024, DIN = 8704;
constexpr int C_XR = 0, C_GR = 1024, C_Q = 2048, C_K = 3584, C_V = 5120, C_GRNN = 6656, C_GATT = 7680;
constexpr int NE = 256, TOPK = 8, DE = 256;
constexpr int TCH = 128, NCH = SEQ / TCH;
constexpr int MAXT_R = 1280, SH_TILES = T / 256, MAXT = MAXT_R + SH_TILES;
constexpr float ALPHA = 1.18920711500272f, LN_EPS = 1e-5f;
constexpr int NPHASE = 13;

constexpr size_t MiB = 1u << 20;
constexpr size_t WS_CTL = 0, CTL_BYTES = 1 * MiB;
constexpr size_t WS_WINT = 1 * MiB;
constexpr size_t WS_WPRT = 18 * MiB;
constexpr size_t WS_WPAT = 20 * MiB;
constexpr size_t WS_WOT = 21 * MiB;
constexpr size_t WS_WRT = 23 * MiB;
constexpr size_t WS_EIDX = 24 * MiB, WS_GATEW = 25 * MiB, WS_RANK = 26 * MiB, WS_SLOTOF = 27 * MiB, WS_TOKSLOT = 28 * MiB, WS_WSLOT = 30 * MiB;
constexpr size_t WS_XB = 32 * MiB;
constexpr size_t WS_YRNN = 32 * MiB;
constexpr size_t WS_HLOC = 96 * MiB;
constexpr size_t WS_MERGED = 96 * MiB;
constexpr size_t WS_CUMA = 160 * MiB;
constexpr size_t WS_AO = 224 * MiB;
constexpr size_t WS_YATT = 320 * MiB;
constexpr size_t WS_SUMA = 352 * MiB, WS_SUMH = 353 * MiB;
constexpr size_t WS_LSE = 354 * MiB;
constexpr size_t WS_PROJ = 360 * MiB;
constexpr size_t WS_PRELN = 700 * MiB;
constexpr size_t WS_WD = 32 * MiB;
constexpr size_t WS_H = 161 * MiB;
constexpr size_t WS_Y = 337 * MiB;
constexpr size_t WS_X1B = 337 * MiB;
constexpr size_t WS_WGU = 401 * MiB;
constexpr size_t WS_LOGITS = 658 * MiB;
constexpr size_t WS_END = 977 * MiB;
constexpr int CW_BAR = 4096, CW_CNT = 16384;

constexpr int RING_BYTES = 131072;
constexpr int L_TBASE = RING_BYTES;
constexpr int L_TILEE = L_TBASE + 1040;
constexpr int L_BTAB = L_TILEE + 2816;
constexpr int L_MISC = L_BTAB + 12672;
constexpr int LDS_BYTES = 151552;
static_assert(L_MISC + 64 <= LDS_BYTES, "LDS map");

__device__ __forceinline__ unsigned f2bf(float f) { unsigned u = __builtin_bit_cast(unsigned, f); return (u + 0x7fffu + ((u >> 16) & 1u)) >> 16; }
__device__ __forceinline__ unsigned pk2(float lo, float hi) { return f2bf(lo) | (f2bf(hi) << 16); }
__device__ __forceinline__ float bflo(unsigned w) { return __builtin_bit_cast(float, w << 16); }
__device__ __forceinline__ float bfhi(unsigned w) { return __builtin_bit_cast(float, w & 0xffff0000u); }
__device__ __forceinline__ float bf1(bf16 h) { return __builtin_bit_cast(float, (unsigned)h << 16); }
__device__ __forceinline__ float sigmoidf_(float x) { return 1.0f / (1.0f + __expf(-x)); }
__device__ __forceinline__ float gelu_tanh(float x) { const float z = 1.5957691216057308f * (x + 0.044715f * x * x * x); return x / (1.0f + __expf(-z)); }
__device__ __forceinline__ float wave_sum(float v) {
#pragma unroll
    for (int o = 1; o < 64; o <<= 1) v += __shfl_xor(v, o);
    return v;
}

namespace pg8 {
#define PG8_LAS __attribute__((address_space(3)))
typedef unsigned short bf16_t;
constexpr int BM = 256, BK = 64, HALF = 128, HTB = HALF * BK * 2, STAGE_BYTES = 8 * HTB, NXCD = 8, WGM = 8;
__host__ __device__ __forceinline__ int lds_byte(int r, int c) { const int st = (r >> 4) * 2 + (c >> 5), rr = r & 15, cc = c & 31, ob = rr * 64 + cc * 2; return st * 1024 + (ob ^ (((ob >> 9) & 1) << 5)); }
__host__ __device__ __forceinline__ void stage_rc(int b, int& R, int& C) { const int st = b / 1024, sb = b % 1024, swz = sb ^ (((sb >> 9) & 1) << 5); R = (st >> 1) * 16 + swz / 64; C = (st & 1) * 32 + (swz % 64) / 2; }
__host__ __device__ __forceinline__ int perm32(int rho) { const int n = rho >> 4, i = rho & 15; return 8 * (i >> 2) + 4 * n + (i & 3); }

struct Unit { int pm, pn, pb; };
struct Gemm { const bf16_t* A; const bf16_t* Bt; int K; };

struct StaticOrder {
    static constexpr bool GATHER = false;
    int nM, nN, nwg, G, c;
    __device__ void init(int M, int N, int G_, int c_) { nM = M / BM; nN = N / BM; nwg = nM * nN; G = G_; c = c_; }
    __device__ bool next(int i, Unit& u) const {
        const long L = (long)i * G + c; if (L >= nwg) return false;
        int wgid = (int)L; { const int q = nwg / NXCD, r = nwg % NXCD, xcd = wgid % NXCD, off = wgid / NXCD; wgid = (xcd < r ? xcd * (q + 1) : r * (q + 1) + (xcd - r) * q) + off; }
        const int nig = WGM * nN, gid = wgid / nig, fm = gid * WGM, gsz = (nM - fm) < WGM ? (nM - fm) : WGM;
        u.pm = fm + ((wgid % nig) % gsz); u.pn = (wgid % nig) / gsz; u.pb = u.pn; return true;
    }
    __device__ __forceinline__ unsigned arow(int) const { return 0u; }
};
template <bool GATHER_> struct GroupOrder {
    static constexpr bool GATHER = GATHER_;
    int nN, nwg, G, c; const LAS unsigned short* tile_e; const int* tok; unsigned rowbytes;
    __device__ bool next(int i, Unit& u) const {
        const long L = (long)i * G + c; if (L >= nwg) return false;
        u.pm = (int)L / nN; u.pn = (int)L % nN; u.pb = (int)tile_e[u.pm] * nN + u.pn; return true;
    }
    __device__ __forceinline__ unsigned arow(int slot) const { return (unsigned)tok[slot] * rowbytes; }
};

__device__ __forceinline__ unsigned cvt_pk_bf16(float lo, float hi) { unsigned r; asm volatile("v_cvt_pk_bf16_f32 %0, %1, %2" : "=v"(r) : "v"(lo), "v"(hi)); return r; }

template <class Epi, class Sched, bool ALIGN_EPI = false>
__device__ __forceinline__ void gemm_phase(PG8_LAS unsigned char* lds, const Gemm g, const Sched& S, const Epi& E) {
    constexpr bool GA = Sched::GATHER;
    const int tid = threadIdx.x, wid = __builtin_amdgcn_readfirstlane(tid >> 6), lane = tid & 63, wr = wid >> 2, wc = wid & 3, fr = lane & 15, fq = lane >> 4;
    const int K = g.K, nt = K / BK;
    unsigned voffA[2], voffA1[2], voffB[2]; int RA[2], CA2[2];
#pragma unroll
    for (int i = 0; i < 2; ++i) { int R, C; stage_rc(tid * 16 + i * 8192, R, C); const int Rb = Epi::PERM ? ((R & ~31) + perm32(R & 31)) : R;
        RA[i] = R; CA2[i] = C * 2;
        voffA[i] = (unsigned)(R * K + C) * 2u; voffA1[i] = voffA[i]; voffB[i] = (unsigned)(Rb * K + C) * 2u; }
    const size_t kstep = (size_t)(BK * 2);
    const size_t hstep = (size_t)HALF * K * 2;
    const size_t tstep = 2 * hstep;
    const size_t hstepA = GA ? 0 : hstep;
    const unsigned ldsw = (unsigned)wid * 1024u;
    const int aoff = lds_byte(wr * 64 + fr, fq * 8), boff = lds_byte(wc * 32 + fr, fq * 8);
#define PG8_SA(b, h) (((b) * 2 + (h)) * HTB)
#define PG8_SB(b, h) ((4 + (b) * 2 + (h)) * HTB)
#define PG8_STAGE(bufoff, gbase, voff) do { _Pragma("unroll") for (int _i = 0; _i < 2; ++_i) \
        __builtin_amdgcn_global_load_lds((const unsigned*)((const char*)(gbase) + (voff)[_i]), (PG8_LAS unsigned*)(lds + (bufoff) + ldsw + _i * 8192), 16, 0, 0); } while (0)
#define PG8_LDA(dst, b, h) do { _Pragma("unroll") for (int m = 0; m < 4; ++m) _Pragma("unroll") for (int k = 0; k < 2; ++k) dst[m][k] = *(const PG8_LAS bf16x8*)(lds + PG8_SA(b, h) + aoff + m * 2048 + k * 1024); } while (0)
#define PG8_LDB(dst, b, h) do { _Pragma("unroll") for (int n = 0; n < 2; ++n) _Pragma("unroll") for (int k = 0; k < 2; ++k) dst[n][k] = *(const PG8_LAS bf16x8*)(lds + PG8_SB(b, h) + boff + n * 2048 + k * 1024); } while (0)
#define PG8_MMA(ai, bj, At, Bt) do { __builtin_amdgcn_s_setprio(1); _Pragma("unroll") for (int m = 0; m < 4; ++m) _Pragma("unroll") for (int n = 0; n < 2; ++n) _Pragma("unroll") for (int k = 0; k < 2; ++k) \
        acc[ai][bj][m][n] = __builtin_amdgcn_mfma_f32_16x16x32_bf16(Bt[n][k], At[m][k], acc[ai][bj][m][n], 0, 0, 0); __builtin_amdgcn_s_setprio(0); } while (0)
#define PG8_WAIT_V(n) asm volatile("s_waitcnt vmcnt(" #n ")" ::: "memory")
#define PG8_WAIT_L(n) asm volatile("s_waitcnt lgkmcnt(" #n ")" ::: "memory")
#define PG8_BAR __builtin_amdgcn_s_barrier()
#define PG8_SCHED __builtin_amdgcn_sched_barrier(0)
    Unit cur, nxt; int ui = 0;
    if (!S.next(0, cur)) return;
    f32x4 acc[2][2][4][2];
#pragma unroll
    for (int a = 0; a < 2; ++a)
#pragma unroll
        for (int b = 0; b < 2; ++b)
#pragma unroll
            for (int m = 0; m < 4; ++m)
#pragma unroll
                for (int n = 0; n < 2; ++n) acc[a][b][m][n] = (f32x4){0.f, 0.f, 0.f, 0.f};
    bf16x8 At[4][2], B0[2][2], B1[2][2];
    const char* cA = GA ? (const char*)g.A : (const char*)g.A + (size_t)cur.pm * tstep; const char* cB = (const char*)g.Bt + (size_t)cur.pb * tstep;
    if constexpr (GA) {
#pragma unroll
        for (int i = 0; i < 2; ++i) { voffA[i] = S.arow(cur.pm * BM + RA[i]) + (unsigned)CA2[i]; voffA1[i] = S.arow(cur.pm * BM + HALF + RA[i]) + (unsigned)CA2[i]; }
    }
    PG8_STAGE(PG8_SB(0, 0), cB, voffB); PG8_STAGE(PG8_SB(0, 1), cB + hstep, voffB); PG8_STAGE(PG8_SA(0, 0), cA, voffA); PG8_STAGE(PG8_SA(0, 1), cA + hstepA, voffA1);
    if (wr == 1) PG8_BAR;
    PG8_WAIT_V(2); PG8_BAR;
    PG8_STAGE(PG8_SB(1, 0), cB + kstep, voffB); PG8_STAGE(PG8_SA(1, 0), cA + kstep, voffA); PG8_STAGE(PG8_SB(1, 1), cB + hstep + kstep, voffB);
    PG8_WAIT_V(6); PG8_BAR;
    for (;;) {
        const bool has_next = S.next(ui + 1, nxt);
        const char* nA = GA ? (const char*)g.A : (has_next ? (const char*)g.A + (size_t)nxt.pm * tstep : cA);
        const char* nB = has_next ? (const char*)g.Bt + (size_t)nxt.pb * tstep : cB;
        for (int t = 0; t < nt; t += 2) {
            const bool last = (t == nt - 2);
            const char* a1 = cA + (size_t)(t + 1) * kstep;
            const char* a2 = last ? nA : cA + (size_t)(t + 2) * kstep; const char* b2 = last ? nB : cB + (size_t)(t + 2) * kstep;
            const char* a3 = a2 + kstep; const char* b3 = b2 + kstep;
            unsigned nvA[2], nvA1[2];
            if constexpr (GA) {
                if (last && has_next) {
#pragma unroll
                    for (int i = 0; i < 2; ++i) { nvA[i] = S.arow(nxt.pm * BM + RA[i]) + (unsigned)CA2[i]; nvA1[i] = S.arow(nxt.pm * BM + HALF + RA[i]) + (unsigned)CA2[i]; }
                } else {
#pragma unroll
                    for (int i = 0; i < 2; ++i) { nvA[i] = voffA[i]; nvA1[i] = voffA1[i]; }
                }
            }
            PG8_LDB(B0, 0, 0); PG8_LDB(B1, 0, 1); PG8_SCHED; PG8_LDA(At, 0, 0); PG8_STAGE(PG8_SA(1, 1), a1 + hstepA, voffA1);
            if constexpr (GA) {
#pragma unroll
                for (int i = 0; i < 2; ++i) { voffA[i] = nvA[i]; voffA1[i] = nvA1[i]; }
            }
            PG8_WAIT_V(8); PG8_WAIT_L(0); PG8_BAR; PG8_MMA(0, 0, At, B0); PG8_MMA(0, 1, At, B1); PG8_BAR; PG8_SCHED;
            PG8_LDA(At, 0, 1); PG8_STAGE(PG8_SB(0, 0), b2, voffB); PG8_STAGE(PG8_SB(0, 1), b2 + hstep, voffB); PG8_STAGE(PG8_SA(0, 0), a2, voffA);
            PG8_WAIT_V(8); PG8_WAIT_L(0); PG8_BAR; PG8_MMA(1, 0, At, B0); PG8_MMA(1, 1, At, B1); PG8_BAR; PG8_SCHED;
            PG8_LDB(B0, 1, 0); PG8_LDB(B1, 1, 1); PG8_SCHED; PG8_LDA(At, 1, 0); PG8_STAGE(PG8_SA(0, 1), a2 + hstepA, voffA1);
            PG8_WAIT_V(8); PG8_WAIT_L(0); PG8_BAR; PG8_MMA(0, 0, At, B0); PG8_MMA(0, 1, At, B1); PG8_BAR; PG8_SCHED;
            PG8_LDA(At, 1, 1); PG8_STAGE(PG8_SB(1, 0), b3, voffB); PG8_STAGE(PG8_SB(1, 1), b3 + hstep, voffB); PG8_STAGE(PG8_SA(1, 0), a3, voffA);
            PG8_WAIT_V(8); PG8_WAIT_L(0); PG8_BAR; PG8_MMA(1, 0, At, B0); PG8_MMA(1, 1, At, B1); PG8_BAR; PG8_SCHED;
        }
        if constexpr (ALIGN_EPI) { if (wr == 0) PG8_BAR; }
        E(acc, cur, wr, wc, fr, fq);
        if (!has_next) break;
#pragma unroll
        for (int a = 0; a < 2; ++a)
#pragma unroll
            for (int b = 0; b < 2; ++b)
#pragma unroll
                for (int m = 0; m < 4; ++m)
#pragma unroll
                    for (int n = 0; n < 2; ++n) acc[a][b][m][n] = (f32x4){0.f, 0.f, 0.f, 0.f};
        cur = nxt; cA = nA; cB = nB; ++ui;
        if constexpr (ALIGN_EPI) { if (wr == 1) PG8_BAR; }
    }
    PG8_WAIT_V(0);
    if constexpr (!ALIGN_EPI) { if (wr == 0) PG8_BAR; }
    PG8_BAR;
#undef PG8_SA
#undef PG8_SB
#undef PG8_STAGE
#undef PG8_LDA
#undef PG8_LDB
#undef PG8_MMA
#undef PG8_WAIT_V
#undef PG8_WAIT_L
#undef PG8_BAR
#undef PG8_SCHED
}

typedef const f32x4 (&AccRef)[2][2][4][2];

struct EpiInProj {
    static constexpr bool PERM = true;
    bf16_t* O; const float* bias;
    __device__ __forceinline__ void operator()(AccRef acc, const Unit& u, int wr, int wc, int fr, int fq) const {
        const int row0 = u.pm * BM + wr * 64 + fr, col0 = u.pn * BM + wc * 32 + 8 * fq;
        const int kind = u.pn < 4 ? 0 : (u.pn < 8 ? 1 : (u.pn < 14 ? 2 : (u.pn < 26 ? 0 : 3)));
        f32x4 bv[2][2];
#pragma unroll
        for (int bj = 0; bj < 2; ++bj)
#pragma unroll
            for (int n = 0; n < 2; ++n) bv[bj][n] = *(const f32x4*)(bias + col0 + bj * HALF + 4 * n);
#pragma unroll
        for (int ai = 0; ai < 2; ++ai)
#pragma unroll
            for (int m = 0; m < 4; ++m) { bf16_t* rowp = O + (size_t)(row0 + ai * HALF + m * 16) * DIN + col0;
#pragma unroll
                for (int bj = 0; bj < 2; ++bj) { f32x4 v0 = acc[ai][bj][m][0] + bv[bj][0], v1 = acc[ai][bj][m][1] + bv[bj][1];
                    if (kind == 1) {
#pragma unroll
                        for (int j = 0; j < 4; ++j) { v0[j] = gelu_tanh(v0[j]); v1[j] = gelu_tanh(v1[j]); }
                    } else if (kind == 2) { v0 = v0 * 0.125f; v1 = v1 * 0.125f; }
                    else if (kind == 3) {
#pragma unroll
                        for (int j = 0; j < 4; ++j) { v0[j] = sigmoidf_(v0[j]); v1[j] = sigmoidf_(v1[j]); }
                    }
                    u32x4 w; w.x = cvt_pk_bf16(v0[0], v0[1]); w.y = cvt_pk_bf16(v0[2], v0[3]); w.z = cvt_pk_bf16(v1[0], v1[1]); w.w = cvt_pk_bf16(v1[2], v1[3]);
                    *(u32x4*)(rowp + bj * HALF) = w; } }
    }
};
struct EpiProjRnn {
    static constexpr bool PERM = false;
    const bf16_t* proj; float* part;
    __device__ __forceinline__ void operator()(AccRef acc, const Unit& u, int wr, int wc, int fr, int fq) const {
        const int row0 = u.pm * BM + wr * 64 + fr, col0 = u.pn * BM + wc * 32 + 4 * fq;
#pragma unroll
        for (int ai = 0; ai < 2; ++ai)
#pragma unroll
            for (int m = 0; m < 4; ++m) { const size_t row = (size_t)(row0 + ai * HALF + m * 16);
#pragma unroll
                for (int bj = 0; bj < 2; ++bj)
#pragma unroll
                    for (int n = 0; n < 2; ++n) { const int c = col0 + bj * HALF + n * 16;
                        const u32x2 gw = *(const u32x2*)(proj + row * DIN + C_GRNN + c);
                        const f32x4 gt = (f32x4){bflo(gw.x), bfhi(gw.x), bflo(gw.y), bfhi(gw.y)};
                        *(f32x4*)(part + row * D + c) = gt * acc[ai][bj][m][n]; } }
    }
};
struct EpiProjAtt {
    static constexpr bool PERM = false;
    const bf16_t* proj; const float* part; bf16_t* merged;
    __device__ __forceinline__ void operator()(AccRef acc, const Unit& u, int wr, int wc, int fr, int fq) const {
        const int row0 = u.pm * BM + wr * 64 + fr, col0 = u.pn * BM + wc * 32 + 4 * fq;
#pragma unroll
        for (int ai = 0; ai < 2; ++ai)
#pragma unroll
            for (int m = 0; m < 4; ++m) { const size_t row = (size_t)(row0 + ai * HALF + m * 16);
#pragma unroll
                for (int bj = 0; bj < 2; ++bj)
#pragma unroll
                    for (int n = 0; n < 2; ++n) { const int c = col0 + bj * HALF + n * 16;
                        const u32x2 gw = *(const u32x2*)(proj + row * DIN + C_GATT + c);
                        const f32x4 gt = (f32x4){bflo(gw.x), bfhi(gw.x), bflo(gw.y), bfhi(gw.y)};
                        const f32x4 v = *(const f32x4*)(part + row * D + c) + gt * acc[ai][bj][m][n];
                        u32x2 w; w.x = cvt_pk_bf16(v[0], v[1]); w.y = cvt_pk_bf16(v[2], v[3]);
                        *(u32x2*)(merged + row * D + c) = w; } }
    }
};
struct EpiF32Res {
    static constexpr bool PERM = false;
    const float* base; float* out; int ldc; float scale;
    __device__ __forceinline__ void operator()(AccRef acc, const Unit& u, int wr, int wc, int fr, int fq) const {
        const int row0 = u.pm * BM + wr * 64 + fr, col0 = u.pn * BM + wc * 32 + 4 * fq;
#pragma unroll
        for (int ai = 0; ai < 2; ++ai)
#pragma unroll
            for (int m = 0; m < 4; ++m) { const size_t off = (size_t)(row0 + ai * HALF + m * 16) * ldc + col0;
#pragma unroll
                for (int bj = 0; bj < 2; ++bj)
#pragma unroll
                    for (int n = 0; n < 2; ++n) { f32x4 v = acc[ai][bj][m][n];
                        if (base) v = v + *(const f32x4*)(base + off + bj * HALF + n * 16) * scale;
                        *(f32x4*)(out + off + bj * HALF + n * 16) = v; } }
    }
};
struct EpiGateUp {
    static constexpr bool PERM = true;
    bf16_t* H;
    __device__ __forceinline__ void operator()(AccRef acc, const Unit& u, int wr, int wc, int fr, int fq) const {
        const int row0 = u.pm * BM + wr * 64 + fr, col0 = u.pn * HALF + wc * 32 + 8 * fq;
#pragma unroll
        for (int ai = 0; ai < 2; ++ai)
#pragma unroll
            for (int m = 0; m < 4; ++m) { bf16_t* rowp = H + (size_t)(row0 + ai * HALF + m * 16) * DE + col0;
                f32x4 o[2];
#pragma unroll
                for (int n = 0; n < 2; ++n) { const f32x4 gt = acc[ai][0][m][n], up = acc[ai][1][m][n];
#pragma unroll
                    for (int j = 0; j < 4; ++j) o[n][j] = gt[j] / (1.0f + __expf(-gt[j])) * up[j]; }
                u32x4 w; w.x = cvt_pk_bf16(o[0][0], o[0][1]); w.y = cvt_pk_bf16(o[0][2], o[0][3]); w.z = cvt_pk_bf16(o[1][0], o[1][1]); w.w = cvt_pk_bf16(o[1][2], o[1][3]);
                *(u32x4*)rowp = w; }
    }
};
struct EpiDown {
    static constexpr bool PERM = true;
    bf16_t* Y; const float* wslot; float* out; int mt_r;
    __device__ __forceinline__ void operator()(AccRef acc, const Unit& u, int wr, int wc, int fr, int fq) const {
        const int col0 = u.pn * BM + wc * 32 + 8 * fq;
        if (u.pm < mt_r) {
            const int row0 = u.pm * BM + wr * 64 + fr;
#pragma unroll
            for (int ai = 0; ai < 2; ++ai)
#pragma unroll
                for (int m = 0; m < 4; ++m) { const size_t row = (size_t)(row0 + ai * HALF + m * 16); const float w8 = wslot[row]; bf16_t* rowp = Y + row * D + col0;
#pragma unroll
                    for (int bj = 0; bj < 2; ++bj) { const f32x4 v0 = acc[ai][bj][m][0] * w8, v1 = acc[ai][bj][m][1] * w8;
                        u32x4 w; w.x = cvt_pk_bf16(v0[0], v0[1]); w.y = cvt_pk_bf16(v0[2], v0[3]); w.z = cvt_pk_bf16(v1[0], v1[1]); w.w = cvt_pk_bf16(v1[2], v1[3]);
                        *(u32x4*)(rowp + bj * HALF) = w; } }
        } else {
            const int row0 = (u.pm - mt_r) * BM + wr * 64 + fr;
#pragma unroll
            for (int ai = 0; ai < 2; ++ai)
#pragma unroll
                for (int m = 0; m < 4; ++m) { float* rowp = out + (size_t)(row0 + ai * HALF + m * 16) * D + col0;
#pragma unroll
                    for (int bj = 0; bj < 2; ++bj)
#pragma unroll
                        for (int n = 0; n < 2; ++n) { float* p = rowp + bj * HALF + 4 * n; *(f32x4*)p = *(const f32x4*)p * ALPHA + acc[ai][bj][m][n]; } }
        }
    }
};
}

#define XB_TMO      128
#define XB_XCNT(j)  (256  + 64 * (j))
#define XB_XSUB(j)  (1280 + 64 * (j))
#define XB_XGEN(j)  (2304 + 64 * (j))
#define XB_TOP      3328
#define XB_TOPGEN   3392
#define XCD_BAR_WORDS 3456
#define XB_SPIN_CAP (1u << 18)
__device__ __forceinline__ unsigned xb_ld(unsigned* p)              { return __hip_atomic_load(p, __ATOMIC_RELAXED, __HIP_MEMORY_SCOPE_AGENT); }
__device__ __forceinline__ unsigned xb_add(unsigned* p, unsigned v) { return __hip_atomic_fetch_add(p, v, __ATOMIC_RELAXED, __HIP_MEMORY_SCOPE_AGENT); }
__device__ __forceinline__ unsigned xb_xcc_id() { return (unsigned)__builtin_amdgcn_s_getreg((3 << 11) | 20) & 0xFu; }
#define XB_SPIN(cond, bar) do { unsigned _sp = 0; while (cond) { __builtin_amdgcn_s_sleep(1); \
    if ((++_sp & 255u) == 0u) { if (xb_ld(&(bar)[XB_TMO])) break; if (_sp > XB_SPIN_CAP) { atomicAdd(&(bar)[XB_TMO], 1u); break; } } } } while (0)
struct XcdBarrier { unsigned* bar; unsigned x; volatile LAS unsigned* st; };
__device__ __forceinline__ XcdBarrier xcd_barrier_post(unsigned* bar, volatile LAS unsigned* st) {
    XcdBarrier b; b.bar = bar; b.x = xb_xcc_id(); b.st = st;
    if (threadIdx.x == 0) (void)xb_add(&bar[XB_XCNT(b.x)], 1u);
    return b;
}
__device__ __forceinline__ void xcd_barrier_complete(unsigned* bar, unsigned x, unsigned& nloc, unsigned& nx) {
    const unsigned G = gridDim.x * gridDim.y * gridDim.z;
    unsigned sum, cnt, mine, sp = 0u;
    for (;;) {
        sum = 0u; cnt = 0u; mine = 0u;
#pragma unroll
        for (unsigned j = 0; j < 16; ++j) { const unsigned c = xb_ld(&bar[XB_XCNT(j)]); sum += c; cnt += (c > 0u) ? 1u : 0u; mine = (j == x) ? c : mine; }
        if (sum == G) break;
        __builtin_amdgcn_s_sleep(1);
        if ((++sp & 255u) == 0u) { if (xb_ld(&bar[XB_TMO])) break; if (sp > XB_SPIN_CAP) { atomicAdd(&bar[XB_TMO], 1u); break; } }
    }
    nloc = mine > 0u ? mine : 1u; nx = cnt > 0u ? cnt : 1u;
}
__device__ __forceinline__ void xcd_barrier(const XcdBarrier& b) {
    asm volatile("s_waitcnt vmcnt(0)" ::: "memory");
    __syncthreads();
    if (threadIdx.x == 0) {
        unsigned* bar = b.bar;
        __builtin_amdgcn_s_waitcnt(0);
        unsigned nloc = b.st[0], nx = b.st[1];
        if (nloc == 0u) { xcd_barrier_complete(bar, b.x, nloc, nx); b.st[0] = nloc; b.st[1] = nx; }
        const unsigned old = xb_add(&bar[XB_XSUB(b.x)], 1u);
        const unsigned gen = old / nloc;
        if (old + 1u == (gen + 1u) * nloc) {
            __builtin_amdgcn_fence(__ATOMIC_RELEASE, "agent");
            asm volatile("s_waitcnt vmcnt(0)" ::: "memory");
            const unsigned og = xb_add(&bar[XB_TOP], 1u);
            const unsigned tg = og / nx;
            if (og + 1u == (tg + 1u) * nx) xb_add(&bar[XB_TOPGEN], 1u);
            else XB_SPIN(xb_ld(&bar[XB_TOPGEN]) == tg, bar);
            __builtin_amdgcn_fence(__ATOMIC_ACQUIRE, "agent");
            xb_add(&bar[XB_XGEN(b.x)], 1u);
            asm volatile("s_waitcnt vmcnt(0)" ::: "memory");
        } else {
            XB_SPIN(xb_ld(&bar[XB_XGEN(b.x)]) == gen, bar);
            __builtin_amdgcn_fence(__ATOMIC_ACQUIRE, "agent");
            asm volatile("s_waitcnt vmcnt(0)" ::: "memory");
        }
    }
    __syncthreads();
}

struct Params { const float* in[26]; float* out; unsigned char* ws; int lo, hi; unsigned char bucket[3][136]; };
static_assert(sizeof(Params) == 26 * 8 + 8 + 8 + 8 + 408, "Params has no padding holes");

__device__ __forceinline__ void tr128(const float* src, int ld_src, bf16* dst, int ld_dst, LAS float* tile, int tid) {
    f32x4 v[8];
#pragma unroll
    for (int it = 0; it < 8; ++it) { const int id = it * 512 + tid, k = id >> 5, c4 = id & 31; v[it] = *(const f32x4*)(src + (size_t)k * ld_src + c4 * 4); }
#pragma unroll
    for (int it = 0; it < 8; ++it) { const int id = it * 512 + tid, k = id >> 5, c4 = id & 31; LAS float* p = tile + k * 129 + c4 * 4; p[0] = v[it][0]; p[1] = v[it][1]; p[2] = v[it][2]; p[3] = v[it][3]; }
    __syncthreads();
#pragma unroll
    for (int it = 0; it < 4; ++it) { const int id = it * 512 + tid, n = id >> 4, kc = id & 15; const LAS float* s = tile + (kc * 8) * 129 + n;
        u32x4 o; o.x = pk2(s[0], s[129]); o.y = pk2(s[2 * 129], s[3 * 129]); o.z = pk2(s[4 * 129], s[5 * 129]); o.w = pk2(s[6 * 129], s[7 * 129]);
        *(u32x4*)(dst + (size_t)n * ld_dst + kc * 8) = o; }
    __syncthreads();
}
__device__ __forceinline__ void tr_matrix_item(const float* W, int K, int N, bf16* WT, int item, LAS float* tile, int tid) {
    const int nbn = N / 128, kb = item / nbn, nb = item % nbn;
    tr128(W + (size_t)kb * 128 * N + nb * 128, N, WT + (size_t)nb * 128 * K + kb * 128, K, tile, tid);
}

__device__ __forceinline__ void rglru_chunk(const Params& p, int item, LAS float* xcs, int lane) {
    const bf16* proj = (const bf16*)(p.ws + WS_PROJ);
    bf16* hloc = (bf16*)(p.ws + WS_HLOC); bf16* cuma = (bf16*)(p.ws + WS_CUMA);
    float* sumA = (float*)(p.ws + WS_SUMA); float* sumH = (float*)(p.ws + WS_SUMH);
    const int c = item % NCH, h = (item / NCH) % 16, b = item / (NCH * 16);
    const int ch = h * 64 + lane;
    float wa[64], wi[64];
#pragma unroll
    for (int i = 0; i < 64; ++i) { wa[i] = p.in[5][(size_t)(h * 64 + i) * 64 + lane]; wi[i] = p.in[7][(size_t)(h * 64 + i) * 64 + lane]; }
    const float cw0 = p.in[3][ch], cw1 = p.in[3][1024 + ch], cw2 = p.in[3][2048 + ch], cw3 = p.in[3][3072 + ch], cb = p.in[4][ch];
    const float ba = p.in[6][ch], bi = p.in[8][ch];
    const float sp8 = 8.0f * log1pf(expf(-p.in[9][ch]));
    const int t0 = c * TCH;
    const bf16* xr = proj + (size_t)(b * SEQ) * DIN + C_XR + ch;
    float xm3 = 0.f, xm2 = 0.f, xm1 = 0.f;
    if (t0 > 0) { xm3 = bf1(xr[(size_t)(t0 - 3) * DIN]); xm2 = bf1(xr[(size_t)(t0 - 2) * DIN]); xm1 = bf1(xr[(size_t)(t0 - 1) * DIN]); }
    float hst = 0.f, pa = 1.f;
    for (int tb = 0; tb < TCH; tb += 8) {
        float xv[8], xc[8];
#pragma unroll
        for (int j = 0; j < 8; ++j) xv[j] = bf1(xr[(size_t)(t0 + tb + j) * DIN]);
#pragma unroll
        for (int j = 0; j < 8; ++j) { xc[j] = cb + cw0 * xm3 + cw1 * xm2 + cw2 * xm1 + cw3 * xv[j]; xm3 = xm2; xm2 = xm1; xm1 = xv[j]; xcs[j * 64 + lane] = xc[j]; }
        asm volatile("s_waitcnt lgkmcnt(0)" ::: "memory");
#pragma unroll
        for (int j = 0; j < 8; ++j) {
            float ra = ba, ri = bi;
#pragma unroll
            for (int i = 0; i < 64; i += 4) { const f32x4 x4 = *(const LAS f32x4*)(xcs + j * 64 + i);
                ra += x4[0] * wa[i] + x4[1] * wa[i + 1] + x4[2] * wa[i + 2] + x4[3] * wa[i + 3];
                ri += x4[0] * wi[i] + x4[1] * wi[i + 1] + x4[2] * wi[i + 2] + x4[3] * wi[i + 3]; }
            const float r = sigmoidf_(ra), ig = sigmoidf_(ri);
            const float la = -sp8 * r, a = __expf(la);
            const float uu = sqrtf(-expm1f(2.0f * la)) * (ig * xc[j]);
            hst = a * hst + uu; pa = pa * a;
            const size_t o = (size_t)(b * SEQ + t0 + tb + j) * D + ch;
            hloc[o] = (bf16)f2bf(hst); cuma[o] = (bf16)f2bf(pa);
        }
        asm volatile("s_waitcnt lgkmcnt(0)" ::: "memory");
    }
    sumA[(size_t)(b * NCH + c) * D + ch] = pa; sumH[(size_t)(b * NCH + c) * D + ch] = hst;
}

__device__ __forceinline__ void attn_item(const Params& p, int item, LAS unsigned char* vt, const LAS float* btab_all, int lane) {
    const bf16* proj = (const bf16*)(p.ws + WS_PROJ);
    const int rq = item & 127, bh = item >> 7, head = bh % 24, b = bh / 24;
    const int g = head >> 3, hh = head & 7, dil = (g == 0) ? 1 : (g == 1 ? 4 : 16), nqb = 128 / dil;
    const int res = rq / nqb, qb = rq % nqb, l0 = qb * 32;
    const int r = lane & 31, hf = lane >> 5;
    const LAS float* btab = btab_all + (g * 8 + hh) * 132;
    const size_t tokbase = (size_t)b * SEQ;
    bf16x8 qf[4];
    { const bf16* qp = proj + (tokbase + (size_t)(l0 + r) * dil + res) * DIN + C_Q + head * 64 + 8 * hf;
#pragma unroll
      for (int s = 0; s < 4; ++s) qf[s] = *(const bf16x8*)(qp + 16 * s); }
    f32x16 o0, o1;
#pragma unroll
    for (int i = 0; i < 16; ++i) { o0[i] = 0.f; o1[i] = 0.f; }
    float mrun = -1e30f, lrun = 0.f;
    for (int kt = 0; kt < 5; ++kt) {
        const int k0 = l0 - 128 + 32 * kt;
        if (k0 < 0) continue;
        const bf16* kp = proj + (tokbase + (size_t)(k0 + r) * dil + res) * DIN + C_K + head * 64 + 8 * hf;
        bf16x8 kf[4];
#pragma unroll
        for (int s = 0; s < 4; ++s) kf[s] = *(const bf16x8*)(kp + 16 * s);
        u32x4 va[2][2];
#pragma unroll
        for (int it = 0; it < 2; ++it) { const int kp2 = (lane >> 3) + 8 * it, dc = lane & 7;
#pragma unroll
            for (int e = 0; e < 2; ++e) va[it][e] = *(const u32x4*)(proj + (tokbase + (size_t)(k0 + 2 * kp2 + e) * dil + res) * DIN + C_V + head * 64 + 8 * dc); }
        f32x16 st;
#pragma unroll
        for (int i = 0; i < 16; ++i) st[i] = 0.f;
#pragma unroll
        for (int s = 0; s < 4; ++s) st = __builtin_amdgcn_mfma_f32_32x32x16_bf16(kf[s], qf[s], st, 0, 0, 0);
#pragma unroll
        for (int it = 0; it < 2; ++it) { const int kp2 = (lane >> 3) + 8 * it, dc = lane & 7;
#pragma unroll
            for (int w = 0; w < 4; ++w) { const unsigned a0 = va[it][0][w], a1 = va[it][1][w];
                *(LAS unsigned*)(vt + (8 * dc + 2 * w) * 72 + 4 * kp2) = (a0 & 0xffffu) | (a1 << 16);
                *(LAS unsigned*)(vt + (8 * dc + 2 * w + 1) * 72 + 4 * kp2) = (a0 >> 16) | (a1 & 0xffff0000u); } }
        float sv[16]; float mt = -1e30f;
#pragma unroll
        for (int i = 0; i < 16; ++i) { const int kk = (i & 3) + 8 * (i >> 2) + 4 * hf; const int rel = (l0 + r) - (k0 + kk);
            const bool ok = (rel >= 0) && (rel <= 128); const float bs = btab[ok ? rel : 0];
            sv[i] = ok ? st[i] + bs : -1e30f; mt = fmaxf(mt, sv[i]); }
        mt = fmaxf(mt, __shfl_xor(mt, 32));
        const float mnew = fmaxf(mrun, mt), al = __expf(mrun - mnew);
        float ps = 0.f; float pv[16];
#pragma unroll
        for (int i = 0; i < 16; ++i) { pv[i] = __expf(sv[i] - mnew); ps += pv[i]; }
        lrun = lrun * al + ps; mrun = mnew;
#pragma unroll
        for (int i = 0; i < 16; ++i) { o0[i] *= al; o1[i] *= al; }
        bf16x8 pf[2];
#pragma unroll
        for (int s = 0; s < 2; ++s) { u32x4 w; w.x = pk2(pv[8 * s], pv[8 * s + 1]); w.y = pk2(pv[8 * s + 2], pv[8 * s + 3]); w.z = pk2(pv[8 * s + 4], pv[8 * s + 5]); w.w = pk2(pv[8 * s + 6], pv[8 * s + 7]);
            pf[s] = __builtin_bit_cast(bf16x8, w); }
        asm volatile("s_waitcnt lgkmcnt(0)" ::: "memory");
#pragma unroll
        for (int s = 0; s < 2; ++s) {
            { const LAS unsigned char* q = vt + (r) * 72 + (16 * s + 4 * hf) * 2; u32x4 w; const u32x2 lo = *(const LAS u32x2*)q, hi = *(const LAS u32x2*)(q + 16); w.x = lo.x; w.y = lo.y; w.z = hi.x; w.w = hi.y;
              o0 = __builtin_amdgcn_mfma_f32_32x32x16_bf16(__builtin_bit_cast(bf16x8, w), pf[s], o0, 0, 0, 0); }
            { const LAS unsigned char* q = vt + (32 + r) * 72 + (16 * s + 4 * hf) * 2; u32x4 w; const u32x2 lo = *(const LAS u32x2*)q, hi = *(const LAS u32x2*)(q + 16); w.x = lo.x; w.y = lo.y; w.z = hi.x; w.w = hi.y;
              o1 = __builtin_amdgcn_mfma_f32_32x32x16_bf16(__builtin_bit_cast(bf16x8, w), pf[s], o1, 0, 0, 0); }
        }
        asm volatile("s_waitcnt lgkmcnt(0)" ::: "memory");
    }
    const float ltot = lrun + __shfl_xor(lrun, 32), inv = 1.0f / ltot;
    const size_t tok = tokbase + (size_t)(l0 + r) * dil + res;
    bf16* ao = (bf16*)(p.ws + WS_AO) + ((size_t)g * T + tok) * 512 + hh * 64;
#pragma unroll
    for (int q4 = 0; q4 < 4; ++q4) {
        u32x2 w; w.x = pk2(o0[4 * q4] * inv, o0[4 * q4 + 1] * inv); w.y = pk2(o0[4 * q4 + 2] * inv, o0[4 * q4 + 3] * inv);
        *(u32x2*)(ao + 8 * q4 + 4 * hf) = w;
        u32x2 w1; w1.x = pk2(o1[4 * q4] * inv, o1[4 * q4 + 1] * inv); w1.y = pk2(o1[4 * q4 + 2] * inv, o1[4 * q4 + 3] * inv);
        *(u32x2*)(ao + 32 + 8 * q4 + 4 * hf) = w1;
    }
    if (hf == 0) ((float*)(p.ws + WS_LSE))[((size_t)g * T + tok) * 8 + hh] = mrun + __logf(ltot);
}

__device__ __forceinline__ void build_tile_table(const Params& p, LAS unsigned char* lds, int tid) {
    LAS int* tbase = (LAS int*)(lds + L_TBASE); LAS unsigned short* tile_e = (LAS unsigned short*)(lds + L_TILEE);
    const unsigned* cnt = (const unsigned*)(p.ws + WS_CTL) + CW_CNT;
    __syncthreads();
    if (tid == 0) { int acc = 0; for (int e = 0; e < NE; ++e) { tbase[e] = acc; acc += ((int)cnt[e] + 255) >> 8; } tbase[NE] = acc; tbase[NE + 1] = acc + SH_TILES; }
    __syncthreads();
    if (tid < NE) { const int a = tbase[tid], bnd = tbase[tid + 1]; for (int i = a; i < bnd; ++i) tile_e[i] = (unsigned short)tid; }
    if (tid < SH_TILES) tile_e[tbase[NE] + tid] = (unsigned short)NE;
    __syncthreads();
}

__global__ void __launch_bounds__(512, 2) fwd_kernel(Params p) {
    extern __shared__ __attribute__((aligned(16))) unsigned char lds_raw[];
    LAS unsigned char* lds = (LAS unsigned char*)lds_raw;
    const int tid = threadIdx.x, lane = tid & 63, wave = __builtin_amdgcn_readfirstlane(tid >> 6);
    const int G = gridDim.x, bid = blockIdx.x;
    const int gw = bid * 8 + wave, NGW = G * 8;
    const size_t gtid = (size_t)bid * 512 + tid, NTH = (size_t)G * 512;
    unsigned char* ws = p.ws;
    volatile LAS unsigned* misc = (volatile LAS unsigned*)(lds + L_MISC);
    if (tid < 16) misc[tid] = 0u;
    { LAS float* bt = (LAS float*)(lds + L_BTAB);
      for (int i = tid; i < 3 * 8 * 132; i += 512) { const int g = i / (8 * 132), hh = (i / 132) % 8, rel = i % 132; bt[i] = (rel <= 128) ? p.in[12][(int)p.bucket[g][rel] * 24 + g * 8 + hh] : 0.f; } }
    __syncthreads();
#if N_LAUNCHES == 1
    XcdBarrier bar = xcd_barrier_post((unsigned*)(ws + WS_CTL) + CW_BAR, misc);
#define GRID_BAR() xcd_barrier(bar)
#else
#define GRID_BAR() do { } while (0)
#endif
    const int lo = p.lo, hi = p.hi;
#define IN(k) (lo <= (k) && (k) < hi)
#define SEAM(k) do { if (IN(k) && IN((k) + 1)) GRID_BAR(); } while (0)

    if (IN(0)) {
        LAS float* tile = (LAS float*)lds;
        for (int it = bid; it < 720; it += G) {
            int r = it;
            if (r < 544) { tr_matrix_item(p.in[1], 1024, DIN, (bf16*)(ws + WS_WINT), r, tile, tid); continue; } r -= 544;
            if (r < 64) { tr_matrix_item(p.in[10], 1024, 1024, (bf16*)(ws + WS_WPRT), r, tile, tid); continue; } r -= 64;
            if (r < 32) { tr_matrix_item(p.in[11], 512, 1024, (bf16*)(ws + WS_WPAT), r, tile, tid); continue; } r -= 32;
            if (r < 64) { tr_matrix_item(p.in[13], 1024, 1024, (bf16*)(ws + WS_WOT), r, tile, tid); continue; } r -= 64;
            tr_matrix_item(p.in[16], 1024, 256, (bf16*)(ws + WS_WRT), r, tile, tid);
        }
        const f32x4* x4 = (const f32x4*)p.in[0]; u32x4* xb = (u32x4*)(ws + WS_XB);
        for (size_t i = gtid; i < (size_t)T * D / 8; i += NTH) { const f32x4 a = x4[2 * i], b = x4[2 * i + 1];
            u32x4 o; o.x = pk2(a[0], a[1]); o.y = pk2(a[2], a[3]); o.z = pk2(b[0], b[1]); o.w = pk2(b[2], b[3]); xb[i] = o; }
    }
    SEAM(0);
    if (IN(1)) {
        pg8::Gemm g{(const bf16*)(ws + WS_XB), (const bf16*)(ws + WS_WINT), 1024}; pg8::StaticOrder S; S.init(T, DIN, G, bid);
        pg8::EpiInProj E{(bf16*)(ws + WS_PROJ), p.in[2]};
        pg8::gemm_phase<pg8::EpiInProj, pg8::StaticOrder, true>(lds, g, S, E);
    }
    SEAM(1);
    if (IN(2)) {
        LAS float* xcs = (LAS float*)(lds + wave * 2048);
        for (int it = gw; it < NB * 16 * NCH; it += NGW) rglru_chunk(p, it, xcs, lane);
        LAS unsigned char* vt = lds + 16384 + wave * 4608;
        const LAS float* bt = (const LAS float*)(lds + L_BTAB);
        for (int it = gw; it < NB * 24 * 128; it += NGW) attn_item(p, it, vt, bt, lane);
    }
    SEAM(2);
    if (IN(3)) {
        const bf16* proj = (const bf16*)(ws + WS_PROJ);
        const bf16* hloc = (const bf16*)(ws + WS_HLOC); const bf16* cuma = (const bf16*)(ws + WS_CUMA);
        const float* sumA = (const float*)(ws + WS_SUMA); const float* sumH = (const float*)(ws + WS_SUMH);
        bf16* yrnn = (bf16*)(ws + WS_YRNN);
        for (int it = bid; it < NB * NCH; it += G) {
            const int b = it / NCH, c = it % NCH, ch0 = (tid & 127) * 8, ts = tid >> 7;
            float H[8];
#pragma unroll
            for (int j = 0; j < 8; ++j) H[j] = 0.f;
            for (int k = 0; k < c; ++k) { const float* pa = sumA + (size_t)(b * NCH + k) * D + ch0; const float* ph = sumH + (size_t)(b * NCH + k) * D + ch0;
                const f32x4 a0 = *(const f32x4*)pa, a1 = *(const f32x4*)(pa + 4), h0 = *(const f32x4*)ph, h1 = *(const f32x4*)(ph + 4);
#pragma unroll
                for (int j = 0; j < 4; ++j) { H[j] = a0[j] * H[j] + h0[j]; H[4 + j] = a1[j] * H[4 + j] + h1[j]; } }
            for (int tt = ts; tt < TCH; tt += 4) { const size_t t = (size_t)b * SEQ + c * TCH + tt;
                const u32x4 hl = *(const u32x4*)(hloc + t * D + ch0), ca = *(const u32x4*)(cuma + t * D + ch0), gg = *(const u32x4*)(proj + t * DIN + C_GR + ch0);
                u32x4 o;
#pragma unroll
                for (int w = 0; w < 4; ++w) { const float y0 = (bflo(hl[w]) + bflo(ca[w]) * H[2 * w]) * bflo(gg[w]), y1 = (bfhi(hl[w]) + bfhi(ca[w]) * H[2 * w + 1]) * bfhi(gg[w]); o[w] = pk2(y0, y1); }
                *(u32x4*)(yrnn + t * D + ch0) = o; }
        }
        const bf16* ao = (const bf16*)(ws + WS_AO); const float* lse = (const float*)(ws + WS_LSE); bf16* yatt = (bf16*)(ws + WS_YATT);
        for (size_t i = gtid; i < (size_t)T * 64; i += NTH) { const size_t t = i >> 6; const int c8 = (int)(i & 63), hh = c8 >> 3;
            const float l0 = lse[t * 8 + hh], l1 = lse[((size_t)T + t) * 8 + hh], l2 = lse[((size_t)2 * T + t) * 8 + hh];
            const float mx = fmaxf(l0, fmaxf(l1, l2)); float w0 = __expf(l0 - mx), w1 = __expf(l1 - mx), w2 = __expf(l2 - mx); const float inv = 1.0f / (w0 + w1 + w2); w0 *= inv; w1 *= inv; w2 *= inv;
            const u32x4 a = *(const u32x4*)(ao + t * 512 + c8 * 8), bq = *(const u32x4*)(ao + ((size_t)T + t) * 512 + c8 * 8), cq = *(const u32x4*)(ao + ((size_t)2 * T + t) * 512 + c8 * 8);
            u32x4 o;
#pragma unroll
            for (int w = 0; w < 4; ++w) o[w] = pk2(w0 * bflo(a[w]) + w1 * bflo(bq[w]) + w2 * bflo(cq[w]), w0 * bfhi(a[w]) + w1 * bfhi(bq[w]) + w2 * bfhi(cq[w]));
            *(u32x4*)(yatt + t * 512 + c8 * 8) = o; }
    }
    SEAM(3);
    if (IN(4)) {
        pg8::StaticOrder S; S.init(T, D, G, bid);
        { pg8::Gemm g{(const bf16*)(ws + WS_YRNN), (const bf16*)(ws + WS_WPRT), 1024};
          pg8::EpiProjRnn E{(const bf16*)(ws + WS_PROJ), p.out};
          pg8::gemm_phase<pg8::EpiProjRnn, pg8::StaticOrder, true>(lds, g, S, E); }
        asm volatile("s_waitcnt vmcnt(0)" ::: "memory"); __syncthreads();
        { pg8::Gemm g{(const bf16*)(ws + WS_YATT), (const bf16*)(ws + WS_WPAT), 512};
          pg8::EpiProjAtt E{(const bf16*)(ws + WS_PROJ), p.out, (bf16*)(ws + WS_MERGED)};
          pg8::gemm_phase<pg8::EpiProjAtt, pg8::StaticOrder, true>(lds, g, S, E); }
    }
    SEAM(4);
    if (IN(5)) {
        pg8::Gemm g{(const bf16*)(ws + WS_MERGED), (const bf16*)(ws + WS_WOT), 1024}; pg8::StaticOrder S; S.init(T, D, G, bid);
        pg8::EpiF32Res E{p.in[0], (float*)(ws + WS_PRELN), D, ALPHA};
        pg8::gemm_phase<pg8::EpiF32Res, pg8::StaticOrder, true>(lds, g, S, E);
    }
    SEAM(5);
    if (IN(6)) {
        const float* preln = (const float*)(ws + WS_PRELN); bf16* x1b = (bf16*)(ws + WS_X1B);
        for (int row = gw; row < T; row += NGW) {
            const f32x4* xr = (const f32x4*)(preln + (size_t)row * D) + lane; f32x4 v[4]; float s = 0.f;
#pragma unroll
            for (int j = 0; j < 4; ++j) { v[j] = xr[64 * j]; s += (v[j][0] + v[j][1]) + (v[j][2] + v[j][3]); }
            const float mean = wave_sum(s) * (1.f / D); float s2 = 0.f;
#pragma unroll
            for (int j = 0; j < 4; ++j) { v[j] = v[j] - mean; s2 += (v[j][0] * v[j][0] + v[j][1] * v[j][1]) + (v[j][2] * v[j][2] + v[j][3] * v[j][3]); }
            const float rstd = 1.f / sqrtf(wave_sum(s2) * (1.f / D) + LN_EPS);
#pragma unroll
            for (int j = 0; j < 4; ++j) { const f32x4 gm = ((const f32x4*)p.in[14])[lane + 64 * j], bt = ((const f32x4*)p.in[15])[lane + 64 * j];
                const f32x4 o = v[j] * rstd * gm + bt;
                ((f32x4*)(p.out + (size_t)row * D))[lane + 64 * j] = o;
                u32x2 w; w.x = pk2(o[0], o[1]); w.y = pk2(o[2], o[3]); ((u32x2*)(x1b + (size_t)row * D))[lane + 64 * j] = w; }
        }
        __syncthreads();
        LAS float* tile = (LAS float*)lds;
        for (int it = bid; it < 257 * 48; it += G) {
            const int e = it / 48, r = it % 48;
            if (r < 32) { const int up = r >> 4, q = r & 15, kb = q >> 1, nbk = q & 1;
                const float* W = (e < NE) ? p.in[up ? 19 : 18] + (size_t)e * 1024 * 256 : p.in[up ? 22 : 21];
                tr128(W + (size_t)kb * 128 * 256 + nbk * 128, 256, (bf16*)(ws + WS_WGU) + ((size_t)e * 512 + nbk * 256 + up * 128) * 1024 + kb * 128, 1024, tile, tid);
            } else { const int q = r - 32, kb = q >> 3, nb = q & 7;
                const float* W = (e < NE) ? p.in[20] + (size_t)e * 256 * 1024 : p.in[23];
                tr128(W + (size_t)kb * 128 * 1024 + nb * 128, 1024, (bf16*)(ws + WS_WD) + ((size_t)e * 1024 + nb * 128) * 256 + kb * 128, 256, tile, tid); }
        }
    }
    SEAM(6);
    if (IN(7)) {
        pg8::Gemm g{(const bf16*)(ws + WS_X1B), (const bf16*)(ws + WS_WRT), 1024}; pg8::StaticOrder S; S.init(T, NE, G, bid);
        pg8::EpiF32Res E{nullptr, (float*)(ws + WS_LOGITS), NE, 0.f};
        pg8::gemm_phase<pg8::EpiF32Res, pg8::StaticOrder, true>(lds, g, S, E);
    }
    SEAM(7);
    if (IN(8)) {
        const float* logits = (const float*)(ws + WS_LOGITS); unsigned* cnt = (unsigned*)(ws + WS_CTL) + CW_CNT;
        int* eidx = (int*)(ws + WS_EIDX); float* gatew = (float*)(ws + WS_GATEW); int* rank = (int*)(ws + WS_RANK);
        const f32x4 rb = ((const f32x4*)p.in[17])[lane];
        for (int t = gw; t < T; t += NGW) {
            const f32x4 z = ((const f32x4*)(logits + (size_t)t * NE))[lane];
            float sc[4], sel[4];
#pragma unroll
            for (int j = 0; j < 4; ++j) { sc[j] = 1.0f / (1.0f + expf(-z[j])); sel[j] = sc[j] + rb[j]; }
            float m1 = fmaxf(sel[0], sel[1]), m2 = fminf(sel[0], sel[1]);
#pragma unroll
            for (int j = 2; j < 4; ++j) { const float v = sel[j]; m2 = fmaxf(m2, fminf(m1, v)); m1 = fmaxf(m1, v); }
#pragma unroll
            for (int o = 1; o < 8; o <<= 1) { const float o1 = __shfl_xor(m1, o), o2 = __shfl_xor(m2, o); m2 = fmaxf(fminf(m1, o1), fmaxf(m2, o2)); m1 = fmaxf(m1, o1); }
            const float gs = m1 + m2; const int mygrp = lane >> 3; int rk = 0;
#pragma unroll
            for (int g2 = 0; g2 < 8; ++g2) { const float og = __shfl(gs, g2 * 8); rk += (og > gs || (og == gs && g2 < mygrp)) ? 1 : 0; }
            if (rk >= 4) {
#pragma unroll
                for (int j = 0; j < 4; ++j) sel[j] = -INFINITY;
            }
            int ek[8]; float gk[8]; float gsum = 0.f;
#pragma unroll
            for (int k = 0; k < 8; ++k) {
                float bv = sel[0]; int bi = 0;
#pragma unroll
                for (int j = 1; j < 4; ++j) if (sel[j] > bv) { bv = sel[j]; bi = j; }
                bi += 4 * lane;
#pragma unroll
                for (int o = 1; o < 64; o <<= 1) { const float ov = __shfl_xor(bv, o); const int oi = __shfl_xor(bi, o); if (ov > bv || (ov == bv && oi < bi)) { bv = ov; bi = oi; } }
                const int own = bi >> 2, jj = bi & 3;
                const float mysc = jj == 0 ? sc[0] : (jj == 1 ? sc[1] : (jj == 2 ? sc[2] : sc[3]));
                const float wsc = __shfl(mysc, own);
                if (lane == own) {
#pragma unroll
                    for (int j = 0; j < 4; ++j) if (j == jj) sel[j] = -INFINITY;
                }
                ek[k] = bi; gk[k] = wsc; gsum += wsc;
            }
            int me = 0; float mg = 0.f;
#pragma unroll
            for (int k = 0; k < 8; ++k) if (lane == k) { me = ek[k]; mg = gk[k]; }
            if (lane < 8) { const int rr = (int)atomicAdd(&cnt[me], 1u);
                eidx[(size_t)t * 8 + lane] = me; gatew[(size_t)t * 8 + lane] = mg / gsum * 2.5f; rank[(size_t)t * 8 + lane] = rr; }
        }
    }
    SEAM(8);
    if (IN(9)) {
        build_tile_table(p, lds, tid);
        const LAS int* tbase = (const LAS int*)(lds + L_TBASE);
        const unsigned* cnt = (const unsigned*)(ws + WS_CTL) + CW_CNT;
        const int* eidx = (const int*)(ws + WS_EIDX); const float* gatew = (const float*)(ws + WS_GATEW); const int* rank = (const int*)(ws + WS_RANK);
        int* slotof = (int*)(ws + WS_SLOTOF); int* tokslot = (int*)(ws + WS_TOKSLOT); float* wslot = (float*)(ws + WS_WSLOT);
        for (size_t i = gtid; i < (size_t)T * 8; i += NTH) { const int e = eidx[i]; const int slot = tbase[e] * 256 + rank[i]; tokslot[slot] = (int)(i >> 3); wslot[slot] = gatew[i]; slotof[i] = slot; }
        for (size_t i = gtid; i < (size_t)NE * 256; i += NTH) { const int e = (int)(i >> 8), j = (int)(i & 255); const int s = (int)cnt[e] + j; if (s < (tbase[e + 1] - tbase[e]) * 256) { tokslot[tbase[e] * 256 + s] = 0; wslot[tbase[e] * 256 + s] = 0.f; } }
        const int sb = tbase[NE] * 256;
        for (size_t i = gtid; i < (size_t)T; i += NTH) { tokslot[sb + i] = (int)i; }
    }
    SEAM(9);
    if (IN(10)) {
        build_tile_table(p, lds, tid);
        const LAS int* tbase = (const LAS int*)(lds + L_TBASE);
        pg8::GroupOrder<true> S; S.nN = 2; S.nwg = tbase[NE + 1] * 2; S.G = G; S.c = bid; S.tile_e = (const LAS unsigned short*)(lds + L_TILEE); S.tok = (const int*)(ws + WS_TOKSLOT); S.rowbytes = 2048u;
        pg8::Gemm g{(const bf16*)(ws + WS_X1B), (const bf16*)(ws + WS_WGU), 1024};
        pg8::EpiGateUp E{(bf16*)(ws + WS_H)};
        pg8::gemm_phase<pg8::EpiGateUp, pg8::GroupOrder<true>, true>(lds, g, S, E);
    }
    SEAM(10);
    if (IN(11)) {
        build_tile_table(p, lds, tid);
        const LAS int* tbase = (const LAS int*)(lds + L_TBASE);
        pg8::GroupOrder<false> S; S.nN = 4; S.nwg = tbase[NE + 1] * 4; S.G = G; S.c = bid; S.tile_e = (const LAS unsigned short*)(lds + L_TILEE); S.tok = nullptr; S.rowbytes = 0u;
        pg8::Gemm g{(const bf16*)(ws + WS_H), (const bf16*)(ws + WS_WD), 256};
        pg8::EpiDown E{(bf16*)(ws + WS_Y), (const float*)(ws + WS_WSLOT), p.out, tbase[NE]};
        pg8::gemm_phase<pg8::EpiDown, pg8::GroupOrder<false>, true>(lds, g, S, E);
    }
    SEAM(11);
    if (IN(12)) {
        const bf16* Y = (const bf16*)(ws + WS_Y); const int* slotof = (const int*)(ws + WS_SLOTOF);
        for (int t = gw; t < T; t += NGW) {
            float* orow = p.out + (size_t)t * D; float v[16];
            { const f32x4 a = *(const f32x4*)(orow + 8 * lane), b = *(const f32x4*)(orow + 8 * lane + 4), c = *(const f32x4*)(orow + 512 + 8 * lane), d = *(const f32x4*)(orow + 512 + 8 * lane + 4);
#pragma unroll
              for (int j = 0; j < 4; ++j) { v[j] = a[j]; v[4 + j] = b[j]; v[8 + j] = c[j]; v[12 + j] = d[j]; } }
            int sl[8];
#pragma unroll
            for (int k = 0; k < 8; ++k) sl[k] = slotof[(size_t)t * 8 + k];
#pragma unroll
            for (int k = 0; k < 8; ++k) { const bf16* yr = Y + (size_t)sl[k] * D; const u32x4 a = *(const u32x4*)(yr + 8 * lane), b = *(const u32x4*)(yr + 512 + 8 * lane);
#pragma unroll
                for (int w = 0; w < 4; ++w) { v[2 * w] += bflo(a[w]); v[2 * w + 1] += bfhi(a[w]); v[8 + 2 * w] += bflo(b[w]); v[8 + 2 * w + 1] += bfhi(b[w]); } }
            float s = 0.f;
#pragma unroll
            for (int j = 0; j < 16; ++j) s += v[j];
            const float mean = wave_sum(s) * (1.f / D); float s2 = 0.f;
#pragma unroll
            for (int j = 0; j < 16; ++j) { v[j] -= mean; s2 += v[j] * v[j]; }
            const float rstd = 1.f / sqrtf(wave_sum(s2) * (1.f / D) + LN_EPS);
            const float* gm = p.in[24]; const float* bt = p.in[25];
#pragma unroll
            for (int q = 0; q < 4; ++q) { const int c0 = (q >> 1) * 512 + 8 * lane + (q & 1) * 4; const f32x4 g4 = *(const f32x4*)(gm + c0), b4 = *(const f32x4*)(bt + c0); f32x4 o;
#pragma unroll
                for (int j = 0; j < 4; ++j) o[j] = v[4 * q + j] * rstd * g4[j] + b4[j];
                *(f32x4*)(orow + c0) = o; }
        }
    }
#undef IN
#undef SEAM
}

extern "C" void kernel_launch(void* const* d_in, const int* in_sizes, int n_in, void* d_out, int out_size, void* d_ws, size_t ws_size, hipStream_t stream) {
    static int grid = 0;
    if (grid == 0) {
        if (n_in != 26 || in_sizes[0] != T * D || out_size != T * D || ws_size < WS_END) { fprintf(stderr, "kernel_launch: unexpected shapes / workspace (%d inputs, ws %zu < %zu)\n", n_in, ws_size, (size_t)WS_END); grid = -1; return; }
        int dev = 0, cus = 0, per_cu = 0;
        if (hipGetDevice(&dev) != hipSuccess || hipDeviceGetAttribute(&cus, hipDeviceAttributeMultiprocessorCount, dev) != hipSuccess) { grid = -1; return; }
        if (hipFuncSetAttribute((const void*)fwd_kernel, hipFuncAttributeMaxDynamicSharedMemorySize, LDS_BYTES) != hipSuccess) { fprintf(stderr, "kernel_launch: hipFuncSetAttribute failed\n"); grid = -1; return; }
        if (hipOccupancyMaxActiveBlocksPerMultiprocessor(&per_cu, (const void*)fwd_kernel, 512, LDS_BYTES) != hipSuccess || per_cu < 1) { fprintf(stderr, "kernel_launch: occupancy query says %d\n", per_cu); }
        (void)hipGetLastError();
        grid = cus;
    }
    if (grid < 0) return;
    (void)hipMemsetAsync((char*)d_ws + WS_CTL, 0, CTL_BYTES, stream);
    Params p{};
    for (int i = 0; i < 26; ++i) p.in[i] = (const float*)d_in[i];
    p.out = (float*)d_out; p.ws = (unsigned char*)d_ws;
    const int dils[3] = {1, 4, 16};
    for (int g = 0; g < 3; ++g) for (int rel = 0; rel <= 128; ++rel) {
        const long dist = (long)rel * dils[g]; long bk;
        if (dist < 16) bk = dist;
        else { const double dd = (double)(dist < 1 ? 1 : dist); long large = 16 + (long)(std::log(dd / 16.0) / std::log(2048.0 / 16.0) * 16.0); bk = large < 31 ? large : 31; }
        p.bucket[g][rel] = (unsigned char)bk;
    }
#if N_LAUNCHES == 1
    p.lo = 0; p.hi = NPHASE;
    hipLaunchKernelGGL(fwd_kernel, dim3(grid), dim3(512), LDS_BYTES, stream, p);
#else
    for (int k = 0; k < NPHASE; ++k) { p.lo = k; p.hi = k + 1; hipLaunchKernelGGL(fwd_kernel, dim3(grid), dim3(512), LDS_BYTES, stream, p); }
#endif
}
```

```cpp
#include <hip/hip_runtime.h>
#include <cstdio>
#include <cstdint>
#include <cmath>

#ifndef N_LAUNCHES
#define N_LAUNCHES 1
#endif

#define GAS __attribute__((address_space(1)))
#define LAS __attribute__((address_space(3)))
typedef unsigned short bf16;
typedef float f32x2 __attribute__((ext_vector_type(2)));
typedef float f32x4 __attribute__((ext_vector_type(4)));
typedef float f32x16 __attribute__((ext_vector_type(16)));
typedef short bf16x8 __attribute__((ext_vector_type(8)));
typedef short bf16x4 __attribute__((ext_vector_type(4)));
typedef unsigned u32x4 __attribute__((ext_vector_type(4)));
typedef unsigned u32x2 __attribute__((ext_vector_type(2)));

constexpr int NB = 8, SEQ = 4096, T = NB * SEQ, D = 1024, DIN = 8704;
constexpr int C_XR = 0, C_GR = 1024, C_Q = 2048, C_K = 3584, C_V = 5120, C_GRNN = 6656, C_GATT = 7680;
constexpr int NE = 256, TOPK = 8, DE = 256;
constexpr int TCH = 128, NCH = SEQ / TCH;
constexpr int MAXT_R = 1280, SH_TILES = T / 256, MAXT = MAXT_R + SH_TILES;
constexpr float ALPHA = 1.18920711500272f, LN_EPS = 1e-5f;
constexpr int NPHASE = 13;

constexpr size_t MiB = 1u << 20;
constexpr size_t WS_CTL = 0, CTL_BYTES = 1 * MiB;
constexpr size_t WS_WINT = 1 * MiB;
constexpr size_t WS_WPRT = 18 * MiB;
constexpr size_t WS_WPAT = 20 * MiB;
constexpr size_t WS_WOT = 21 * MiB;
constexpr size_t WS_WRT = 23 * MiB;
constexpr size_t WS_EIDX = 24 * MiB, WS_GATEW = 25 * MiB, WS_RANK = 26 * MiB, WS_SLOTOF = 27 * MiB, WS_TOKSLOT = 28 * MiB, WS_WSLOT = 30 * MiB;
constexpr size_t WS_XB = 32 * MiB;
constexpr size_t WS_YRNN = 32 * MiB;
constexpr size_t WS_HLOC = 96 * MiB;
constexpr size_t WS_MERGED = 96 * MiB;
constexpr size_t WS_CUMA = 160 * MiB;
constexpr size_t WS_AO = 224 * MiB;
constexpr size_t WS_YATT = 320 * MiB;
constexpr size_t WS_SUMA = 352 * MiB, WS_SUMH = 353 * MiB;
constexpr size_t WS_LSE = 354 * MiB;
constexpr size_t WS_PROJ = 360 * MiB;
constexpr size_t WS_PRELN = 700 * MiB;
constexpr size_t WS_WD = 32 * MiB;
constexpr size_t WS_H = 161 * MiB;
constexpr size_t WS_Y = 337 * MiB;
constexpr size_t WS_X1B = 337 * MiB;
constexpr size_t WS_WGU = 401 * MiB;
constexpr size_t WS_LOGITS = 658 * MiB;
constexpr size_t WS_END = 977 * MiB;
constexpr int CW_BAR = 4096, CW_CNT = 16384;

constexpr int RING_BYTES = 131072;
constexpr int L_TBASE = RING_BYTES;
constexpr int L_TILEE = L_TBASE + 1040;
constexpr int L_BTAB = L_TILEE + 2816;
constexpr int L_MISC = L_BTAB + 12672;
constexpr int LDS_BYTES = 151552;
static_assert(L_MISC + 64 <= LDS_BYTES, "LDS map");

__device__ __forceinline__ unsigned f2bf(float f) { unsigned u = __builtin_bit_cast(unsigned, f); return (u + 0x7fffu + ((u >> 16) & 1u)) >> 16; }
__device__ __forceinline__ unsigned pk2(float lo, float hi) { return f2bf(lo) | (f2bf(hi) << 16); }
__device__ __forceinline__ float bflo(unsigned w) { return __builtin_bit_cast(float, w << 16); }
__device__ __forceinline__ float bfhi(unsigned w) { return __builtin_bit_cast(float, w & 0xffff0000u); }
__device__ __forceinline__ float bf1(bf16 h) { return __builtin_bit_cast(float, (unsigned)h << 16); }
__device__ __forceinline__ float sigmoidf_(float x) { return 1.0f / (1.0f + __expf(-x)); }
__device__ __forceinline__ float gelu_tanh(float x) { const float z = 1.5957691216057308f * (x + 0.044715f * x * x * x); return x / (1.0f + __expf(-z)); }
__device__ __forceinline__ float wave_sum(float v) {
#pragma unroll
    for (int o = 1; o < 64; o <<= 1) v += __shfl_xor(v, o);
    return v;
}

namespace pg8 {
#define PG8_LAS __attribute__((address_space(3)))
typedef unsigned short bf16_t;
constexpr int BM = 256, BK = 64, HALF = 128, HTB = HALF * BK * 2, STAGE_BYTES = 8 * HTB, NXCD = 8, WGM = 8;
__host__ __device__ __forceinline__ int lds_byte(int r, int c) { const int st = (r >> 4) * 2 + (c >> 5), rr = r & 15, cc = c & 31, ob = rr * 64 + cc * 2; return st * 1024 + (ob ^ (((ob >> 9) & 1) << 5)); }
__host__ __device__ __forceinline__ void stage_rc(int b, int& R, int& C) { const int st = b / 1024, sb = b % 1024, swz = sb ^ (((sb >> 9) & 1) << 5); R = (st >> 1) * 16 + swz / 64; C = (st & 1) * 32 + (swz % 64) / 2; }
__host__ __device__ __forceinline__ int perm32(int rho) { const int n = rho >> 4, i = rho & 15; return 8 * (i >> 2) + 4 * n + (i & 3); }

struct Unit { int pm, pn, pb; };
struct Gemm { const bf16_t* A; const bf16_t* Bt; int K; };

struct StaticOrder {
    static constexpr bool GATHER = false;
    int nM, nN, nwg, G, c;
    __device__ void init(int M, int N, int G_, int c_) { nM = M / BM; nN = N / BM; nwg = nM * nN; G = G_; c = c_; }
    __device__ bool next(int i, Unit& u) const {
        const long L = (long)i * G + c; if (L >= nwg) return false;
        int wgid = (int)L; { const int q = nwg / NXCD, r = nwg % NXCD, xcd = wgid % NXCD, off = wgid / NXCD; wgid = (xcd < r ? xcd * (q + 1) : r * (q + 1) + (xcd - r) * q) + off; }
        const int nig = WGM * nN, gid = wgid / nig, fm = gid * WGM, gsz = (nM - fm) < WGM ? (nM - fm) : WGM;
        u.pm = fm + ((wgid % nig) % gsz); u.pn = (wgid % nig) / gsz; u.pb = u.pn; return true;
    }
    __device__ __forceinline__ unsigned arow(int) const { return 0u; }
};
template <bool GATHER_> struct GroupOrder {
    static constexpr bool GATHER = GATHER_;
    int nN, nwg, G, c; const LAS unsigned short* tile_e; const int* tok; unsigned rowbytes;
    __device__ bool next(int i, Unit& u) const {
        const long L = (long)i * G + c; if (L >= nwg) return false;
        u.pm = (int)L / nN; u.pn = (int)L % nN; u.pb = (int)tile_e[u.pm] * nN + u.pn; return true;
    }
    __device__ __forceinline__ unsigned arow(int slot) const { return (unsigned)tok[slot] * rowbytes; }
};

__device__ __forceinline__ unsigned cvt_pk_bf16(float lo, float hi) { unsigned r; asm volatile("v_cvt_pk_bf16_f32 %0, %1, %2" : "=v"(r) : "v"(lo), "v"(hi)); return r; }

template <class Epi, class Sched, bool ALIGN_EPI = false>
__device__ __forceinline__ void gemm_phase(PG8_LAS unsigned char* lds, const Gemm g, const Sched& S, const Epi& E) {
    constexpr bool GA = Sched::GATHER;
    const int tid = threadIdx.x, wid = __builtin_amdgcn_readfirstlane(tid >> 6), lane = tid & 63, wr = wid >> 2, wc = wid & 3, fr = lane & 15, fq = lane >> 4;
    const int K = g.K, nt = K / BK;
    unsigned voffA[2], voffA1[2], voffB[2]; int RA[2], CA2[2];
#pragma unroll
    for (int i = 0; i < 2; ++i) { int R, C; stage_rc(tid * 16 + i * 8192, R, C); const int Rb = Epi::PERM ? ((R & ~31) + perm32(R & 31)) : R;
        RA[i] = R; CA2[i] = C * 2;
        voffA[i] = (unsigned)(R * K + C) * 2u; voffA1[i] = voffA[i]; voffB[i] = (unsigned)(Rb * K + C) * 2u; }
    const size_t kstep = (size_t)(BK * 2);
    const size_t hstep = (size_t)HALF * K * 2;
    const size_t tstep = 2 * hstep;
    const size_t hstepA = GA ? 0 : hstep;
    const unsigned ldsw = (unsigned)wid * 1024u;
    const int aoff = lds_byte(wr * 64 + fr, fq * 8), boff = lds_byte(wc * 32 + fr, fq * 8);
#define PG8_SA(b, h) (((b) * 2 + (h)) * HTB)
#define PG8_SB(b, h) ((4 + (b) * 2 + (h)) * HTB)
#define PG8_STAGE(bufoff, gbase, voff) do { _Pragma("unroll") for (int _i = 0; _i < 2; ++_i) \
        __builtin_amdgcn_global_load_lds((const unsigned*)((const char*)(gbase) + (voff)[_i]), (PG8_LAS unsigned*)(lds + (bufoff) + ldsw + _i * 8192), 16, 0, 0); } while (0)
#define PG8_LDA(dst, b, h) do { _Pragma("unroll") for (int m = 0; m < 4; ++m) _Pragma("unroll") for (int k = 0; k < 2; ++k) dst[m][k] = *(const PG8_LAS bf16x8*)(lds + PG8_SA(b, h) + aoff + m * 2048 + k * 1024); } while (0)
#define PG8_LDB(dst, b, h) do { _Pragma("unroll") for (int n = 0; n < 2; ++n) _Pragma("unroll") for (int k = 0; k < 2; ++k) dst[n][k] = *(const PG8_LAS bf16x8*)(lds + PG8_SB(b, h) + boff + n * 2048 + k * 1024); } while (0)
#define PG8_MMA(ai, bj, At, Bt) do { __builtin_amdgcn_s_setprio(1); _Pragma("unroll") for (int m = 0; m < 4; ++m) _Pragma("unroll") for (int n = 0; n < 2; ++n) _Pragma("unroll") for (int k = 0; k < 2; ++k) \
        acc[ai][bj][m][n] = __builtin_amdgcn_mfma_f32_16x16x32_bf16(Bt[n][k], At[m][k], acc[ai][bj][m][n], 0, 0, 0); __builtin_amdgcn_s_setprio(0); } while (0)
#define PG8_WAIT_V(n) asm volatile("s_waitcnt vmcnt(" #n ")" ::: "memory")
#define PG8_WAIT_L(n) asm volatile("s_waitcnt lgkmcnt(" #n ")" ::: "memory")
#define PG8_BAR __builtin_amdgcn_s_barrier()
#define PG8_SCHED __builtin_amdgcn_sched_barrier(0)
    Unit cur, nxt; int ui = 0;
    if (!S.next(0, cur)) return;
    f32x4 acc[2][2][4][2];
#pragma unroll
    for (int a = 0; a < 2; ++a)
#pragma unroll
        for (int b = 0; b < 2; ++b)
#pragma unroll
            for (int m = 0; m < 4; ++m)
#pragma unroll
                for (int n = 0; n < 2; ++n) acc[a][b][m][n] = (f32x4){0.f, 0.f, 0.f, 0.f};
    bf16x8 At[4][2], B0[2][2], B1[2][2];
    const char* cA = GA ? (const char*)g.A : (const char*)g.A + (size_t)cur.pm * tstep; const char* cB = (const char*)g.Bt + (size_t)cur.pb * tstep;
    if constexpr (GA) {
#pragma unroll
        for (int i = 0; i < 2; ++i) { voffA[i] = S.arow(cur.pm * BM + RA[i]) + (unsigned)CA2[i]; voffA1[i] = S.arow(cur.pm * BM + HALF + RA[i]) + (unsigned)CA2[i]; }
    }
    PG8_STAGE(PG8_SB(0, 0), cB, voffB); PG8_STAGE(PG8_SB(0, 1), cB + hstep, voffB); PG8_STAGE(PG8_SA(0, 0), cA, voffA); PG8_STAGE(PG8_SA(0, 1), cA + hstepA, voffA1);
    if (wr == 1) PG8_BAR;
    PG8_WAIT_V(2); PG8_BAR;
    PG8_STAGE(PG8_SB(1, 0), cB + kstep, voffB); PG8_STAGE(PG8_SA(1, 0), cA + kstep, voffA); PG8_STAGE(PG8_SB(1, 1), cB + hstep + kstep, voffB);
    PG8_WAIT_V(6); PG8_BAR;
    for (;;) {
        const bool has_next = S.next(ui + 1, nxt);
        const char* nA = GA ? (const char*)g.A : (has_next ? (const char*)g.A + (size_t)nxt.pm * tstep : cA);
        const char* nB = has_next ? (const char*)g.Bt + (size_t)nxt.pb * tstep : cB;
        for (int t = 0; t < nt; t += 2) {
            const bool last = (t == nt - 2);
            const char* a1 = cA + (size_t)(t + 1) * kstep;
            const char* a2 = last ? nA : cA + (size_t)(t + 2) * kstep; const char* b2 = last ? nB : cB + (size_t)(t + 2) * kstep;
            const char* a3 = a2 + kstep; const char* b3 = b2 + kstep;
            unsigned nvA[2], nvA1[2];
            if constexpr (GA) {
                if (last && has_next) {
#pragma unroll
                    for (int i = 0; i < 2; ++i) { nvA[i] = S.arow(nxt.pm * BM + RA[i]) + (unsigned)CA2[i]; nvA1[i] = S.arow(nxt.pm * BM + HALF + RA[i]) + (unsigned)CA2[i]; }
                } else {
#pragma unroll
                    for (int i = 0; i < 2; ++i) { nvA[i] = voffA[i]; nvA1[i] = voffA1[i]; }
                }
            }
            PG8_LDB(B0, 0, 0); PG8_LDB(B1, 0, 1); PG8_SCHED; PG8_LDA(At, 0, 0); PG8_STAGE(PG8_SA(1, 1), a1 + hstepA, voffA1);
            if constexpr (GA) {
#pragma unroll
                for (int i = 0; i < 2; ++i) { voffA[i] = nvA[i]; voffA1[i] = nvA1[i]; }
            }
            PG8_WAIT_V(8); PG8_WAIT_L(0); PG8_BAR; PG8_MMA(0, 0, At, B0); PG8_MMA(0, 1, At, B1); PG8_BAR; PG8_SCHED;
            PG8_LDA(At, 0, 1); PG8_STAGE(PG8_SB(0, 0), b2, voffB); PG8_STAGE(PG8_SB(0, 1), b2 + hstep, voffB); PG8_STAGE(PG8_SA(0, 0), a2, voffA);
            PG8_WAIT_V(8); PG8_WAIT_L(0); PG8_BAR; PG8_MMA(1, 0, At, B0); PG8_MMA(1, 1, At, B1); PG8_BAR; PG8_SCHED;
            PG8_LDB(B0, 1, 0); PG8_LDB(B1, 1, 1); PG8_SCHED; PG8_LDA(At, 1, 0); PG8_STAGE(PG8_SA(0, 1), a2 + hstepA, voffA1);
            PG8_WAIT_V(8); PG8_WAIT_L(0); PG8_BAR; PG8_MMA(0, 0, At, B0); PG8_MMA(0, 1, At, B1); PG8_BAR; PG8_SCHED;
            PG8_LDA(At, 1, 1); PG8_STAGE(PG8_SB(1, 0), b3, voffB); PG8_STAGE(PG8_SB(1, 1), b3 + hstep, voffB); PG8_STAGE(PG8_SA(1, 0), a3, voffA);
            PG8_WAIT_V(8); PG8_WAIT_L(0); PG8_BAR; PG8_MMA(1, 0, At, B0); PG8_MMA(1, 1, At, B1); PG8_BAR; PG8_SCHED;
        }
        if constexpr (ALIGN_EPI) { if (wr == 0) PG8_BAR; }
        E(acc, cur, wr, wc, fr, fq);
        if (!has_next) break;
#pragma unroll
        for (int a = 0; a < 2; ++a)
#pragma unroll
            for (int b = 0; b < 2; ++b)
#pragma unroll
                for (int m = 0; m < 4; ++m)
#pragma unroll
                    for (int n = 0; n < 2; ++n) acc[a][b][m][n] = (f32x4){0.f, 0.f, 0.f, 0.f};
        cur = nxt; cA = nA; cB = nB; ++ui;
        if constexpr (ALIGN_EPI) { if (wr == 1) PG8_BAR; }
    }
    PG8_WAIT_V(0);
    if constexpr (!ALIGN_EPI) { if (wr == 0) PG8_BAR; }
    PG8_BAR;
#undef PG8_SA
#undef PG8_SB
#undef PG8_STAGE
#undef PG8_LDA
#undef PG8_LDB
#undef PG8_MMA
#undef PG8_WAIT_V
#undef PG8_WAIT_L
#undef PG8_BAR
#undef PG8_SCHED
}

typedef const f32x4 (&AccRef)[2][2][4][2];

struct EpiInProj {
    static constexpr bool PERM = true;
    bf16_t* O; const float* bias;
    __device__ __forceinline__ void operator()(AccRef acc, const Unit& u, int wr, int wc, int fr, int fq) const {
        const int row0 = u.pm * BM + wr * 64 + fr, col0 = u.pn * BM + wc * 32 + 8 * fq;
        const int kind = u.pn < 4 ? 0 : (u.pn < 8 ? 1 : (u.pn < 14 ? 2 : (u.pn < 26 ? 0 : 3)));
        f32x4 bv[2][2];
#pragma unroll
        for (int bj = 0; bj < 2; ++bj)
#pragma unroll
            for (int n = 0; n < 2; ++n) bv[bj][n] = *(const f32x4*)(bias + col0 + bj * HALF + 4 * n);
#pragma unroll
        for (int ai = 0; ai < 2; ++ai)
#pragma unroll
            for (int m = 0; m < 4; ++m) { bf16_t* rowp = O + (size_t)(row0 + ai * HALF + m * 16) * DIN + col0;
#pragma unroll
                for (int bj = 0; bj < 2; ++bj) { f32x4 v0 = acc[ai][bj][m][0] + bv[bj][0], v1 = acc[ai][bj][m][1] + bv[bj][1];
                    if (kind == 1) {
#pragma unroll
                        for (int j = 0; j < 4; ++j) { v0[j] = gelu_tanh(v0[j]); v1[j] = gelu_tanh(v1[j]); }
                    } else if (kind == 2) { v0 = v0 * 0.125f; v1 = v1 * 0.125f; }
                    else if (kind == 3) {
#pragma unroll
                        for (int j = 0; j < 4; ++j) { v0[j] = sigmoidf_(v0[j]); v1[j] = sigmoidf_(v1[j]); }
                    }
                    u32x4 w; w.x = cvt_pk_bf16(v0[0], v0[1]); w.y = cvt_pk_bf16(v0[2], v0[3]); w.z = cvt_pk_bf16(v1[0], v1[1]); w.w = cvt_pk_bf16(v1[2], v1[3]);
                    *(u32x4*)(rowp + bj * HALF) = w; } }
    }
};
struct EpiProjRnn {
    static constexpr bool PERM = false;
    const bf16_t* proj; float* part;
    __device__ __forceinline__ void operator()(AccRef acc, const Unit& u, int wr, int wc, int fr, int fq) const {
        const int row0 = u.pm * BM + wr * 64 + fr, col0 = u.pn * BM + wc * 32 + 4 * fq;
#pragma unroll
        for (int ai = 0; ai < 2; ++ai)
#pragma unroll
            for (int m = 0; m < 4; ++m) { const size_t row = (size_t)(row0 + ai * HALF + m * 16);
#pragma unroll
                for (int bj = 0; bj < 2; ++bj)
#pragma unroll
                    for (int n = 0; n < 2; ++n) { const int c = col0 + bj * HALF + n * 16;
                        const u32x2 gw = *(const u32x2*)(proj + row * DIN + C_GRNN + c);
                        const f32x4 gt = (f32x4){bflo(gw.x), bfhi(gw.x), bflo(gw.y), bfhi(gw.y)};
                        *(f32x4*)(part + row * D + c) = gt * acc[ai][bj][m][n]; } }
    }
};
struct EpiProjAtt {
    static constexpr bool PERM = false;
    const bf16_t* proj; const float* part; bf16_t* merged;
    __device__ __forceinline__ void operator()(AccRef acc, const Unit& u, int wr, int wc, int fr, int fq) const {
        const int row0 = u.pm * BM + wr * 64 + fr, col0 = u.pn * BM + wc * 32 + 4 * fq;
#pragma unroll
        for (int ai = 0; ai < 2; ++ai)
#pragma unroll
            for (int m = 0; m < 4; ++m) { const size_t row = (size_t)(row0 + ai * HALF + m * 16);
#pragma unroll
                for (int bj = 0; bj < 2; ++bj)
#pragma unroll
                    for (int n = 0; n < 2; ++n) { const int c = col0 + bj * HALF + n * 16;
                        const u32x2 gw = *(const u32x2*)(proj + row * DIN + C_GATT + c);
                        const f32x4 gt = (f32x4){bflo(gw.x), bfhi(gw.x), bflo(gw.y), bfhi(gw.y)};
                        const f32x4 v = *(const f32x4*)(part + row * D + c) + gt * acc[ai][bj][m][n];
                        u32x2 w; w.x = cvt_pk_bf16(v[0], v[1]); w.y = cvt_pk_bf16(v[2], v[3]);
                        *(u32x2*)(merged + row * D + c) = w; } }
    }
};
struct EpiF32Res {
    static constexpr bool PERM = false;
    const float* base; float* out; int ldc; float scale;
    __device__ __forceinline__ void operator()(AccRef acc, const Unit& u, int wr, int wc, int fr, int fq) const {
        const int row0 = u.pm * BM + wr * 64 + fr, col0 = u.pn * BM + wc * 32 + 4 * fq;
#pragma unroll
        for (int ai = 0; ai < 2; ++ai)
#pragma unroll
            for (int m = 0; m < 4; ++m) { const size_t off = (size_t)(row0 + ai * HALF + m * 16) * ldc + col0;
#pragma unroll
                for (int bj = 0; bj < 2; ++bj)
#pragma unroll
                    for (int n = 0; n < 2; ++n) { f32x4 v = acc[ai][bj][m][n];
                        if (base) v = v + *(const f32x4*)(base + off + bj * HALF + n * 16) * scale;
                        *(f32x4*)(out + off + bj * HALF + n * 16) = v; } }
    }
};
struct EpiGateUp {
    static constexpr bool PERM = true;
    bf16_t* H;
    __device__ __forceinline__ void operator()(AccRef acc, const Unit& u, int wr, int wc, int fr, int fq) const {
        const int row0 = u.pm * BM + wr * 64 + fr, col0 = u.pn * HALF + wc * 32 + 8 * fq;
#pragma unroll
        for (int ai = 0; ai < 2; ++ai)
#pragma unroll
            for (int m = 0; m < 4; ++m) { bf16_t* rowp = H + (size_t)(row0 + ai * HALF + m * 16) * DE + col0;
                f32x4 o[2];
#pragma unroll
                for (int n = 0; n < 2; ++n) { const f32x4 gt = acc[ai][0][m][n], up = acc[ai][1][m][n];
#pragma unroll
                    for (int j = 0; j < 4; ++j) o[n][j] = gt[j] / (1.0f + __expf(-gt[j])) * up[j]; }
                u32x4 w; w.x = cvt_pk_bf16(o[0][0], o[0][1]); w.y = cvt_pk_bf16(o[0][2], o[0][3]); w.z = cvt_pk_bf16(o[1][0], o[1][1]); w.w = cvt_pk_bf16(o[1][2], o[1][3]);
                *(u32x4*)rowp = w; }
    }
};
struct EpiDown {
    static constexpr bool PERM = true;
    bf16_t* Y; const float* wslot; float* out; int mt_r;
    __device__ __forceinline__ void operator()(AccRef acc, const Unit& u, int wr, int wc, int fr, int fq) const {
        const int col0 = u.pn * BM + wc * 32 + 8 * fq;
        if (u.pm < mt_r) {
            const int row0 = u.pm * BM + wr * 64 + fr;
#pragma unroll
            for (int ai = 0; ai < 2; ++ai)
#pragma unroll
                for (int m = 0; m < 4; ++m) { const size_t row = (size_t)(row0 + ai * HALF + m * 16); const float w8 = wslot[row]; bf16_t* rowp = Y + row * D + col0;
#pragma unroll
                    for (int bj = 0; bj < 2; ++bj) { const f32x4 v0 = acc[ai][bj][m][0] * w8, v1 = acc[ai][bj][m][1] * w8;
                        u32x4 w; w.x = cvt_pk_bf16(v0[0], v0[1]); w.y = cvt_pk_bf16(v0[2], v0[3]); w.z = cvt_pk_bf16(v1[0], v1[1]); w.w = cvt_pk_bf16(v1[2], v1[3]);
                        *(u32x4*)(rowp + bj * HALF) = w; } }
        } else {
            const int row0 = (u.pm - mt_r) * BM + wr * 64 + fr;
#pragma unroll
            for (int ai = 0; ai < 2; ++ai)
#pragma unroll
                for (int m = 0; m < 4; ++m) { float* rowp = out + (size_t)(row0 + ai * HALF + m * 16) * D + col0;
#pragma unroll
                    for (int bj = 0; bj < 2; ++bj)
#pragma unroll
                        for (int n = 0; n < 2; ++n) { float* p = rowp + bj * HALF + 4 * n; *(f32x4*)p = *(const f32x4*)p * ALPHA + acc[ai][bj][m][n]; } }
        }
    }
};
}

#define XB_TMO      128
#define XB_XCNT(j)  (256  + 64 * (j))
#define XB_XSUB(j)  (1280 + 64 * (j))
#define XB_XGEN(j)  (2304 + 64 * (j))
#define XB_TOP      3328
#define XB_TOPGEN   3392
#define XCD_BAR_WORDS 3456
#define XB_SPIN_CAP (1u << 18)
__device__ __forceinline__ unsigned xb_ld(unsigned* p)              { return __hip_atomic_load(p, __ATOMIC_RELAXED, __HIP_MEMORY_SCOPE_AGENT); }
__device__ __forceinline__ unsigned xb_add(unsigned* p, unsigned v) { return __hip_atomic_fetch_add(p, v, __ATOMIC_RELAXED, __HIP_MEMORY_SCOPE_AGENT); }
__device__ __forceinline__ unsigned xb_xcc_id() { return (unsigned)__builtin_amdgcn_s_getreg((3 << 11) | 20) & 0xFu; }
#define XB_SPIN(cond, bar) do { unsigned _sp = 0; while (cond) { __builtin_amdgcn_s_sleep(1); \
    if ((++_sp & 255u) == 0u) { if (xb_ld(&(bar)[XB_TMO])) break; if (_sp > XB_SPIN_CAP) { atomicAdd(&(bar)[XB_TMO], 1u); break; } } } } while (0)
struct XcdBarrier { unsigned* bar; unsigned x; volatile LAS unsigned* st; };
__device__ __forceinline__ XcdBarrier xcd_barrier_post(unsigned* bar, volatile LAS unsigned* st) {
    XcdBarrier b; b.bar = bar; b.x = xb_xcc_id(); b.st = st;
    if (threadIdx.x == 0) (void)xb_add(&bar[XB_XCNT(b.x)], 1u);
    return b;
}
__device__ __forceinline__ void xcd_barrier_complete(unsigned* bar, unsigned x, unsigned& nloc, unsigned& nx) {
    const unsigned G = gridDim.x * gridDim.y * gridDim.z;
    unsigned sum, cnt, mine, sp = 0u;
    for (;;) {
        sum = 0u; cnt = 0u; mine = 0u;
#pragma unroll
        for (unsigned j = 0; j < 16; ++j) { const unsigned c = xb_ld(&bar[XB_XCNT(j)]); sum += c; cnt += (c > 0u) ? 1u : 0u; mine = (j == x) ? c : mine; }
        if (sum == G) break;
        __builtin_amdgcn_s_sleep(1);
        if ((++sp & 255u) == 0u) { if (xb_ld(&bar[XB_TMO])) break; if (sp > XB_SPIN_CAP) { atomicAdd(&bar[XB_TMO], 1u); break; } }
    }
    nloc = mine > 0u ? mine : 1u; nx = cnt > 0u ? cnt : 1u;
}
__device__ __forceinline__ void xcd_barrier(const XcdBarrier& b) {
    asm volatile("s_waitcnt vmcnt(0)" ::: "memory");
    __syncthreads();
    if (threadIdx.x == 0) {
        unsigned* bar = b.bar;
        __builtin_amdgcn_s_waitcnt(0);
        unsigned nloc = b.st[0], nx = b.st[1];
        if (nloc == 0u) { xcd_barrier_complete(bar, b.x, nloc, nx); b.st[0] = nloc; b.st[1] = nx; }
        const unsigned old = xb_add(&bar[XB_XSUB(b.x)], 1u);
        const unsigned gen = old / nloc;
        if (old + 1u == (gen + 1u) * nloc) {
            __builtin_amdgcn_fence(__ATOMIC_RELEASE, "agent");
            asm volatile("s_waitcnt vmcnt(0)" ::: "memory");
            const unsigned og = xb_add(&bar[XB_TOP], 1u);
            const unsigned tg = og / nx;
            if (og + 1u == (tg + 1u) * nx) xb_add(&bar[XB_TOPGEN], 1u);
            else XB_SPIN(xb_ld(&bar[XB_TOPGEN]) == tg, bar);
            __builtin_amdgcn_fence(__ATOMIC_ACQUIRE, "agent");
            xb_add(&bar[XB_XGEN(b.x)], 1u);
            asm volatile("s_waitcnt vmcnt(0)" ::: "memory");
        } else {
            XB_SPIN(xb_ld(&bar[XB_XGEN(b.x)]) == gen, bar);
            __builtin_amdgcn_fence(__ATOMIC_ACQUIRE, "agent");
            asm volatile("s_waitcnt vmcnt(0)" ::: "memory");
        }
    }
    __syncthreads();
}

struct Params { const float* in[26]; float* out; unsigned char* ws; int lo, hi; unsigned char bucket[3][136]; };
static_assert(sizeof(Params) == 26 * 8 + 8 + 8 + 8 + 408, "Params has no padding holes");

__device__ __forceinline__ void tr128(const float* src, int ld_src, bf16* dst, int ld_dst, LAS float* tile, int tid) {
    f32x4 v[8];
#pragma unroll
    for (int it = 0; it < 8; ++it) { const int id = it * 512 + tid, k = id >> 5, c4 = id & 31; v[it] = *(const f32x4*)(src + (size_t)k * ld_src + c4 * 4); }
#pragma unroll
    for (int it = 0; it < 8; ++it) { const int id = it * 512 + tid, k = id >> 5, c4 = id & 31; LAS float* p = tile + k * 129 + c4 * 4; p[0] = v[it][0]; p[1] = v[it][1]; p[2] = v[it][2]; p[3] = v[it][3]; }
    __syncthreads();
#pragma unroll
    for (int it = 0; it < 4; ++it) { const int id = it * 512 + tid, n = id >> 4, kc = id & 15; const LAS float* s = tile + (kc * 8) * 129 + n;
        u32x4 o; o.x = pk2(s[0], s[129]); o.y = pk2(s[2 * 129], s[3 * 129]); o.z = pk2(s[4 * 129], s[5 * 129]); o.w = pk2(s[6 * 129], s[7 * 129]);
        *(u32x4*)(dst + (size_t)n * ld_dst + kc * 8) = o; }
    __syncthreads();
}
__device__ __forceinline__ void tr_matrix_item(const float* W, int K, int N, bf16* WT, int item, LAS float* tile, int tid) {
    const int nbn = N / 128, kb = item / nbn, nb = item % nbn;
    tr128(W + (size_t)kb * 128 * N + nb * 128, N, WT + (size_t)nb * 128 * K + kb * 128, K, tile, tid);
}

__device__ __forceinline__ void rglru_chunk(const Params& p, int item, LAS float* xcs, int lane) {
    const bf16* proj = (const bf16*)(p.ws + WS_PROJ);
    bf16* hloc = (bf16*)(p.ws + WS_HLOC); bf16* cuma = (bf16*)(p.ws + WS_CUMA);
    float* sumA = (float*)(p.ws + WS_SUMA); float* sumH = (float*)(p.ws + WS_SUMH);
    const int c = item % NCH, h = (item / NCH) % 16, b = item / (NCH * 16);
    const int ch = h * 64 + lane;
    float wa[64], wi[64];
#pragma unroll
    for (int i = 0; i < 64; ++i) { wa[i] = p.in[5][(size_t)(h * 64 + i) * 64 + lane]; wi[i] = p.in[7][(size_t)(h * 64 + i) * 64 + lane]; }
    const float cw0 = p.in[3][ch], cw1 = p.in[3][1024 + ch], cw2 = p.in[3][2048 + ch], cw3 = p.in[3][3072 + ch], cb = p.in[4][ch];
    const float ba = p.in[6][ch], bi = p.in[8][ch];
    const float sp8 = 8.0f * log1pf(expf(-p.in[9][ch]));
    const int t0 = c * TCH;
    const bf16* xr = proj + (size_t)(b * SEQ) * DIN + C_XR + ch;
    float xm3 = 0.f, xm2 = 0.f, xm1 = 0.f;
    if (t0 > 0) { xm3 = bf1(xr[(size_t)(t0 - 3) * DIN]); xm2 = bf1(xr[(size_t)(t0 - 2) * DIN]); xm1 = bf1(xr[(size_t)(t0 - 1) * DIN]); }
    float hst = 0.f, pa = 1.f;
    for (int tb = 0; tb < TCH; tb += 8) {
        float xv[8], xc[8];
#pragma unroll
        for (int j = 0; j < 8; ++j) xv[j] = bf1(xr[(size_t)(t0 + tb + j) * DIN]);
#pragma unroll
        for (int j = 0; j < 8; ++j) { xc[j] = cb + cw0 * xm3 + cw1 * xm2 + cw2 * xm1 + cw3 * xv[j]; xm3 = xm2; xm2 = xm1; xm1 = xv[j]; xcs[j * 64 + lane] = xc[j]; }
        asm volatile("s_waitcnt lgkmcnt(0)" ::: "memory");
#pragma unroll
        for (int j = 0; j < 8; ++j) {
            float ra = ba, ri = bi;
#pragma unroll
            for (int i = 0; i < 64; i += 4) { const f32x4 x4 = *(const LAS f32x4*)(xcs + j * 64 + i);
                ra += x4[0] * wa[i] + x4[1] * wa[i + 1] + x4[2] * wa[i + 2] + x4[3] * wa[i + 3];
                ri += x4[0] * wi[i] + x4[1] * wi[i + 1] + x4[2] * wi[i + 2] + x4[3] * wi[i + 3]; }
            const float r = sigmoidf_(ra), ig = sigmoidf_(ri);
            const float la = -sp8 * r, a = __expf(la);
            const float uu = sqrtf(-expm1f(2.0f * la)) * (ig * xc[j]);
            hst = a * hst + uu; pa = pa * a;
            const size_t o = (size_t)(b * SEQ + t0 + tb + j) * D + ch;
            hloc[o] = (bf16)f2bf(hst); cuma[o] = (bf16)f2bf(pa);
        }
        asm volatile("s_waitcnt lgkmcnt(0)" ::: "memory");
    }
    sumA[(size_t)(b * NCH + c) * D + ch] = pa; sumH[(size_t)(b * NCH + c) * D + ch] = hst;
}

__device__ __forceinline__ void attn_item(const Params& p, int item, LAS unsigned char* vt, const LAS float* btab_all, int lane) {
    const bf16* proj = (const bf16*)(p.ws + WS_PROJ);
    const int rq = item & 127, bh = item >> 7, head = bh % 24, b = bh / 24;
    const int g = head >> 3, hh = head & 7, dil = (g == 0) ? 1 : (g == 1 ? 4 : 16), nqb = 128 / dil;
    const int res = rq / nqb, qb = rq % nqb, l0 = qb * 32;
    const int r = lane & 31, hf = lane >> 5;
    const LAS float* btab = btab_all + (g * 8 + hh) * 132;
    const size_t tokbase = (size_t)b * SEQ;
    bf16x8 qf[4];
    { const bf16* qp = proj + (tokbase + (size_t)(l0 + r) * dil + res) * DIN + C_Q + head * 64 + 8 * hf;
#pragma unroll
      for (int s = 0; s < 4; ++s) qf[s] = *(const bf16x8*)(qp + 16 * s); }
    f32x16 o0, o1;
#pragma unroll
    for (int i = 0; i < 16; ++i) { o0[i] = 0.f; o1[i] = 0.f; }
    float mrun = -1e30f, lrun = 0.f;
    for (int kt = 0; kt < 5; ++kt) {
        const int k0 = l0 - 128 + 32 * kt;
        if (k0 < 0) continue;
        const bf16* kp = proj + (tokbase + (size_t)(k0 + r) * dil + res) * DIN + C_K + head * 64 + 8 * hf;
        bf16x8 kf[4];
#pragma unroll
        for (int s = 0; s < 4; ++s) kf[s] = *(const bf16x8*)(kp + 16 * s);
        u32x4 va[2][2];
#pragma unroll
        for (int it = 0; it < 2; ++it) { const int kp2 = (lane >> 3) + 8 * it, dc = lane & 7;
#pragma unroll
            for (int e = 0; e < 2; ++e) va[it][e] = *(const u32x4*)(proj + (tokbase + (size_t)(k0 + 2 * kp2 + e) * dil + res) * DIN + C_V + head * 64 + 8 * dc); }
        f32x16 st;
#pragma unroll
        for (int i = 0; i < 16; ++i) st[i] = 0.f;
#pragma unroll
        for (int s = 0; s < 4; ++s) st = __builtin_amdgcn_mfma_f32_32x32x16_bf16(kf[s], qf[s], st, 0, 0, 0);
#pragma unroll
        for (int it = 0; it < 2; ++it) { const int kp2 = (lane >> 3) + 8 * it, dc = lane & 7;
#pragma unroll
            for (int w = 0; w < 4; ++w) { const unsigned a0 = va[it][0][w], a1 = va[it][1][w];
                *(LAS unsigned*)(vt + (8 * dc + 2 * w) * 72 + 4 * kp2) = (a0 & 0xffffu) | (a1 << 16);
                *(LAS unsigned*)(vt + (8 * dc + 2 * w + 1) * 72 + 4 * kp2) = (a0 >> 16) | (a1 & 0xffff0000u); } }
        float sv[16]; float mt = -1e30f;
#pragma unroll
        for (int i = 0; i < 16; ++i) { const int kk = (i & 3) + 8 * (i >> 2) + 4 * hf; const int rel = (l0 + r) - (k0 + kk);
            const bool ok = (rel >= 0) && (rel <= 128); const float bs = btab[ok ? rel : 0];
            sv[i] = ok ? st[i] + bs : -1e30f; mt = fmaxf(mt, sv[i]); }
        mt = fmaxf(mt, __shfl_xor(mt, 32));
        const float mnew = fmaxf(mrun, mt), al = __expf(mrun - mnew);
        float ps = 0.f; float pv[16];
#pragma unroll
        for (int i = 0; i < 16; ++i) { pv[i] = __expf(sv[i] - mnew); ps += pv[i]; }
        lrun = lrun * al + ps; mrun = mnew;
#pragma unroll
        for (int i = 0; i < 16; ++i) { o0[i] *= al; o1[i] *= al; }
        bf16x8 pf[2];
#pragma unroll
        for (int s = 0; s < 2; ++s) { u32x4 w; w.x = pk2(pv[8 * s], pv[8 * s + 1]); w.y = pk2(pv[8 * s + 2], pv[8 * s + 3]); w.z = pk2(pv[8 * s + 4], pv[8 * s + 5]); w.w = pk2(pv[8 * s + 6], pv[8 * s + 7]);
            pf[s] = __builtin_bit_cast(bf16x8, w); }
        asm volatile("s_waitcnt lgkmcnt(0)" ::: "memory");
#pragma unroll
        for (int s = 0; s < 2; ++s) {
            { const LAS unsigned char* q = vt + (r) * 72 + (16 * s + 4 * hf) * 2; u32x4 w; const u32x2 lo = *(const LAS u32x2*)q, hi = *(const LAS u32x2*)(q + 16); w.x = lo.x; w.y = lo.y; w.z = hi.x; w.w = hi.y;
              o0 = __builtin_amdgcn_mfma_f32_32x32x16_bf16(__builtin_bit_cast(bf16x8, w), pf[s], o0, 0, 0, 0); }
            { const LAS unsigned char* q = vt + (32 + r) * 72 + (16 * s + 4 * hf) * 2; u32x4 w; const u32x2 lo = *(const LAS u32x2*)q, hi = *(const LAS u32x2*)(q + 16); w.x = lo.x; w.y = lo.y; w.z = hi.x; w.w = hi.y;
              o1 = __builtin_amdgcn_mfma_f32_32x32x16_bf16(__builtin_bit_cast(bf16x8, w), pf[s], o1, 0, 0, 0); }
        }
        asm volatile("s_waitcnt lgkmcnt(0)" ::: "memory");
    }
    const float ltot = lrun + __shfl_xor(lrun, 32), inv = 1.0f / ltot;
    const size_t tok = tokbase + (size_t)(l0 + r) * dil + res;
    bf16* ao = (bf16*)(p.ws + WS_AO) + ((size_t)g * T + tok) * 512 + hh * 64;
#pragma unroll
    for (int q4 = 0; q4 < 4; ++q4) {
        u32x2 w; w.x = pk2(o0[4 * q4] * inv, o0[4 * q4 + 1] * inv); w.y = pk2(o0[4 * q4 + 2] * inv, o0[4 * q4 + 3] * inv);
        *(u32x2*)(ao + 8 * q4 + 4 * hf) = w;
        u32x2 w1; w1.x = pk2(o1[4 * q4] * inv, o1[4 * q4 + 1] * inv); w1.y = pk2(o1[4 * q4 + 2] * inv, o1[4 * q4 + 3] * inv);
        *(u32x2*)(ao + 32 + 8 * q4 + 4 * hf) = w1;
    }
    if (hf == 0) ((float*)(p.ws + WS_LSE))[((size_t)g * T + tok) * 8 + hh] = mrun + __logf(ltot);
}

__device__ __forceinline__ void build_tile_table(const Params& p, LAS unsigned char* lds, int tid) {
    LAS int* tbase = (LAS int*)(lds + L_TBASE); LAS unsigned short* tile_e = (LAS unsigned short*)(lds + L_TILEE);
    const unsigned* cnt = (const unsigned*)(p.ws + WS_CTL) + CW_CNT;
    __syncthreads();
    if (tid == 0) { int acc = 0; for (int e = 0; e < NE; ++e) { tbase[e] = acc; acc += ((int)cnt[e] + 255) >> 8; } tbase[NE] = acc; tbase[NE + 1] = acc + SH_TILES; }
    __syncthreads();
    if (tid < NE) { const int a = tbase[tid], bnd = tbase[tid + 1]; for (int i = a; i < bnd; ++i) tile_e[i] = (unsigned short)tid; }
    if (tid < SH_TILES) tile_e[tbase[NE] + tid] = (unsigned short)NE;
    __syncthreads();
}

__global__ void __launch_bounds__(512, 2) fwd_kernel(Params p) {
    extern __shared__ __attribute__((aligned(16))) unsigned char lds_raw[];
    LAS unsigned char* lds = (LAS unsigned char*)lds_raw;
    const int tid = threadIdx.x, lane = tid & 63, wave = __builtin_amdgcn_readfirstlane(tid >> 6);
    const int G = gridDim.x, bid = blockIdx.x;
    const int gw = bid * 8 + wave, NGW = G * 8;
    const size_t gtid = (size_t)bid * 512 + tid, NTH = (size_t)G * 512;
    unsigned char* ws = p.ws;
    volatile LAS unsigned* misc = (volatile LAS unsigned*)(lds + L_MISC);
    if (tid < 16) misc[tid] = 0u;
    { LAS float* bt = (LAS float*)(lds + L_BTAB);
      for (int i = tid; i < 3 * 8 * 132; i += 512) { const int g = i / (8 * 132), hh = (i / 132) % 8, rel = i % 132; bt[i] = (rel <= 128) ? p.in[12][(int)p.bucket[g][rel] * 24 + g * 8 + hh] : 0.f; } }
    __syncthreads();
#if N_LAUNCHES == 1
    XcdBarrier bar = xcd_barrier_post((unsigned*)(ws + WS_CTL) + CW_BAR, misc);
#define GRID_BAR() xcd_barrier(bar)
#else
#define GRID_BAR() do { } while (0)
#endif
    const int lo = p.lo, hi = p.hi;
#define IN(k) (lo <= (k) && (k) < hi)
#define SEAM(k) do { if (IN(k) && IN((k) + 1)) GRID_BAR(); } while (0)

    if (IN(0)) {
        LAS float* tile = (LAS float*)lds;
        for (int it = bid; it < 720; it += G) {
            int r = it;
            if (r < 544) { tr_matrix_item(p.in[1], 1024, DIN, (bf16*)(ws + WS_WINT), r, tile, tid); continue; } r -= 544;
            if (r < 64) { tr_matrix_item(p.in[10], 1024, 1024, (bf16*)(ws + WS_WPRT), r, tile, tid); continue; } r -= 64;
            if (r < 32) { tr_matrix_item(p.in[11], 512, 1024, (bf16*)(ws + WS_WPAT), r, tile, tid); continue; } r -= 32;
            if (r < 64) { tr_matrix_item(p.in[13], 1024, 1024, (bf16*)(ws + WS_WOT), r, tile, tid); continue; } r -= 64;
            tr_matrix_item(p.in[16], 1024, 256, (bf16*)(ws + WS_WRT), r, tile, tid);
        }
        const f32x4* x4 = (const f32x4*)p.in[0]; u32x4* xb = (u32x4*)(ws + WS_XB);
        for (size_t i = gtid; i < (size_t)T * D / 8; i += NTH) { const f32x4 a = x4[2 * i], b = x4[2 * i + 1];
            u32x4 o; o.x = pk2(a[0], a[1]); o.y = pk2(a[2], a[3]); o.z = pk2(b[0], b[1]); o.w = pk2(b[2], b[3]); xb[i] = o; }
    }
    SEAM(0);
    if (IN(1)) {
        pg8::Gemm g{(const bf16*)(ws + WS_XB), (const bf16*)(ws + WS_WINT), 1024}; pg8::StaticOrder S; S.init(T, DIN, G, bid);
        pg8::EpiInProj E{(bf16*)(ws + WS_PROJ), p.in[2]};
        pg8::gemm_phase<pg8::EpiInProj, pg8::StaticOrder, true>(lds, g, S, E);
    }
    SEAM(1);
    if (IN(2)) {
        LAS float* xcs = (LAS float*)(lds + wave * 2048);
        for (int it = gw; it < NB * 16 * NCH; it += NGW) rglru_chunk(p, it, xcs, lane);
        LAS unsigned char* vt = lds + 16384 + wave * 4608;
        const LAS float* bt = (const LAS float*)(lds + L_BTAB);
        for (int it = gw; it < NB * 24 * 128; it += NGW) attn_item(p, it, vt, bt, lane);
    }
    SEAM(2);
    if (IN(3)) {
        const bf16* proj = (const bf16*)(ws + WS_PROJ);
        const bf16* hloc = (const bf16*)(ws + WS_HLOC); const bf16* cuma = (const bf16*)(ws + WS_CUMA);
        const float* sumA = (const float*)(ws + WS_SUMA); const float* sumH = (const float*)(ws + WS_SUMH);
        bf16* yrnn = (bf16*)(ws + WS_YRNN);
        for (int it = bid; it < NB * NCH; it += G) {
            const int b = it / NCH, c = it % NCH, ch0 = (tid & 127) * 8, ts = tid >> 7;
            float H[8];
#pragma unroll
            for (int j = 0; j < 8; ++j) H[j] = 0.f;
            for (int k = 0; k < c; ++k) { const float* pa = sumA + (size_t)(b * NCH + k) * D + ch0; const float* ph = sumH + (size_t)(b * NCH + k) * D + ch0;
                const f32x4 a0 = *(const f32x4*)pa, a1 = *(const f32x4*)(pa + 4), h0 = *(const f32x4*)ph, h1 = *(const f32x4*)(ph + 4);
#pragma unroll
                for (int j = 0; j < 4; ++j) { H[j] = a0[j] * H[j] + h0[j]; H[4 + j] = a1[j] * H[4 + j] + h1[j]; } }
            for (int tt = ts; tt < TCH; tt += 4) { const size_t t = (size_t)b * SEQ + c * TCH + tt;
                const u32x4 hl = *(const u32x4*)(hloc + t * D + ch0), ca = *(const u32x4*)(cuma + t * D + ch0), gg = *(const u32x4*)(proj + t * DIN + C_GR + ch0);
                u32x4 o;
#pragma unroll
                for (int w = 0; w < 4; ++w) { const float y0 = (bflo(hl[w]) + bflo(ca[w]) * H[2 * w]) * bflo(gg[w]), y1 = (bfhi(hl[w]) + bfhi(ca[w]) * H[2 * w + 1]) * bfhi(gg[w]); o[w] = pk2(y0, y1); }
                *(u32x4*)(yrnn + t * D + ch0) = o; }
        }
        const bf16* ao = (const bf16*)(ws + WS_AO); const float* lse = (const float*)(ws + WS_LSE); bf16* yatt = (bf16*)(ws + WS_YATT);
        for (size_t i = gtid; i < (size_t)T * 64; i += NTH) { const size_t t = i >> 6; const int c8 = (int)(i & 63), hh = c8 >> 3;
            const float l0 = lse[t * 8 + hh], l1 = lse[((size_t)T + t) * 8 + hh], l2 = lse[((size_t)2 * T + t) * 8 + hh];
            const float mx = fmaxf(l0, fmaxf(l1, l2)); float w0 = __expf(l0 - mx), w1 = __expf(l1 - mx), w2 = __expf(l2 - mx); const float inv = 1.0f / (w0 + w1 + w2); w0 *= inv; w1 *= inv; w2 *= inv;
            const u32x4 a = *(const u32x4*)(ao + t * 512 + c8 * 8), bq = *(const u32x4*)(ao + ((size_t)T + t) * 512 + c8 * 8), cq = *(const u32x4*)(ao + ((size_t)2 * T + t) * 512 + c8 * 8);
            u32x4 o;
#pragma unroll
            for (int w = 0; w < 4; ++w) o[w] = pk2(w0 * bflo(a[w]) + w1 * bflo(bq[w]) + w2 * bflo(cq[w]), w0 * bfhi(a[w]) + w1 * bfhi(bq[w]) + w2 * bfhi(cq[w]));
            *(u32x4*)(yatt + t * 512 + c8 * 8) = o; }
    }
    SEAM(3);
    if (IN(4)) {
        pg8::StaticOrder S; S.init(T, D, G, bid);
        { pg8::Gemm g{(const bf16*)(ws + WS_YRNN), (const bf16*)(ws + WS_WPRT), 1024};
          pg8::EpiProjRnn E{(const bf16*)(ws + WS_PROJ), p.out};
          pg8::gemm_phase<pg8::EpiProjRnn, pg8::StaticOrder, true>(lds, g, S, E); }
        asm volatile("s_waitcnt vmcnt(0)" ::: "memory"); __syncthreads();
        { pg8::Gemm g{(const bf16*)(ws + WS_YATT), (const bf16*)(ws + WS_WPAT), 512};
          pg8::EpiProjAtt E{(const bf16*)(ws + WS_PROJ), p.out, (bf16*)(ws + WS_MERGED)};
          pg8::gemm_phase<pg8::EpiProjAtt, pg8::StaticOrder, true>(lds, g, S, E); }
    }
    SEAM(4);
    if (IN(5)) {
        pg8::Gemm g{(const bf16*)(ws + WS_MERGED), (const bf16*)(ws + WS_WOT), 1024}; pg8::StaticOrder S; S.init(T, D, G, bid);
        pg8::EpiF32Res E{p.in[0], (float*)(ws + WS_PRELN), D, ALPHA};
        pg8::gemm_phase<pg8::EpiF32Res, pg8::StaticOrder, true>(lds, g, S, E);
    }
    SEAM(5);
    if (IN(6)) {
        const float* preln = (const float*)(ws + WS_PRELN); bf16* x1b = (bf16*)(ws + WS_X1B);
        for (int row = gw; row < T; row += NGW) {
            const f32x4* xr = (const f32x4*)(preln + (size_t)row * D) + lane; f32x4 v[4]; float s = 0.f;
#pragma unroll
            for (int j = 0; j < 4; ++j) { v[j] = xr[64 * j]; s += (v[j][0] + v[j][1]) + (v[j][2] + v[j][3]); }
            const float mean = wave_sum(s) * (1.f / D); float s2 = 0.f;
#pragma unroll
            for (int j = 0; j < 4; ++j) { v[j] = v[j] - mean; s2 += (v[j][0] * v[j][0] + v[j][1] * v[j][1]) + (v[j][2] * v[j][2] + v[j][3] * v[j][3]); }
            const float rstd = 1.f / sqrtf(wave_sum(s2) * (1.f / D) + LN_EPS);
#pragma unroll
            for (int j = 0; j < 4; ++j) { const f32x4 gm = ((const f32x4*)p.in[14])[lane + 64 * j], bt = ((const f32x4*)p.in[15])[lane + 64 * j];
                const f32x4 o = v[j] * rstd * gm + bt;
                ((f32x4*)(p.out + (size_t)row * D))[lane + 64 * j] = o;
                u32x2 w; w.x = pk2(o[0], o[1]); w.y = pk2(o[2], o[3]); ((u32x2*)(x1b + (size_t)row * D))[lane + 64 * j] = w; }
        }
        __syncthreads();
        LAS float* tile = (LAS float*)lds;
        for (int it = bid; it < 257 * 48; it += G) {
            const int e = it / 48, r = it % 48;
            if (r < 32) { const int up = r >> 4, q = r & 15, kb = q >> 1, nbk = q & 1;
                const float* W = (e < NE) ? p.in[up ? 19 : 18] + (size_t)e * 1024 * 256 : p.in[up ? 22 : 21];
                tr128(W + (size_t)kb * 128 * 256 + nbk * 128, 256, (bf16*)(ws + WS_WGU) + ((size_t)e * 512 + nbk * 256 + up * 128) * 1024 + kb * 128, 1024, tile, tid);
            } else { const int q = r - 32, kb = q >> 3, nb = q & 7;
                const float* W = (e < NE) ? p.in[20] + (size_t)e * 256 * 1024 : p.in[23];
                tr128(W + (size_t)kb * 128 * 1024 + nb * 128, 1024, (bf16*)(ws + WS_WD) + ((size_t)e * 1024 + nb * 128) * 256 + kb * 128, 256, tile, tid); }
        }
    }
    SEAM(6);
    if (IN(7)) {
        pg8::Gemm g{(const bf16*)(ws + WS_X1B), (const bf16*)(ws + WS_WRT), 1024}; pg8::StaticOrder S; S.init(T, NE, G, bid);
        pg8::EpiF32Res E{nullptr, (float*)(ws + WS_LOGITS), NE, 0.f};
        pg8::gemm_phase<pg8::EpiF32Res, pg8::StaticOrder, true>(lds, g, S, E);
    }
    SEAM(7);
    if (IN(8)) {
        const float* logits = (const float*)(ws + WS_LOGITS); unsigned* cnt = (unsigned*)(ws + WS_CTL) + CW_CNT;
        int* eidx = (int*)(ws + WS_EIDX); float* gatew = (float*)(ws + WS_GATEW); int* rank = (int*)(ws + WS_RANK);
        const f32x4 rb = ((const f32x4*)p.in[17])[lane];
        for (int t = gw; t < T; t += NGW) {
            const f32x4 z = ((const f32x4*)(logits + (size_t)t * NE))[lane];
            float sc[4], sel[4];
#pragma unroll
            for (int j = 0; j < 4; ++j) { sc[j] = 1.0f / (1.0f + expf(-z[j])); sel[j] = sc[j] + rb[j]; }
            float m1 = fmaxf(sel[0], sel[1]), m2 = fminf(sel[0], sel[1]);
#pragma unroll
            for (int j = 2; j < 4; ++j) { const float v = sel[j]; m2 = fmaxf(m2, fminf(m1, v)); m1 = fmaxf(m1, v); }
#pragma unroll
            for (int o = 1; o < 8; o <<= 1) { const float o1 = __shfl_xor(m1, o), o2 = __shfl_xor(m2, o); m2 = fmaxf(fminf(m1, o1), fmaxf(m2, o2)); m1 = fmaxf(m1, o1); }
            const float gs = m1 + m2; const int mygrp = lane >> 3; int rk = 0;
#pragma unroll
            for (int g2 = 0; g2 < 8; ++g2) { const float og = __shfl(gs, g2 * 8); rk += (og > gs || (og == gs && g2 < mygrp)) ? 1 : 0; }
            if (rk >= 4) {
#pragma unroll
                for (int j = 0; j < 4; ++j) sel[j] = -INFINITY;
            }
            int ek[8]; float gk[8]; float gsum = 0.f;
#pragma unroll
            for (int k = 0; k < 8; ++k) {
                float bv = sel[0]; int bi = 0;
#pragma unroll
                for (int j = 1; j < 4; ++j) if (sel[j] > bv) { bv = sel[j]; bi = j; }
                bi += 4 * lane;
#pragma unroll
                for (int o = 1; o < 64; o <<= 1) { const float ov = __shfl_xor(bv, o); const int oi = __shfl_xor(bi, o); if (ov > bv || (ov == bv && oi < bi)) { bv = ov; bi = oi; } }
                const int own = bi >> 2, jj = bi & 3;
                const float mysc = jj == 0 ? sc[0] : (jj == 1 ? sc[1] : (jj == 2 ? sc[2] : sc[3]));
                const float wsc = __shfl(mysc, own);
                if (lane == own) {
#pragma unroll
                    for (int j = 0; j < 4; ++j) if (j == jj) sel[j] = -INFINITY;
                }
                ek[k] = bi; gk[k] = wsc; gsum += wsc;
            }
            int me = 0; float mg = 0.f;
#pragma unroll
            for (int k = 0; k < 8; ++k) if (lane == k) { me = ek[k]; mg = gk[k]; }
            if (lane < 8) { const int rr = (int)atomicAdd(&cnt[me], 1u);
                eidx[(size_t)t * 8 + lane] = me; gatew[(size_t)t * 8 + lane] = mg / gsum * 2.5f; rank[(size_t)t * 8 + lane] = rr; }
        }
    }
    SEAM(8);
    if (IN(9)) {
        build_tile_table(p, lds, tid);
        const LAS int* tbase = (const LAS int*)(lds + L_TBASE);
        const unsigned* cnt = (const unsigned*)(ws + WS_CTL) + CW_CNT;
        const int* eidx = (const int*)(ws + WS_EIDX); const float* gatew = (const float*)(ws + WS_GATEW); const int* rank = (const int*)(ws + WS_RANK);
        int* slotof = (int*)(ws + WS_SLOTOF); int* tokslot = (int*)(ws + WS_TOKSLOT); float* wslot = (float*)(ws + WS_WSLOT);
        for (size_t i = gtid; i < (size_t)T * 8; i += NTH) { const int e = eidx[i]; const int slot = tbase[e] * 256 + rank[i]; tokslot[slot] = (int)(i >> 3); wslot[slot] = gatew[i]; slotof[i] = slot; }
        for (size_t i = gtid; i < (size_t)NE * 256; i += NTH) { const int e = (int)(i >> 8), j = (int)(i & 255); const int s = (int)cnt[e] + j; if (s < (tbase[e + 1] - tbase[e]) * 256) { tokslot[tbase[e] * 256 + s] = 0; wslot[tbase[e] * 256 + s] = 0.f; } }
        const int sb = tbase[NE] * 256;
        for (size_t i = gtid; i < (size_t)T; i += NTH) { tokslot[sb + i] = (int)i; }
    }
    SEAM(9);
    if (IN(10)) {
        build_tile_table(p, lds, tid);
        const LAS int* tbase = (const LAS int*)(lds + L_TBASE);
        pg8::GroupOrder<true> S; S.nN = 2; S.nwg = tbase[NE + 1] * 2; S.G = G; S.c = bid; S.tile_e = (const LAS unsigned short*)(lds + L_TILEE); S.tok = (const int*)(ws + WS_TOKSLOT); S.rowbytes = 2048u;
        pg8::Gemm g{(const bf16*)(ws + WS_X1B), (const bf16*)(ws + WS_WGU), 1024};
        pg8::EpiGateUp E{(bf16*)(ws + WS_H)};
        pg8::gemm_phase<pg8::EpiGateUp, pg8::GroupOrder<true>, true>(lds, g, S, E);
    }
    SEAM(10);
    if (IN(11)) {
        build_tile_table(p, lds, tid);
        const LAS int* tbase = (const LAS int*)(lds + L_TBASE);
        pg8::GroupOrder<false> S; S.nN = 4; S.nwg = tbase[NE + 1] * 4; S.G = G; S.c = bid; S.tile_e = (const LAS unsigned short*)(lds + L_TILEE); S.tok = nullptr; S.rowbytes = 0u;
        pg8::Gemm g{(const bf16*)(ws + WS_H), (const bf16*)(ws + WS_WD), 256};
        pg8::EpiDown E{(bf16*)(ws + WS_Y), (const float*)(ws + WS_WSLOT), p.out, tbase[NE]};
        pg8::gemm_phase<pg8::EpiDown, pg8::GroupOrder<false>, true>(lds, g, S, E);
    }
    SEAM(11);
    if (IN(12)) {
        const bf16* Y = (const bf16*)(ws + WS_Y); const int* slotof = (const int*)(ws + WS_SLOTOF);
        for (int t = gw; t < T; t += NGW) {
            float* orow = p.out + (size_t)t * D; float v[16];
            { const f32x4 a = *(const f32x4*)(orow + 8 * lane), b = *(const f32x4*)(orow + 8 * lane + 4), c = *(const f32x4*)(orow + 512 + 8 * lane), d = *(const f32x4*)(orow + 512 + 8 * lane + 4);
#pragma unroll
              for (int j = 0; j < 4; ++j) { v[j] = a[j]; v[4 + j] = b[j]; v[8 + j] = c[j]; v[12 + j] = d[j]; } }
            int sl[8];
#pragma unroll
            for (int k = 0; k < 8; ++k) sl[k] = slotof[(size_t)t * 8 + k];
#pragma unroll
            for (int k = 0; k < 8; ++k) { const bf16* yr = Y + (size_t)sl[k] * D; const u32x4 a = *(const u32x4*)(yr + 8 * lane), b = *(const u32x4*)(yr + 512 + 8 * lane);
#pragma unroll
                for (int w = 0; w < 4; ++w) { v[2 * w] += bflo(a[w]); v[2 * w + 1] += bfhi(a[w]); v[8 + 2 * w] += bflo(b[w]); v[8 + 2 * w + 1] += bfhi(b[w]); } }
            float s = 0.f;
#pragma unroll
            for (int j = 0; j < 16; ++j) s += v[j];
            const float mean = wave_sum(s) * (1.f / D); float s2 = 0.f;
#pragma unroll
            for (int j = 0; j < 16; ++j) { v[j] -= mean; s2 += v[j] * v[j]; }
            const float rstd = 1.f / sqrtf(wave_sum(s2) * (1.f / D) + LN_EPS);
            const float* gm = p.in[24]; const float* bt = p.in[25];
#pragma unroll
            for (int q = 0; q < 4; ++q) { const int c0 = (q >> 1) * 512 + 8 * lane + (q & 1) * 4; const f32x4 g4 = *(const f32x4*)(gm + c0), b4 = *(const f32x4*)(bt + c0); f32x4 o;
#pragma unroll
                for (int j = 0; j < 4; ++j) o[j] = v[4 * q + j] * rstd * g4[j] + b4[j];
                *(f32x4*)(orow + c0) = o; }
        }
    }
#undef IN
#undef SEAM
}

extern "C" void kernel_launch(void* const* d_in, const int* in_sizes, int n_in, void* d_out, int out_size, void* d_ws, size_t ws_size, hipStream_t stream) {
    static int grid = 0;
    if (grid == 0) {
        if (n_in != 26 || in_sizes[0] != T * D || out_size != T * D || ws_size < WS_END) { fprintf(stderr, "kernel_launch: unexpected shapes / workspace (%d inputs, ws %zu < %zu)\n", n_in, ws_size, (size_t)WS_END); grid = -1; return; }
        int dev = 0, cus = 0, per_cu = 0;
        if (hipGetDevice(&dev) != hipSuccess || hipDeviceGetAttribute(&cus, hipDeviceAttributeMultiprocessorCount, dev) != hipSuccess) { grid = -1; return; }
        if (hipFuncSetAttribute((const void*)fwd_kernel, hipFuncAttributeMaxDynamicSharedMemorySize, LDS_BYTES) != hipSuccess) { fprintf(stderr, "kernel_launch: hipFuncSetAttribute failed\n"); grid = -1; return; }
        if (hipOccupancyMaxActiveBlocksPerMultiprocessor(&per_cu, (const void*)fwd_kernel, 512, LDS_BYTES) != hipSuccess || per_cu < 1) { fprintf(stderr, "kernel_launch: occupancy query says %d\n", per_cu); }
        (void)hipGetLastError();
        grid = cus;
    }
    if (grid < 0) return;
    (void)hipMemsetAsync((char*)d_ws + WS_CTL, 0, CTL_BYTES, stream);
    Params p{};
    for (int i = 0; i < 26; ++i) p.in[i] = (const float*)d_in[i];
    p.out = (float*)d_out; p.ws = (unsigned char*)d_ws;
    const int dils[3] = {1, 4, 16};
    for (int g = 0; g < 3; ++g) for (int rel = 0; rel <= 128; ++rel) {
        const long dist = (long)rel * dils[g]; long bk;
        if (dist < 16) bk = dist;
        else { const double dd = (double)(dist < 1 ? 1 : dist); long large = 16 + (long)(std::log(dd / 16.0) / std::log(2048.0 / 16.0) * 16.0); bk = large < 31 ? large : 31; }
        p.bucket[g][rel] = (unsigned char)bk;
    }
#if N_LAUNCHES == 1
    p.lo = 0; p.hi = NPHASE;
    hipLaunchKernelGGL(fwd_kernel, dim3(grid), dim3(512), LDS_BYTES, stream, p);
#else
    for (int k = 0; k < NPHASE; ++k) { p.lo = k; p.hi = k + 1; hipLaunchKernelGGL(fwd_kernel, dim3(grid), dim3(512), LDS_BYTES, stream, p); }
#endif
}
```

```cpp
#include <hip/hip_runtime.h>
#include <cstdio>
#include <cstdint>
#include <cmath>

#ifndef N_LAUNCHES
#define N_LAUNCHES 1
#endif

#define GAS __attribute__((address_space(1)))
#define LAS __attribute__((address_space(3)))
typedef unsigned short bf16;
typedef float f32x2 __attribute__((ext_vector_type(2)));
typedef float f32x4 __attribute__((ext_vector_type(4)));
typedef float f32x16 __attribute__((ext_vector_type(16)));
typedef short bf16x8 __attribute__((ext_vector_type(8)));
typedef short bf16x4 __attribute__((ext_vector_type(4)));
typedef unsigned u32x4 __attribute__((ext_vector_type(4)));
typedef unsigned u32x2 __attribute__((ext_vector_type(2)));

constexpr int NB = 8, SEQ = 4096, T = NB * SEQ, D = 1024, DIN = 8704;
constexpr int C_XR = 0, C_GR = 1024, C_Q = 2048, C_K = 3584, C_V = 5120, C_GRNN = 6656, C_GATT = 7680;
constexpr int NE = 256, TOPK = 8, DE = 256;
constexpr int TCH = 128, NCH = SEQ / TCH;
constexpr int MAXT_R = 1280, SH_TILES = T / 256, MAXT = MAXT_R + SH_TILES;
constexpr float ALPHA = 1.18920711500272f, LN_EPS = 1e-5f;
constexpr int NPHASE = 13;

constexpr size_t MiB = 1u << 20;
constexpr size_t WS_CTL = 0, CTL_BYTES = 1 * MiB;
constexpr size_t WS_WINT = 1 * MiB;
constexpr size_t WS_WPRT = 18 * MiB;
constexpr size_t WS_WPAT = 20 * MiB;
constexpr size_t WS_WOT = 21 * MiB;
constexpr size_t WS_WRT = 23 * MiB;
constexpr size_t WS_HIST = 31 * MiB + 512 * 1024;
constexpr size_t WS_EIDX = 24 * MiB, WS_GATEW = 25 * MiB, WS_RANK = 26 * MiB, WS_SLOTOF = 27 * MiB, WS_TOKSLOT = 28 * MiB, WS_WSLOT = 30 * MiB;
constexpr size_t WS_XB = 32 * MiB;
constexpr size_t WS_YRNN = 32 * MiB;
constexpr size_t WS_HLOC = 96 * MiB;
constexpr size_t WS_MERGED = 96 * MiB;
constexpr size_t WS_CUMA = 160 * MiB;
constexpr size_t WS_AO = 224 * MiB;
constexpr size_t WS_YATT = 320 * MiB;
constexpr size_t WS_SUMA = 352 * MiB, WS_SUMH = 353 * MiB;
constexpr size_t WS_LSE = 354 * MiB;
constexpr size_t WS_PROJ = 360 * MiB;
constexpr size_t WS_PRELN = 700 * MiB;
constexpr size_t WS_WD = 32 * MiB;
constexpr size_t WS_H = 161 * MiB;
constexpr size_t WS_Y = 337 * MiB;
constexpr size_t WS_X1B = 337 * MiB;
constexpr size_t WS_WGU = 401 * MiB;
constexpr size_t WS_LOGITS = 658 * MiB;
constexpr size_t WS_END = 977 * MiB;
constexpr int CW_BAR = 4096, CW_CNT = 16384;

constexpr int RING_BYTES = 131072;
constexpr int L_TBASE = RING_BYTES;
constexpr int L_TILEE = L_TBASE + 1040;
constexpr int L_BTAB = L_TILEE + 2816;
constexpr int L_MISC = L_BTAB + 12672;
constexpr int L_LCNT = L_MISC + 64;
constexpr int L_BBASE = L_LCNT + 1024;
constexpr int LDS_BYTES = 151552;
static_assert(L_BBASE + 1024 <= LDS_BYTES, "LDS map");

__device__ __forceinline__ unsigned f2bf(float f) { unsigned u = __builtin_bit_cast(unsigned, f); return (u + 0x7fffu + ((u >> 16) & 1u)) >> 16; }
__device__ __forceinline__ unsigned pk2(float lo, float hi) { return f2bf(lo) | (f2bf(hi) << 16); }
__device__ __forceinline__ float bflo(unsigned w) { return __builtin_bit_cast(float, w << 16); }
__device__ __forceinline__ float bfhi(unsigned w) { return __builtin_bit_cast(float, w & 0xffff0000u); }
__device__ __forceinline__ float bf1(bf16 h) { return __builtin_bit_cast(float, (unsigned)h << 16); }
__device__ __forceinline__ float sigmoidf_(float x) { return 1.0f / (1.0f + __expf(-x)); }
__device__ __forceinline__ float gelu_tanh(float x) { const float z = 1.5957691216057308f * (x + 0.044715f * x * x * x); return x / (1.0f + __expf(-z)); }
__device__ __forceinline__ float wave_sum(float v) {
#pragma unroll
    for (int o = 1; o < 64; o <<= 1) v += __shfl_xor(v, o);
    return v;
}

namespace pg8 {
#define PG8_LAS __attribute__((address_space(3)))
typedef unsigned short bf16_t;
constexpr int BM = 256, BK = 64, HALF = 128, HTB = HALF * BK * 2, STAGE_BYTES = 8 * HTB, NXCD = 8, WGM = 8;
__host__ __device__ __forceinline__ int lds_byte(int r, int c) { const int st = (r >> 4) * 2 + (c >> 5), rr = r & 15, cc = c & 31, ob = rr * 64 + cc * 2; return st * 1024 + (ob ^ (((ob >> 9) & 1) << 5)); }
__host__ __device__ __forceinline__ void stage_rc(int b, int& R, int& C) { const int st = b / 1024, sb = b % 1024, swz = sb ^ (((sb >> 9) & 1) << 5); R = (st >> 1) * 16 + swz / 64; C = (st & 1) * 32 + (swz % 64) / 2; }
__host__ __device__ __forceinline__ int perm32(int rho) { const int n = rho >> 4, i = rho & 15; return 8 * (i >> 2) + 4 * n + (i & 3); }

struct Unit { int pm, pn, pb; };
struct Gemm { const bf16_t* A; const bf16_t* Bt; int K; };

struct StaticOrder {
    static constexpr bool GATHER = false;
    int nM, nN, nwg, G, c;
    __device__ void init(int M, int N, int G_, int c_) { nM = M / BM; nN = N / BM; nwg = nM * nN; G = G_; c = c_; }
    __device__ bool next(int i, Unit& u) const {
        const long L = (long)i * G + c; if (L >= nwg) return false;
        int wgid = (int)L; { const int q = nwg / NXCD, r = nwg % NXCD, xcd = wgid % NXCD, off = wgid / NXCD; wgid = (xcd < r ? xcd * (q + 1) : r * (q + 1) + (xcd - r) * q) + off; }
        const int nig = WGM * nN, gid = wgid / nig, fm = gid * WGM, gsz = (nM - fm) < WGM ? (nM - fm) : WGM;
        u.pm = fm + ((wgid % nig) % gsz); u.pn = (wgid % nig) / gsz; u.pb = u.pn; return true;
    }
    __device__ __forceinline__ unsigned arow(int) const { return 0u; }
};
template <bool GATHER_> struct GroupOrder {
    static constexpr bool GATHER = GATHER_;
    int nN, nwg, G, c; const LAS unsigned short* tile_e; const int* tok; unsigned rowbytes;
    __device__ bool next(int i, Unit& u) const {
        const long L = (long)i * G + c; if (L >= nwg) return false;
        u.pm = (int)L / nN; u.pn = (int)L % nN; u.pb = (int)tile_e[u.pm] * nN + u.pn; return true;
    }
    __device__ __forceinline__ unsigned arow(int slot) const { return (unsigned)tok[slot] * rowbytes; }
};

__device__ __forceinline__ unsigned cvt_pk_bf16(float lo, float hi) { unsigned r; asm volatile("v_cvt_pk_bf16_f32 %0, %1, %2" : "=v"(r) : "v"(lo), "v"(hi)); return r; }

template <class Epi, class Sched, bool ALIGN_EPI = false>
__device__ __forceinline__ void gemm_phase(PG8_LAS unsigned char* lds, const Gemm g, const Sched& S, const Epi& E) {
    constexpr bool GA = Sched::GATHER;
    const int tid = threadIdx.x, wid = __builtin_amdgcn_readfirstlane(tid >> 6), lane = tid & 63, wr = wid >> 2, wc = wid & 3, fr = lane & 15, fq = lane >> 4;
    const int K = g.K, nt = K / BK;
    unsigned voffA[2], voffA1[2], voffB[2]; int RA[2], CA2[2];
#pragma unroll
    for (int i = 0; i < 2; ++i) { int R, C; stage_rc(tid * 16 + i * 8192, R, C); const int Rb = Epi::PERM ? ((R & ~31) + perm32(R & 31)) : R;
        RA[i] = R; CA2[i] = C * 2;
        voffA[i] = (unsigned)(R * K + C) * 2u; voffA1[i] = voffA[i]; voffB[i] = (unsigned)(Rb * K + C) * 2u; }
    const size_t kstep = (size_t)(BK * 2);
    const size_t hstep = (size_t)HALF * K * 2;
    const size_t tstep = 2 * hstep;
    const size_t hstepA = GA ? 0 : hstep;
    const unsigned ldsw = (unsigned)wid * 1024u;
    const int aoff = lds_byte(wr * 64 + fr, fq * 8), boff = lds_byte(wc * 32 + fr, fq * 8);
#define PG8_SA(b, h) (((b) * 2 + (h)) * HTB)
#define PG8_SB(b, h) ((4 + (b) * 2 + (h)) * HTB)
#define PG8_STAGE(bufoff, gbase, voff) do { _Pragma("unroll") for (int _i = 0; _i < 2; ++_i) \
        __builtin_amdgcn_global_load_lds((const unsigned*)((const char*)(gbase) + (voff)[_i]), (PG8_LAS unsigned*)(lds + (bufoff) + ldsw + _i * 8192), 16, 0, 0); } while (0)
#define PG8_LDA(dst, b, h) do { _Pragma("unroll") for (int m = 0; m < 4; ++m) _Pragma("unroll") for (int k = 0; k < 2; ++k) dst[m][k] = *(const PG8_LAS bf16x8*)(lds + PG8_SA(b, h) + aoff + m * 2048 + k * 1024); } while (0)
#define PG8_LDB(dst, b, h) do { _Pragma("unroll") for (int n = 0; n < 2; ++n) _Pragma("unroll") for (int k = 0; k < 2; ++k) dst[n][k] = *(const PG8_LAS bf16x8*)(lds + PG8_SB(b, h) + boff + n * 2048 + k * 1024); } while (0)
#define PG8_MMA(ai, bj, At, Bt) do { __builtin_amdgcn_s_setprio(1); _Pragma("unroll") for (int m = 0; m < 4; ++m) _Pragma("unroll") for (int n = 0; n < 2; ++n) _Pragma("unroll") for (int k = 0; k < 2; ++k) \
        acc[ai][bj][m][n] = __builtin_amdgcn_mfma_f32_16x16x32_bf16(Bt[n][k], At[m][k], acc[ai][bj][m][n], 0, 0, 0); __builtin_amdgcn_s_setprio(0); } while (0)
#define PG8_WAIT_V(n) asm volatile("s_waitcnt vmcnt(" #n ")" ::: "memory")
#define PG8_WAIT_L(n) asm volatile("s_waitcnt lgkmcnt(" #n ")" ::: "memory")
#define PG8_BAR __builtin_amdgcn_s_barrier()
#define PG8_SCHED __builtin_amdgcn_sched_barrier(0)
    Unit cur, nxt; int ui = 0;
    if (!S.next(0, cur)) return;
    f32x4 acc[2][2][4][2];
#pragma unroll
    for (int a = 0; a < 2; ++a)
#pragma unroll
        for (int b = 0; b < 2; ++b)
#pragma unroll
            for (int m = 0; m < 4; ++m)
#pragma unroll
                for (int n = 0; n < 2; ++n) acc[a][b][m][n] = (f32x4){0.f, 0.f, 0.f, 0.f};
    bf16x8 At[4][2], B0[2][2], B1[2][2];
    const char* cA = GA ? (const char*)g.A : (const char*)g.A + (size_t)cur.pm * tstep; const char* cB = (const char*)g.Bt + (size_t)cur.pb * tstep;
    if constexpr (GA) {
#pragma unroll
        for (int i = 0; i < 2; ++i) { voffA[i] = S.arow(cur.pm * BM + RA[i]) + (unsigned)CA2[i]; voffA1[i] = S.arow(cur.pm * BM + HALF + RA[i]) + (unsigned)CA2[i]; }
    }
    PG8_STAGE(PG8_SB(0, 0), cB, voffB); PG8_STAGE(PG8_SB(0, 1), cB + hstep, voffB); PG8_STAGE(PG8_SA(0, 0), cA, voffA); PG8_STAGE(PG8_SA(0, 1), cA + hstepA, voffA1);
    if (wr == 1) PG8_BAR;
    PG8_WAIT_V(2); PG8_BAR;
    PG8_STAGE(PG8_SB(1, 0), cB + kstep, voffB); PG8_STAGE(PG8_SA(1, 0), cA + kstep, voffA); PG8_STAGE(PG8_SB(1, 1), cB + hstep + kstep, voffB);
    PG8_WAIT_V(6); PG8_BAR;
    for (;;) {
        const bool has_next = S.next(ui + 1, nxt);
        const char* nA = GA ? (const char*)g.A : (has_next ? (const char*)g.A + (size_t)nxt.pm * tstep : cA);
        const char* nB = has_next ? (const char*)g.Bt + (size_t)nxt.pb * tstep : cB;
        for (int t = 0; t < nt; t += 2) {
            const bool last = (t == nt - 2);
            const char* a1 = cA + (size_t)(t + 1) * kstep;
            const char* a2 = last ? nA : cA + (size_t)(t + 2) * kstep; const char* b2 = last ? nB : cB + (size_t)(t + 2) * kstep;
            const char* a3 = a2 + kstep; const char* b3 = b2 + kstep;
            unsigned nvA[2], nvA1[2];
            if constexpr (GA) {
                if (last && has_next) {
#pragma unroll
                    for (int i = 0; i < 2; ++i) { nvA[i] = S.arow(nxt.pm * BM + RA[i]) + (unsigned)CA2[i]; nvA1[i] = S.arow(nxt.pm * BM + HALF + RA[i]) + (unsigned)CA2[i]; }
                } else {
#pragma unroll
                    for (int i = 0; i < 2; ++i) { nvA[i] = voffA[i]; nvA1[i] = voffA1[i]; }
                }
            }
            PG8_LDB(B0, 0, 0); PG8_LDB(B1, 0, 1); PG8_SCHED; PG8_LDA(At, 0, 0); PG8_STAGE(PG8_SA(1, 1), a1 + hstepA, voffA1);
            if constexpr (GA) {
#pragma unroll
                for (int i = 0; i < 2; ++i) { voffA[i] = nvA[i]; voffA1[i] = nvA1[i]; }
            }
            PG8_WAIT_V(8); PG8_WAIT_L(0); PG8_BAR; PG8_MMA(0, 0, At, B0); PG8_MMA(0, 1, At, B1); PG8_BAR; PG8_SCHED;
            PG8_LDA(At, 0, 1); PG8_STAGE(PG8_SB(0, 0), b2, voffB); PG8_STAGE(PG8_SB(0, 1), b2 + hstep, voffB); PG8_STAGE(PG8_SA(0, 0), a2, voffA);
            PG8_WAIT_V(8); PG8_WAIT_L(0); PG8_BAR; PG8_MMA(1, 0, At, B0); PG8_MMA(1, 1, At, B1); PG8_BAR; PG8_SCHED;
            PG8_LDB(B0, 1, 0); PG8_LDB(B1, 1, 1); PG8_SCHED; PG8_LDA(At, 1, 0); PG8_STAGE(PG8_SA(0, 1), a2 + hstepA, voffA1);
            PG8_WAIT_V(8); PG8_WAIT_L(0); PG8_BAR; PG8_MMA(0, 0, At, B0); PG8_MMA(0, 1, At, B1); PG8_BAR; PG8_SCHED;
            PG8_LDA(At, 1, 1); PG8_STAGE(PG8_SB(1, 0), b3, voffB); PG8_STAGE(PG8_SB(1, 1), b3 + hstep, voffB); PG8_STAGE(PG8_SA(1, 0), a3, voffA);
            PG8_WAIT_V(8); PG8_WAIT_L(0); PG8_BAR; PG8_MMA(1, 0, At, B0); PG8_MMA(1, 1, At, B1); PG8_BAR; PG8_SCHED;
        }
        if constexpr (ALIGN_EPI) { if (wr == 0) PG8_BAR; }
        E(acc, cur, wr, wc, fr, fq);
        if (!has_next) break;
#pragma unroll
        for (int a = 0; a < 2; ++a)
#pragma unroll
            for (int b = 0; b < 2; ++b)
#pragma unroll
                for (int m = 0; m < 4; ++m)
#pragma unroll
                    for (int n = 0; n < 2; ++n) acc[a][b][m][n] = (f32x4){0.f, 0.f, 0.f, 0.f};
        cur = nxt; cA = nA; cB = nB; ++ui;
        if constexpr (ALIGN_EPI) { if (wr == 1) PG8_BAR; }
    }
    PG8_WAIT_V(0);
    if constexpr (!ALIGN_EPI) { if (wr == 0) PG8_BAR; }
    PG8_BAR;
#undef PG8_SA
#undef PG8_SB
#undef PG8_STAGE
#undef PG8_LDA
#undef PG8_LDB
#undef PG8_MMA
#undef PG8_WAIT_V
#undef PG8_WAIT_L
#undef PG8_BAR
#undef PG8_SCHED
}

typedef const f32x4 (&AccRef)[2][2][4][2];

struct EpiInProj {
    static constexpr bool PERM = true;
    bf16_t* O; const float* bias;
    __device__ __forceinline__ void operator()(AccRef acc, const Unit& u, int wr, int wc, int fr, int fq) const {
        const int row0 = u.pm * BM + wr * 64 + fr, col0 = u.pn * BM + wc * 32 + 8 * fq;
        const int kind = u.pn < 4 ? 0 : (u.pn < 8 ? 1 : (u.pn < 14 ? 2 : (u.pn < 26 ? 0 : 3)));
        f32x4 bv[2][2];
#pragma unroll
        for (int bj = 0; bj < 2; ++bj)
#pragma unroll
            for (int n = 0; n < 2; ++n) bv[bj][n] = *(const f32x4*)(bias + col0 + bj * HALF + 4 * n);
#pragma unroll
        for (int ai = 0; ai < 2; ++ai)
#pragma unroll
            for (int m = 0; m < 4; ++m) { bf16_t* rowp = O + (size_t)(row0 + ai * HALF + m * 16) * DIN + col0;
#pragma unroll
                for (int bj = 0; bj < 2; ++bj) { f32x4 v0 = acc[ai][bj][m][0] + bv[bj][0], v1 = acc[ai][bj][m][1] + bv[bj][1];
                    if (kind == 1) {
#pragma unroll
                        for (int j = 0; j < 4; ++j) { v0[j] = gelu_tanh(v0[j]); v1[j] = gelu_tanh(v1[j]); }
                    } else if (kind == 2) { v0 = v0 * 0.125f; v1 = v1 * 0.125f; }
                    else if (kind == 3) {
#pragma unroll
                        for (int j = 0; j < 4; ++j) { v0[j] = sigmoidf_(v0[j]); v1[j] = sigmoidf_(v1[j]); }
                    }
                    u32x4 w; w.x = cvt_pk_bf16(v0[0], v0[1]); w.y = cvt_pk_bf16(v0[2], v0[3]); w.z = cvt_pk_bf16(v1[0], v1[1]); w.w = cvt_pk_bf16(v1[2], v1[3]);
                    *(u32x4*)(rowp + bj * HALF) = w; } }
    }
};
struct EpiProjRnn {
    static constexpr bool PERM = false;
    const bf16_t* proj; float* part;
    __device__ __forceinline__ void operator()(AccRef acc, const Unit& u, int wr, int wc, int fr, int fq) const {
        const int row0 = u.pm * BM + wr * 64 + fr, col0 = u.pn * BM + wc * 32 + 4 * fq;
#pragma unroll
        for (int ai = 0; ai < 2; ++ai)
#pragma unroll
            for (int m = 0; m < 4; ++m) { const size_t row = (size_t)(row0 + ai * HALF + m * 16);
#pragma unroll
                for (int bj = 0; bj < 2; ++bj)
#pragma unroll
                    for (int n = 0; n < 2; ++n) { const int c = col0 + bj * HALF + n * 16;
                        const u32x2 gw = *(const u32x2*)(proj + row * DIN + C_GRNN + c);
                        const f32x4 gt = (f32x4){bflo(gw.x), bfhi(gw.x), bflo(gw.y), bfhi(gw.y)};
                        *(f32x4*)(part + row * D + c) = gt * acc[ai][bj][m][n]; } }
    }
};
struct EpiProjAtt {
    static constexpr bool PERM = false;
    const bf16_t* proj; const float* part; bf16_t* merged;
    __device__ __forceinline__ void operator()(AccRef acc, const Unit& u, int wr, int wc, int fr, int fq) const {
        const int row0 = u.pm * BM + wr * 64 + fr, col0 = u.pn * BM + wc * 32 + 4 * fq;
#pragma unroll
        for (int ai = 0; ai < 2; ++ai)
#pragma unroll
            for (int m = 0; m < 4; ++m) { const size_t row = (size_t)(row0 + ai * HALF + m * 16);
#pragma unroll
                for (int bj = 0; bj < 2; ++bj)
#pragma unroll
                    for (int n = 0; n < 2; ++n) { const int c = col0 + bj * HALF + n * 16;
                        const u32x2 gw = *(const u32x2*)(proj + row * DIN + C_GATT + c);
                        const f32x4 gt = (f32x4){bflo(gw.x), bfhi(gw.x), bflo(gw.y), bfhi(gw.y)};
                        const f32x4 v = *(const f32x4*)(part + row * D + c) + gt * acc[ai][bj][m][n];
                        u32x2 w; w.x = cvt_pk_bf16(v[0], v[1]); w.y = cvt_pk_bf16(v[2], v[3]);
                        *(u32x2*)(merged + row * D + c) = w; } }
    }
};
struct EpiF32Res {
    static constexpr bool PERM = false;
    const float* base; float* out; int ldc; float scale;
    __device__ __forceinline__ void operator()(AccRef acc, const Unit& u, int wr, int wc, int fr, int fq) const {
        const int row0 = u.pm * BM + wr * 64 + fr, col0 = u.pn * BM + wc * 32 + 4 * fq;
#pragma unroll
        for (int ai = 0; ai < 2; ++ai)
#pragma unroll
            for (int m = 0; m < 4; ++m) { const size_t off = (size_t)(row0 + ai * HALF + m * 16) * ldc + col0;
#pragma unroll
                for (int bj = 0; bj < 2; ++bj)
#pragma unroll
                    for (int n = 0; n < 2; ++n) { f32x4 v = acc[ai][bj][m][n];
                        if (base) v = v + *(const f32x4*)(base + off + bj * HALF + n * 16) * scale;
                        *(f32x4*)(out + off + bj * HALF + n * 16) = v; } }
    }
};
struct EpiGateUp {
    static constexpr bool PERM = true;
    bf16_t* H;
    __device__ __forceinline__ void operator()(AccRef acc, const Unit& u, int wr, int wc, int fr, int fq) const {
        const int row0 = u.pm * BM + wr * 64 + fr, col0 = u.pn * HALF + wc * 32 + 8 * fq;
#pragma unroll
        for (int ai = 0; ai < 2; ++ai)
#pragma unroll
            for (int m = 0; m < 4; ++m) { bf16_t* rowp = H + (size_t)(row0 + ai * HALF + m * 16) * DE + col0;
                f32x4 o[2];
#pragma unroll
                for (int n = 0; n < 2; ++n) { const f32x4 gt = acc[ai][0][m][n], up = acc[ai][1][m][n];
#pragma unroll
                    for (int j = 0; j < 4; ++j) o[n][j] = gt[j] / (1.0f + __expf(-gt[j])) * up[j]; }
                u32x4 w; w.x = cvt_pk_bf16(o[0][0], o[0][1]); w.y = cvt_pk_bf16(o[0][2], o[0][3]); w.z = cvt_pk_bf16(o[1][0], o[1][1]); w.w = cvt_pk_bf16(o[1][2], o[1][3]);
                *(u32x4*)rowp = w; }
    }
};
struct EpiDown {
    static constexpr bool PERM = true;
    bf16_t* Y; const float* wslot; float* out; int mt_r;
    __device__ __forceinline__ void operator()(AccRef acc, const Unit& u, int wr, int wc, int fr, int fq) const {
        const int col0 = u.pn * BM + wc * 32 + 8 * fq;
        if (u.pm < mt_r) {
            const int row0 = u.pm * BM + wr * 64 + fr;
#pragma unroll
            for (int ai = 0; ai < 2; ++ai)
#pragma unroll
                for (int m = 0; m < 4; ++m) { const size_t row = (size_t)(row0 + ai * HALF + m * 16); const float w8 = wslot[row]; bf16_t* rowp = Y + row * D + col0;
#pragma unroll
                    for (int bj = 0; bj < 2; ++bj) { const f32x4 v0 = acc[ai][bj][m][0] * w8, v1 = acc[ai][bj][m][1] * w8;
                        u32x4 w; w.x = cvt_pk_bf16(v0[0], v0[1]); w.y = cvt_pk_bf16(v0[2], v0[3]); w.z = cvt_pk_bf16(v1[0], v1[1]); w.w = cvt_pk_bf16(v1[2], v1[3]);
                        *(u32x4*)(rowp + bj * HALF) = w; } }
        } else {
            const int row0 = (u.pm - mt_r) * BM + wr * 64 + fr;
#pragma unroll
            for (int ai = 0; ai < 2; ++ai)
#pragma unroll
                for (int m = 0; m < 4; ++m) { float* rowp = out + (size_t)(row0 + ai * HALF + m * 16) * D + col0;
#pragma unroll
                    for (int bj = 0; bj < 2; ++bj)
#pragma unroll
                        for (int n = 0; n < 2; ++n) { float* p = rowp + bj * HALF + 4 * n; *(f32x4*)p = *(const f32x4*)p * ALPHA + acc[ai][bj][m][n]; } }
        }
    }
};
}

#define XB_TMO      128
#define XB_XCNT(j)  (256  + 64 * (j))
#define XB_XSUB(j)  (1280 + 64 * (j))
#define XB_XGEN(j)  (2304 + 64 * (j))
#define XB_TOP      3328
#define XB_TOPGEN   3392
#define XCD_BAR_WORDS 3456
#define XB_SPIN_CAP (1u << 18)
__device__ __forceinline__ unsigned xb_ld(unsigned* p)              { return __hip_atomic_load(p, __ATOMIC_RELAXED, __HIP_MEMORY_SCOPE_AGENT); }
__device__ __forceinline__ unsigned xb_add(unsigned* p, unsigned v) { return __hip_atomic_fetch_add(p, v, __ATOMIC_RELAXED, __HIP_MEMORY_SCOPE_AGENT); }
__device__ __forceinline__ unsigned xb_xcc_id() { return (unsigned)__builtin_amdgcn_s_getreg((3 << 11) | 20) & 0xFu; }
#define XB_SPIN(cond, bar) do { unsigned _sp = 0; while (cond) { __builtin_amdgcn_s_sleep(1); \
    if ((++_sp & 255u) == 0u) { if (xb_ld(&(bar)[XB_TMO])) break; if (_sp > XB_SPIN_CAP) { atomicAdd(&(bar)[XB_TMO], 1u); break; } } } } while (0)
struct XcdBarrier { unsigned* bar; unsigned x; volatile LAS unsigned* st; };
__device__ __forceinline__ XcdBarrier xcd_barrier_post(unsigned* bar, volatile LAS unsigned* st) {
    XcdBarrier b; b.bar = bar; b.x = xb_xcc_id(); b.st = st;
    if (threadIdx.x == 0) (void)xb_add(&bar[XB_XCNT(b.x)], 1u);
    return b;
}
__device__ __forceinline__ void xcd_barrier_complete(unsigned* bar, unsigned x, unsigned& nloc, unsigned& nx) {
    const unsigned G = gridDim.x * gridDim.y * gridDim.z;
    unsigned sum, cnt, mine, sp = 0u;
    for (;;) {
        sum = 0u; cnt = 0u; mine = 0u;
#pragma unroll
        for (unsigned j = 0; j < 16; ++j) { const unsigned c = xb_ld(&bar[XB_XCNT(j)]); sum += c; cnt += (c > 0u) ? 1u : 0u; mine = (j == x) ? c : mine; }
        if (sum == G) break;
        __builtin_amdgcn_s_sleep(1);
        if ((++sp & 255u) == 0u) { if (xb_ld(&bar[XB_TMO])) break; if (sp > XB_SPIN_CAP) { atomicAdd(&bar[XB_TMO], 1u); break; } }
    }
    nloc = mine > 0u ? mine : 1u; nx = cnt > 0u ? cnt : 1u;
}
__device__ __forceinline__ void xcd_barrier(const XcdBarrier& b) {
    asm volatile("s_waitcnt vmcnt(0)" ::: "memory");
    __syncthreads();
    if (threadIdx.x == 0) {
        unsigned* bar = b.bar;
        __builtin_amdgcn_s_waitcnt(0);
        unsigned nloc = b.st[0], nx = b.st[1];
        if (nloc == 0u) { xcd_barrier_complete(bar, b.x, nloc, nx); b.st[0] = nloc; b.st[1] = nx; }
        const unsigned old = xb_add(&bar[XB_XSUB(b.x)], 1u);
        const unsigned gen = old / nloc;
        if (old + 1u == (gen + 1u) * nloc) {
            __builtin_amdgcn_fence(__ATOMIC_RELEASE, "agent");
            asm volatile("s_waitcnt vmcnt(0)" ::: "memory");
            const unsigned og = xb_add(&bar[XB_TOP], 1u);
            const unsigned tg = og / nx;
            if (og + 1u == (tg + 1u) * nx) xb_add(&bar[XB_TOPGEN], 1u);
            else XB_SPIN(xb_ld(&bar[XB_TOPGEN]) == tg, bar);
            __builtin_amdgcn_fence(__ATOMIC_ACQUIRE, "agent");
            xb_add(&bar[XB_XGEN(b.x)], 1u);
            asm volatile("s_waitcnt vmcnt(0)" ::: "memory");
        } else {
            XB_SPIN(xb_ld(&bar[XB_XGEN(b.x)]) == gen, bar);
            __builtin_amdgcn_fence(__ATOMIC_ACQUIRE, "agent");
            asm volatile("s_waitcnt vmcnt(0)" ::: "memory");
        }
    }
    __syncthreads();
}

struct Params { const float* in[26]; float* out; unsigned char* ws; int lo, hi; unsigned char bucket[3][136]; };
static_assert(sizeof(Params) == 26 * 8 + 8 + 8 + 8 + 408, "Params has no padding holes");

__device__ __forceinline__ void tr128(const float* src, int ld_src, bf16* dst, int ld_dst, LAS float* tile, int tid) {
    f32x4 v[8];
#pragma unroll
    for (int it = 0; it < 8; ++it) { const int id = it * 512 + tid, k = id >> 5, c4 = id & 31; v[it] = *(const f32x4*)(src + (size_t)k * ld_src + c4 * 4); }
#pragma unroll
    for (int it = 0; it < 8; ++it) { const int id = it * 512 + tid, k = id >> 5, c4 = id & 31; LAS float* p = tile + k * 129 + c4 * 4; p[0] = v[it][0]; p[1] = v[it][1]; p[2] = v[it][2]; p[3] = v[it][3]; }
    __syncthreads();
#pragma unroll
    for (int it = 0; it < 4; ++it) { const int id = it * 512 + tid, n = id >> 4, kc = id & 15; const LAS float* s = tile + (kc * 8) * 129 + n;
        u32x4 o; o.x = pk2(s[0], s[129]); o.y = pk2(s[2 * 129], s[3 * 129]); o.z = pk2(s[4 * 129], s[5 * 129]); o.w = pk2(s[6 * 129], s[7 * 129]);
        *(u32x4*)(dst + (size_t)n * ld_dst + kc * 8) = o; }
    __syncthreads();
}
__device__ __forceinline__ void tr_matrix_item(const float* W, int K, int N, bf16* WT, int item, LAS float* tile, int tid) {
    const int nbn = N / 128, kb = item / nbn, nb = item % nbn;
    tr128(W + (size_t)kb * 128 * N + nb * 128, N, WT + (size_t)nb * 128 * K + kb * 128, K, tile, tid);
}

__device__ __forceinline__ void rglru_chunk(const Params& p, int item, LAS float* xcs, int lane) {
    const bf16* proj = (const bf16*)(p.ws + WS_PROJ);
    bf16* hloc = (bf16*)(p.ws + WS_HLOC); bf16* cuma = (bf16*)(p.ws + WS_CUMA);
    float* sumA = (float*)(p.ws + WS_SUMA); float* sumH = (float*)(p.ws + WS_SUMH);
    const int c = item % NCH, h = (item / NCH) % 16, b = item / (NCH * 16);
    const int ch = h * 64 + lane;
    float wa[64], wi[64];
#pragma unroll
    for (int i = 0; i < 64; ++i) { wa[i] = p.in[5][(size_t)(h * 64 + i) * 64 + lane]; wi[i] = p.in[7][(size_t)(h * 64 + i) * 64 + lane]; }
    const float cw0 = p.in[3][ch], cw1 = p.in[3][1024 + ch], cw2 = p.in[3][2048 + ch], cw3 = p.in[3][3072 + ch], cb = p.in[4][ch];
    const float ba = p.in[6][ch], bi = p.in[8][ch];
    const float sp8 = 8.0f * log1pf(expf(-p.in[9][ch]));
    const int t0 = c * TCH;
    const bf16* xr = proj + (size_t)(b * SEQ) * DIN + C_XR + ch;
    float xm3 = 0.f, xm2 = 0.f, xm1 = 0.f;
    if (t0 > 0) { xm3 = bf1(xr[(size_t)(t0 - 3) * DIN]); xm2 = bf1(xr[(size_t)(t0 - 2) * DIN]); xm1 = bf1(xr[(size_t)(t0 - 1) * DIN]); }
    float hst = 0.f, pa = 1.f;
    for (int tb = 0; tb < TCH; tb += 8) {
        float xv[8], xc[8];
#pragma unroll
        for (int j = 0; j < 8; ++j) xv[j] = bf1(xr[(size_t)(t0 + tb + j) * DIN]);
#pragma unroll
        for (int j = 0; j < 8; ++j) { xc[j] = cb + cw0 * xm3 + cw1 * xm2 + cw2 * xm1 + cw3 * xv[j]; xm3 = xm2; xm2 = xm1; xm1 = xv[j]; xcs[j * 64 + lane] = xc[j]; }
        asm volatile("s_waitcnt lgkmcnt(0)" ::: "memory");
#pragma unroll
        for (int j = 0; j < 8; ++j) {
            float ra = ba, ri = bi;
#pragma unroll
            for (int i = 0; i < 64; i += 4) { const f32x4 x4 = *(const LAS f32x4*)(xcs + j * 64 + i);
                ra += x4[0] * wa[i] + x4[1] * wa[i + 1] + x4[2] * wa[i + 2] + x4[3] * wa[i + 3];
                ri += x4[0] * wi[i] + x4[1] * wi[i + 1] + x4[2] * wi[i + 2] + x4[3] * wi[i + 3]; }
            const float r = sigmoidf_(ra), ig = sigmoidf_(ri);
            const float la = -sp8 * r, a = __expf(la);
            const float uu = sqrtf(-expm1f(2.0f * la)) * (ig * xc[j]);
            hst = a * hst + uu; pa = pa * a;
            const size_t o = (size_t)(b * SEQ + t0 + tb + j) * D + ch;
            hloc[o] = (bf16)f2bf(hst); cuma[o] = (bf16)f2bf(pa);
        }
        asm volatile("s_waitcnt lgkmcnt(0)" ::: "memory");
    }
    sumA[(size_t)(b * NCH + c) * D + ch] = pa; sumH[(size_t)(b * NCH + c) * D + ch] = hst;
}

__device__ __forceinline__ void attn_item(const Params& p, int item, LAS unsigned char* vt, const LAS float* btab_all, int lane) {
    const bf16* proj = (const bf16*)(p.ws + WS_PROJ);
    const int rq = item & 127, bh = item >> 7, head = bh % 24, b = bh / 24;
    const int g = head >> 3, hh = head & 7, dil = (g == 0) ? 1 : (g == 1 ? 4 : 16), nqb = 128 / dil;
    const int res = rq / nqb, qb = rq % nqb, l0 = qb * 32;
    const int r = lane & 31, hf = lane >> 5;
    const LAS float* btab = btab_all + (g * 8 + hh) * 132;
    const size_t tokbase = (size_t)b * SEQ;
    bf16x8 qf[4];
    { const bf16* qp = proj + (tokbase + (size_t)(l0 + r) * dil + res) * DIN + C_Q + head * 64 + 8 * hf;
#pragma unroll
      for (int s = 0; s < 4; ++s) qf[s] = *(const bf16x8*)(qp + 16 * s); }
    f32x16 o0, o1;
#pragma unroll
    for (int i = 0; i < 16; ++i) { o0[i] = 0.f; o1[i] = 0.f; }
    float mrun = -1e30f, lrun = 0.f;
    for (int kt = 0; kt < 5; ++kt) {
        const int k0 = l0 - 128 + 32 * kt;
        if (k0 < 0) continue;
        const bf16* kp = proj + (tokbase + (size_t)(k0 + r) * dil + res) * DIN + C_K + head * 64 + 8 * hf;
        bf16x8 kf[4];
#pragma unroll
        for (int s = 0; s < 4; ++s) kf[s] = *(const bf16x8*)(kp + 16 * s);
        u32x4 va[2][2];
#pragma unroll
        for (int it = 0; it < 2; ++it) { const int kp2 = (lane >> 3) + 8 * it, dc = lane & 7;
#pragma unroll
            for (int e = 0; e < 2; ++e) va[it][e] = *(const u32x4*)(proj + (tokbase + (size_t)(k0 + 2 * kp2 + e) * dil + res) * DIN + C_V + head * 64 + 8 * dc); }
        f32x16 st;
#pragma unroll
        for (int i = 0; i < 16; ++i) st[i] = 0.f;
#pragma unroll
        for (int s = 0; s < 4; ++s) st = __builtin_amdgcn_mfma_f32_32x32x16_bf16(kf[s], qf[s], st, 0, 0, 0);
#pragma unroll
        for (int it = 0; it < 2; ++it) { const int kp2 = (lane >> 3) + 8 * it, dc = lane & 7;
#pragma unroll
            for (int w = 0; w < 4; ++w) { const unsigned a0 = va[it][0][w], a1 = va[it][1][w];
                *(LAS unsigned*)(vt + (8 * dc + 2 * w) * 72 + 4 * kp2) = (a0 & 0xffffu) | (a1 << 16);
                *(LAS unsigned*)(vt + (8 * dc + 2 * w + 1) * 72 + 4 * kp2) = (a0 >> 16) | (a1 & 0xffff0000u); } }
        float sv[16]; float mt = -1e30f;
#pragma unroll
        for (int i = 0; i < 16; ++i) { const int kk = (i & 3) + 8 * (i >> 2) + 4 * hf; const int rel = (l0 + r) - (k0 + kk);
            const bool ok = (rel >= 0) && (rel <= 128); const float bs = btab[ok ? rel : 0];
            sv[i] = ok ? st[i] + bs : -1e30f; mt = fmaxf(mt, sv[i]); }
        mt = fmaxf(mt, __shfl_xor(mt, 32));
        const float mnew = fmaxf(mrun, mt), al = __expf(mrun - mnew);
        float ps = 0.f; float pv[16];
#pragma unroll
        for (int i = 0; i < 16; ++i) { pv[i] = __expf(sv[i] - mnew); ps += pv[i]; }
        lrun = lrun * al + ps; mrun = mnew;
#pragma unroll
        for (int i = 0; i < 16; ++i) { o0[i] *= al; o1[i] *= al; }
        bf16x8 pf[2];
#pragma unroll
        for (int s = 0; s < 2; ++s) { u32x4 w; w.x = pk2(pv[8 * s], pv[8 * s + 1]); w.y = pk2(pv[8 * s + 2], pv[8 * s + 3]); w.z = pk2(pv[8 * s + 4], pv[8 * s + 5]); w.w = pk2(pv[8 * s + 6], pv[8 * s + 7]);
            pf[s] = __builtin_bit_cast(bf16x8, w); }
        asm volatile("s_waitcnt lgkmcnt(0)" ::: "memory");
#pragma unroll
        for (int s = 0; s < 2; ++s) {
            { const LAS unsigned char* q = vt + (r) * 72 + (16 * s + 4 * hf) * 2; u32x4 w; const u32x2 lo = *(const LAS u32x2*)q, hi = *(const LAS u32x2*)(q + 16); w.x = lo.x; w.y = lo.y; w.z = hi.x; w.w = hi.y;
              o0 = __builtin_amdgcn_mfma_f32_32x32x16_bf16(__builtin_bit_cast(bf16x8, w), pf[s], o0, 0, 0, 0); }
            { const LAS unsigned char* q = vt + (32 + r) * 72 + (16 * s + 4 * hf) * 2; u32x4 w; const u32x2 lo = *(const LAS u32x2*)q, hi = *(const LAS u32x2*)(q + 16); w.x = lo.x; w.y = lo.y; w.z = hi.x; w.w = hi.y;
              o1 = __builtin_amdgcn_mfma_f32_32x32x16_bf16(__builtin_bit_cast(bf16x8, w), pf[s], o1, 0, 0, 0); }
        }
        asm volatile("s_waitcnt lgkmcnt(0)" ::: "memory");
    }
    const float ltot = lrun + __shfl_xor(lrun, 32), inv = 1.0f / ltot;
    const size_t tok = tokbase + (size_t)(l0 + r) * dil + res;
    bf16* ao = (bf16*)(p.ws + WS_AO) + ((size_t)g * T + tok) * 512 + hh * 64;
#pragma unroll
    for (int q4 = 0; q4 < 4; ++q4) {
        u32x2 w; w.x = pk2(o0[4 * q4] * inv, o0[4 * q4 + 1] * inv); w.y = pk2(o0[4 * q4 + 2] * inv, o0[4 * q4 + 3] * inv);
        *(u32x2*)(ao + 8 * q4 + 4 * hf) = w;
        u32x2 w1; w1.x = pk2(o1[4 * q4] * inv, o1[4 * q4 + 1] * inv); w1.y = pk2(o1[4 * q4 + 2] * inv, o1[4 * q4 + 3] * inv);
        *(u32x2*)(ao + 32 + 8 * q4 + 4 * hf) = w1;
    }
    if (hf == 0) ((float*)(p.ws + WS_LSE))[((size_t)g * T + tok) * 8 + hh] = mrun + __logf(ltot);
}

__device__ __forceinline__ void build_tile_table(const LAS unsigned* lcnt, LAS unsigned char* lds, int tid) {
    LAS int* tbase = (LAS int*)(lds + L_TBASE); LAS unsigned short* tile_e = (LAS unsigned short*)(lds + L_TILEE);
    __syncthreads();
    if (tid == 0) { int acc = 0; for (int e = 0; e < NE; ++e) { tbase[e] = acc; acc += ((int)lcnt[e] + 255) >> 8; } tbase[NE] = acc; tbase[NE + 1] = acc + SH_TILES; }
    __syncthreads();
    if (tid < NE) { const int a = tbase[tid], bnd = tbase[tid + 1]; for (int i = a; i < bnd; ++i) tile_e[i] = (unsigned short)tid; }
    if (tid < SH_TILES) tile_e[tbase[NE] + tid] = (unsigned short)NE;
    __syncthreads();
}
__device__ __forceinline__ void build_tile_table_g(const Params& p, LAS unsigned char* lds, int tid) {
    LAS unsigned* lc = (LAS unsigned*)(lds + L_LCNT);
    const unsigned* cnt = (const unsigned*)(p.ws + WS_CTL) + CW_CNT;
    if (tid < NE) lc[tid] = cnt[tid];
    build_tile_table(lc, lds, tid);
}

__global__ void __launch_bounds__(512, 2) fwd_kernel(Params p) {
    extern __shared__ __attribute__((aligned(16))) unsigned char lds_raw[];
    LAS unsigned char* lds = (LAS unsigned char*)lds_raw;
    const int tid = threadIdx.x, lane = tid & 63, wave = __builtin_amdgcn_readfirstlane(tid >> 6);
    const int G = gridDim.x, bid = blockIdx.x;
    const int gw = bid * 8 + wave, NGW = G * 8;
    const size_t gtid = (size_t)bid * 512 + tid, NTH = (size_t)G * 512;
    unsigned char* ws = p.ws;
    volatile LAS unsigned* misc = (volatile LAS unsigned*)(lds + L_MISC);
    if (tid < 16) misc[tid] = 0u;
    { LAS float* bt = (LAS float*)(lds + L_BTAB);
      for (int i = tid; i < 3 * 8 * 132; i += 512) { const int g = i / (8 * 132), hh = (i / 132) % 8, rel = i % 132; bt[i] = (rel <= 128) ? p.in[12][(int)p.bucket[g][rel] * 24 + g * 8 + hh] : 0.f; } }
    __syncthreads();
#if N_LAUNCHES == 1
    XcdBarrier bar = xcd_barrier_post((unsigned*)(ws + WS_CTL) + CW_BAR, misc);
#define GRID_BAR() xcd_barrier(bar)
#else
#define GRID_BAR() do { } while (0)
#endif
    const int lo = p.lo, hi = p.hi;
#define IN(k) (lo <= (k) && (k) < hi)
#define SEAM(k) do { if (IN(k) && IN((k) + 1)) GRID_BAR(); } while (0)
#ifndef PROBE_PHASE
#define PROBE_PHASE -1
#endif
#define REPS(k) for (int _rep = 0; _rep < ((PROBE_PHASE == (k)) ? 2 : 1); ++_rep)
#define REP_BAR() do { if (_rep) GRID_BAR(); } while (0)

    if (IN(0)) REPS(0) { REP_BAR();
        LAS float* tile = (LAS float*)lds;
        for (int it = bid; it < 720; it += G) {
            int r = it;
            if (r < 544) { tr_matrix_item(p.in[1], 1024, DIN, (bf16*)(ws + WS_WINT), r, tile, tid); continue; } r -= 544;
            if (r < 64) { tr_matrix_item(p.in[10], 1024, 1024, (bf16*)(ws + WS_WPRT), r, tile, tid); continue; } r -= 64;
            if (r < 32) { tr_matrix_item(p.in[11], 512, 1024, (bf16*)(ws + WS_WPAT), r, tile, tid); continue; } r -= 32;
            if (r < 64) { tr_matrix_item(p.in[13], 1024, 1024, (bf16*)(ws + WS_WOT), r, tile, tid); continue; } r -= 64;
            tr_matrix_item(p.in[16], 1024, 256, (bf16*)(ws + WS_WRT), r, tile, tid);
        }
        const f32x4* x4 = (const f32x4*)p.in[0]; u32x4* xb = (u32x4*)(ws + WS_XB);
        for (size_t i = gtid; i < (size_t)T * D / 8; i += NTH) { const f32x4 a = x4[2 * i], b = x4[2 * i + 1];
            u32x4 o; o.x = pk2(a[0], a[1]); o.y = pk2(a[2], a[3]); o.z = pk2(b[0], b[1]); o.w = pk2(b[2], b[3]); xb[i] = o; }
    }
    SEAM(0);
    if (IN(1)) REPS(1) { REP_BAR();
        pg8::Gemm g{(const bf16*)(ws + WS_XB), (const bf16*)(ws + WS_WINT), 1024}; pg8::StaticOrder S; S.init(T, DIN, G, bid);
        pg8::EpiInProj E{(bf16*)(ws + WS_PROJ), p.in[2]};
        pg8::gemm_phase<pg8::EpiInProj, pg8::StaticOrder, true>(lds, g, S, E);
    }
    SEAM(1);
    if (IN(2)) REPS(2) { REP_BAR();
        LAS float* xcs = (LAS float*)(lds + wave * 2048);
        for (int rr = 0; rr < (PROBE_PHASE == 20 ? 2 : 1); ++rr)
        for (int it = gw; it < NB * 16 * NCH; it += NGW) rglru_chunk(p, it, xcs, lane);
        LAS unsigned char* vt = lds + 16384 + wave * 4608;
        const LAS float* bt = (const LAS float*)(lds + L_BTAB);
        for (int rr = 0; rr < (PROBE_PHASE == 21 ? 2 : 1); ++rr)
        for (int it = gw; it < NB * 24 * 128; it += NGW) attn_item(p, it, vt, bt, lane);
    }
    SEAM(2);
    if (IN(3)) REPS(3) { REP_BAR();
        const bf16* proj = (const bf16*)(ws + WS_PROJ);
        const bf16* hloc = (const bf16*)(ws + WS_HLOC); const bf16* cuma = (const bf16*)(ws + WS_CUMA);
        const float* sumA = (const float*)(ws + WS_SUMA); const float* sumH = (const float*)(ws + WS_SUMH);
        bf16* yrnn = (bf16*)(ws + WS_YRNN);
        for (int it = bid; it < NB * NCH; it += G) {
            const int b = it / NCH, c = it % NCH, ch0 = (tid & 127) * 8, ts = tid >> 7;
            float H[8];
#pragma unroll
            for (int j = 0; j < 8; ++j) H[j] = 0.f;
            for (int k = 0; k < c; ++k) { const float* pa = sumA + (size_t)(b * NCH + k) * D + ch0; const float* ph = sumH + (size_t)(b * NCH + k) * D + ch0;
                const f32x4 a0 = *(const f32x4*)pa, a1 = *(const f32x4*)(pa + 4), h0 = *(const f32x4*)ph, h1 = *(const f32x4*)(ph + 4);
#pragma unroll
                for (int j = 0; j < 4; ++j) { H[j] = a0[j] * H[j] + h0[j]; H[4 + j] = a1[j] * H[4 + j] + h1[j]; } }
            for (int tt = ts; tt < TCH; tt += 4) { const size_t t = (size_t)b * SEQ + c * TCH + tt;
                const u32x4 hl = *(const u32x4*)(hloc + t * D + ch0), ca = *(const u32x4*)(cuma + t * D + ch0), gg = *(const u32x4*)(proj + t * DIN + C_GR + ch0);
                u32x4 o;
#pragma unroll
                for (int w = 0; w < 4; ++w) { const float y0 = (bflo(hl[w]) + bflo(ca[w]) * H[2 * w]) * bflo(gg[w]), y1 = (bfhi(hl[w]) + bfhi(ca[w]) * H[2 * w + 1]) * bfhi(gg[w]); o[w] = pk2(y0, y1); }
                *(u32x4*)(yrnn + t * D + ch0) = o; }
        }
        const bf16* ao = (const bf16*)(ws + WS_AO); const float* lse = (const float*)(ws + WS_LSE); bf16* yatt = (bf16*)(ws + WS_YATT);
        for (size_t i = gtid; i < (size_t)T * 64; i += NTH) { const size_t t = i >> 6; const int c8 = (int)(i & 63), hh = c8 >> 3;
            const float l0 = lse[t * 8 + hh], l1 = lse[((size_t)T + t) * 8 + hh], l2 = lse[((size_t)2 * T + t) * 8 + hh];
            const float mx = fmaxf(l0, fmaxf(l1, l2)); float w0 = __expf(l0 - mx), w1 = __expf(l1 - mx), w2 = __expf(l2 - mx); const float inv = 1.0f / (w0 + w1 + w2); w0 *= inv; w1 *= inv; w2 *= inv;
            const u32x4 a = *(const u32x4*)(ao + t * 512 + c8 * 8), bq = *(const u32x4*)(ao + ((size_t)T + t) * 512 + c8 * 8), cq = *(const u32x4*)(ao + ((size_t)2 * T + t) * 512 + c8 * 8);
            u32x4 o;
#pragma unroll
            for (int w = 0; w < 4; ++w) o[w] = pk2(w0 * bflo(a[w]) + w1 * bflo(bq[w]) + w2 * bflo(cq[w]), w0 * bfhi(a[w]) + w1 * bfhi(bq[w]) + w2 * bfhi(cq[w]));
            *(u32x4*)(yatt + t * 512 + c8 * 8) = o; }
    }
    SEAM(3);
    if (IN(4)) REPS(4) { REP_BAR();
        pg8::StaticOrder S; S.init(T, D, G, bid);
        { pg8::Gemm g{(const bf16*)(ws + WS_YRNN), (const bf16*)(ws + WS_WPRT), 1024};
          pg8::EpiProjRnn E{(const bf16*)(ws + WS_PROJ), p.out};
          pg8::gemm_phase<pg8::EpiProjRnn, pg8::StaticOrder, true>(lds, g, S, E); }
        asm volatile("s_waitcnt vmcnt(0)" ::: "memory"); __syncthreads();
        { pg8::Gemm g{(const bf16*)(ws + WS_YATT), (const bf16*)(ws + WS_WPAT), 512};
          pg8::EpiProjAtt E{(const bf16*)(ws + WS_PROJ), p.out, (bf16*)(ws + WS_MERGED)};
          pg8::gemm_phase<pg8::EpiProjAtt, pg8::StaticOrder, true>(lds, g, S, E); }
    }
    SEAM(4);
    if (IN(5)) REPS(5) { REP_BAR();
        pg8::Gemm g{(const bf16*)(ws + WS_MERGED), (const bf16*)(ws + WS_WOT), 1024}; pg8::StaticOrder S; S.init(T, D, G, bid);
        pg8::EpiF32Res E{p.in[0], (float*)(ws + WS_PRELN), D, ALPHA};
        pg8::gemm_phase<pg8::EpiF32Res, pg8::StaticOrder, true>(lds, g, S, E);
    }
    SEAM(5);
    if (IN(6)) REPS(6) { REP_BAR();
        const float* preln = (const float*)(ws + WS_PRELN); bf16* x1b = (bf16*)(ws + WS_X1B);
        for (int row = gw; row < T; row += NGW) {
            const f32x4* xr = (const f32x4*)(preln + (size_t)row * D) + lane; f32x4 v[4]; float s = 0.f;
#pragma unroll
            for (int j = 0; j < 4; ++j) { v[j] = xr[64 * j]; s += (v[j][0] + v[j][1]) + (v[j][2] + v[j][3]); }
            const float mean = wave_sum(s) * (1.f / D); float s2 = 0.f;
#pragma unroll
            for (int j = 0; j < 4; ++j) { v[j] = v[j] - mean; s2 += (v[j][0] * v[j][0] + v[j][1] * v[j][1]) + (v[j][2] * v[j][2] + v[j][3] * v[j][3]); }
            const float rstd = 1.f / sqrtf(wave_sum(s2) * (1.f / D) + LN_EPS);
#pragma unroll
            for (int j = 0; j < 4; ++j) { const f32x4 gm = ((const f32x4*)p.in[14])[lane + 64 * j], bt = ((const f32x4*)p.in[15])[lane + 64 * j];
                const f32x4 o = v[j] * rstd * gm + bt;
                ((f32x4*)(p.out + (size_t)row * D))[lane + 64 * j] = o;
                u32x2 w; w.x = pk2(o[0], o[1]); w.y = pk2(o[2], o[3]); ((u32x2*)(x1b + (size_t)row * D))[lane + 64 * j] = w; }
        }
        __syncthreads();
        LAS float* tile = (LAS float*)lds;
        for (int it = bid; it < 257 * 48; it += G) {
            const int e = it / 48, r = it % 48;
            if (r < 32) { const int up = r >> 4, q = r & 15, kb = q >> 1, nbk = q & 1;
                const float* W = (e < NE) ? p.in[up ? 19 : 18] + (size_t)e * 1024 * 256 : p.in[up ? 22 : 21];
                tr128(W + (size_t)kb * 128 * 256 + nbk * 128, 256, (bf16*)(ws + WS_WGU) + ((size_t)e * 512 + nbk * 256 + up * 128) * 1024 + kb * 128, 1024, tile, tid);
            } else { const int q = r - 32, kb = q >> 3, nb = q & 7;
                const float* W = (e < NE) ? p.in[20] + (size_t)e * 256 * 1024 : p.in[23];
                tr128(W + (size_t)kb * 128 * 1024 + nb * 128, 1024, (bf16*)(ws + WS_WD) + ((size_t)e * 1024 + nb * 128) * 256 + kb * 128, 256, tile, tid); }
        }
    }
    SEAM(6);
    if (IN(7)) REPS(7) { REP_BAR();
        pg8::Gemm g{(const bf16*)(ws + WS_X1B), (const bf16*)(ws + WS_WRT), 1024}; pg8::StaticOrder S; S.init(T, NE, G, bid);
        pg8::EpiF32Res E{nullptr, (float*)(ws + WS_LOGITS), NE, 0.f};
        pg8::gemm_phase<pg8::EpiF32Res, pg8::StaticOrder, true>(lds, g, S, E);
    }
    SEAM(7);
    if (IN(8)) REPS(8) { REP_BAR();
        const float* logits = (const float*)(ws + WS_LOGITS); LAS unsigned* lcnt = (LAS unsigned*)(lds + L_LCNT);
        __syncthreads(); if (tid < NE) lcnt[tid] = 0u; __syncthreads();
        int* eidx = (int*)(ws + WS_EIDX); float* gatew = (float*)(ws + WS_GATEW); int* rank = (int*)(ws + WS_RANK);
        const int g = lane & 7, tk = lane >> 3;
        float rb[32];
#pragma unroll
        for (int q = 0; q < 8; ++q) { const f32x4 r4 = ((const f32x4*)p.in[17])[g * 8 + q]; rb[4 * q] = r4[0]; rb[4 * q + 1] = r4[1]; rb[4 * q + 2] = r4[2]; rb[4 * q + 3] = r4[3]; }
        for (int task = gw; task < T / 8; task += NGW) {
            const int t = task * 8 + tk;
            const f32x4* z4 = (const f32x4*)(logits + (size_t)t * NE + g * 32);
            f32x4 zz[8];
#pragma unroll
            for (int q = 0; q < 8; ++q) zz[q] = z4[q];
            float sc[32], sel[32];
#pragma unroll
            for (int j = 0; j < 32; ++j) { sc[j] = 1.0f / (1.0f + __expf(-zz[j >> 2][j & 3])); sel[j] = sc[j] + rb[j]; }
            float m1 = fmaxf(sel[0], sel[1]), m2 = fminf(sel[0], sel[1]);
#pragma unroll
            for (int j = 2; j < 32; ++j) { const float v = sel[j]; m2 = fmaxf(m2, fminf(m1, v)); m1 = fmaxf(m1, v); }
            const float gs = m1 + m2; int rk = 0;
#pragma unroll
            for (int g3 = 0; g3 < 8; ++g3) { const float og = __shfl(gs, (lane & ~7) + g3); rk += (og > gs || (og == gs && g3 < g)) ? 1 : 0; }
            if (rk >= 4) {
#pragma unroll
                for (int j = 0; j < 32; ++j) sel[j] = -INFINITY;
            }
            int me = 0; float ms = 0.f, gsum = 0.f;
#pragma unroll
            for (int k = 0; k < 8; ++k) {
                float bv = sel[0], bs = sc[0]; int bj = 0;
#pragma unroll
                for (int j = 1; j < 32; ++j) { const bool gt = sel[j] > bv; bv = gt ? sel[j] : bv; bs = gt ? sc[j] : bs; bj = gt ? j : bj; }
                int bi = g * 32 + bj;
#pragma unroll
                for (int o = 1; o < 8; o <<= 1) { const float ov = __shfl_xor(bv, o), os = __shfl_xor(bs, o); const int oi = __shfl_xor(bi, o);
                    const bool tk2 = (ov > bv) || (ov == bv && oi < bi); bv = tk2 ? ov : bv; bs = tk2 ? os : bs; bi = tk2 ? oi : bi; }
                const bool own = (bi >> 5) == g; const int jj = bi & 31;
#pragma unroll
                for (int j = 0; j < 32; ++j) sel[j] = (own && j == jj) ? -INFINITY : sel[j];
                gsum += bs; if (g == k) { me = bi; ms = bs; }
            }
            const int rr = (int)__hip_atomic_fetch_add(&lcnt[me], 1u, __ATOMIC_RELAXED, __HIP_MEMORY_SCOPE_WORKGROUP);
            const size_t q = (size_t)t * 8 + g;
            eidx[q] = me; gatew[q] = ms * 2.5f / gsum; rank[q] = rr;
        }
        __syncthreads();
        if (tid < NE) ((unsigned*)(ws + WS_HIST))[(size_t)bid * NE + tid] = lcnt[tid];
    }
    SEAM(8);
    if (IN(9)) REPS(9) { REP_BAR();
        LAS unsigned* lcnt = (LAS unsigned*)(lds + L_LCNT); LAS unsigned* bbase = (LAS unsigned*)(lds + L_BBASE);
        __syncthreads();
        { const u32x4* hist4 = (const u32x4*)(ws + WS_HIST); const int e4 = tid & 63, part = tid >> 6; u32x4 tot = (u32x4){0u, 0u, 0u, 0u}, bs = tot;
          const int per = (G + 7) / 8, b0 = part * per, b1 = (b0 + per < G) ? b0 + per : G;
#pragma unroll 8
          for (int b = b0; b < b1; ++b) { const u32x4 v = hist4[(size_t)b * 64 + e4]; tot += v; if (b < bid) bs += v; }
          LAS u32x4* pt = (LAS u32x4*)lds; pt[part * 64 + e4] = tot; pt[512 + part * 64 + e4] = bs; }
        __syncthreads();
        if (tid < NE) { const LAS unsigned* pw = (const LAS unsigned*)lds; unsigned tot = 0u, bs = 0u;
#pragma unroll
            for (int pp = 0; pp < 8; ++pp) { tot += pw[pp * 256 + tid]; bs += pw[2048 + pp * 256 + tid]; }
            lcnt[tid] = tot; bbase[tid] = bs; if (bid == 0) ((unsigned*)(ws + WS_CTL))[CW_CNT + tid] = tot; }
        build_tile_table(lcnt, lds, tid);
        const LAS int* tbase = (const LAS int*)(lds + L_TBASE);
        const int* eidx = (const int*)(ws + WS_EIDX); const float* gatew = (const float*)(ws + WS_GATEW); const int* rank = (const int*)(ws + WS_RANK);
        int* slotof = (int*)(ws + WS_SLOTOF); int* tokslot = (int*)(ws + WS_TOKSLOT); float* wslot = (float*)(ws + WS_WSLOT);
        for (int task = gw; task < T / 8; task += NGW) {
            const int t = task * 8 + (lane >> 3); const size_t q = (size_t)t * 8 + (lane & 7);
            const int e = eidx[q]; const int slot = tbase[e] * 256 + (int)bbase[e] + rank[q]; tokslot[slot] = t; wslot[slot] = gatew[q]; slotof[q] = slot; }
        for (size_t i = gtid; i < (size_t)NE * 256; i += NTH) { const int e = (int)(i >> 8), j = (int)(i & 255); const int s = (int)lcnt[e] + j; if (s < (tbase[e + 1] - tbase[e]) * 256) { tokslot[tbase[e] * 256 + s] = 0; wslot[tbase[e] * 256 + s] = 0.f; } }
        const int sb = tbase[NE] * 256;
        for (size_t i = gtid; i < (size_t)T; i += NTH) { tokslot[sb + i] = (int)i; }
    }
    SEAM(9);
    if (IN(10)) REPS(10) { REP_BAR();
        build_tile_table_g(p, lds, tid);
        const LAS int* tbase = (const LAS int*)(lds + L_TBASE);
        pg8::GroupOrder<true> S; S.nN = 2; S.nwg = tbase[NE + 1] * 2; S.G = G; S.c = bid; S.tile_e = (const LAS unsigned short*)(lds + L_TILEE); S.tok = (const int*)(ws + WS_TOKSLOT); S.rowbytes = 2048u;
        pg8::Gemm g{(const bf16*)(ws + WS_X1B), (const bf16*)(ws + WS_WGU), 1024};
        pg8::EpiGateUp E{(bf16*)(ws + WS_H)};
        pg8::gemm_phase<pg8::EpiGateUp, pg8::GroupOrder<true>, true>(lds, g, S, E);
    }
    SEAM(10);
    if (IN(11)) REPS(11) { REP_BAR();
        build_tile_table_g(p, lds, tid);
        const LAS int* tbase = (const LAS int*)(lds + L_TBASE);
        pg8::GroupOrder<false> S; S.nN = 4; S.nwg = ((PROBE_PHASE == 11 && _rep == 0) ? tbase[NE] : tbase[NE + 1]) * 4; S.G = G; S.c = bid; S.tile_e = (const LAS unsigned short*)(lds + L_TILEE); S.tok = nullptr; S.rowbytes = 0u;
        pg8::Gemm g{(const bf16*)(ws + WS_H), (const bf16*)(ws + WS_WD), 256};
        pg8::EpiDown E{(bf16*)(ws + WS_Y), (const float*)(ws + WS_WSLOT), p.out, tbase[NE]};
        pg8::gemm_phase<pg8::EpiDown, pg8::GroupOrder<false>, true>(lds, g, S, E);
    }
    SEAM(11);
    if (IN(12)) REPS(12) { REP_BAR();
        const bf16* Y = (const bf16*)(ws + WS_Y); const int* slotof = (const int*)(ws + WS_SLOTOF);
        for (int t = gw; t < T; t += NGW) {
            float* orow = p.out + (size_t)t * D; float* wrow = (PROBE_PHASE == 12 && _rep == 0) ? (float*)(ws + WS_H) + (size_t)t * D : orow; float v[16];
            { const f32x4 a = *(const f32x4*)(orow + 8 * lane), b = *(const f32x4*)(orow + 8 * lane + 4), c = *(const f32x4*)(orow + 512 + 8 * lane), d = *(const f32x4*)(orow + 512 + 8 * lane + 4);
#pragma unroll
              for (int j = 0; j < 4; ++j) { v[j] = a[j]; v[4 + j] = b[j]; v[8 + j] = c[j]; v[12 + j] = d[j]; } }
            int sl[8];
#pragma unroll
            for (int k = 0; k < 8; ++k) sl[k] = slotof[(size_t)t * 8 + k];
#pragma unroll
            for (int k = 0; k < 8; ++k) { const bf16* yr = Y + (size_t)sl[k] * D; const u32x4 a = *(const u32x4*)(yr + 8 * lane), b = *(const u32x4*)(yr + 512 + 8 * lane);
#pragma unroll
                for (int w = 0; w < 4; ++w) { v[2 * w] += bflo(a[w]); v[2 * w + 1] += bfhi(a[w]); v[8 + 2 * w] += bflo(b[w]); v[8 + 2 * w + 1] += bfhi(b[w]); } }
            float s = 0.f;
#pragma unroll
            for (int j = 0; j < 16; ++j) s += v[j];
            const float mean = wave_sum(s) * (1.f / D); float s2 = 0.f;
#pragma unroll
            for (int j = 0; j < 16; ++j) { v[j] -= mean; s2 += v[j] * v[j]; }
            const float rstd = 1.f / sqrtf(wave_sum(s2) * (1.f / D) + LN_EPS);
            const float* gm = p.in[24]; const float* bt = p.in[25];
#pragma unroll
            for (int q = 0; q < 4; ++q) { const int c0 = (q >> 1) * 512 + 8 * lane + (q & 1) * 4; const f32x4 g4 = *(const f32x4*)(gm + c0), b4 = *(const f32x4*)(bt + c0); f32x4 o;
#pragma unroll
                for (int j = 0; j < 4; ++j) o[j] = v[4 * q + j] * rstd * g4[j] + b4[j];
                *(f32x4*)(wrow + c0) = o; }
        }
    }
#undef IN
#undef SEAM
}

extern "C" void kernel_launch(void* const* d_in, const int* in_sizes, int n_in, void* d_out, int out_size, void* d_ws, size_t ws_size, hipStream_t stream) {
    static int grid = 0;
    if (grid == 0) {
        if (n_in != 26 || in_sizes[0] != T * D || out_size != T * D || ws_size < WS_END) { fprintf(stderr, "kernel_launch: unexpected shapes / workspace (%d inputs, ws %zu < %zu)\n", n_in, ws_size, (size_t)WS_END); grid = -1; return; }
        int dev = 0, cus = 0, per_cu = 0;
        if (hipGetDevice(&dev) != hipSuccess || hipDeviceGetAttribute(&cus, hipDeviceAttributeMultiprocessorCount, dev) != hipSuccess) { grid = -1; return; }
        if (hipFuncSetAttribute((const void*)fwd_kernel, hipFuncAttributeMaxDynamicSharedMemorySize, LDS_BYTES) != hipSuccess) { fprintf(stderr, "kernel_launch: hipFuncSetAttribute failed\n"); grid = -1; return; }
        if (hipOccupancyMaxActiveBlocksPerMultiprocessor(&per_cu, (const void*)fwd_kernel, 512, LDS_BYTES) != hipSuccess || per_cu < 1) { fprintf(stderr, "kernel_launch: occupancy query says %d\n", per_cu); }
        (void)hipGetLastError();
        grid = cus;
    }
    if (grid < 0) return;
    (void)hipMemsetAsync((char*)d_ws + WS_CTL, 0, CTL_BYTES, stream);
    Params p{};
    for (int i = 0; i < 26; ++i) p.in[i] = (const float*)d_in[i];
    p.out = (float*)d_out; p.ws = (unsigned char*)d_ws;
    const int dils[3] = {1, 4, 16};
    for (int g = 0; g < 3; ++g) for (int rel = 0; rel <= 128; ++rel) {
        const long dist = (long)rel * dils[g]; long bk;
        if (dist < 16) bk = dist;
        else { const double dd = (double)(dist < 1 ? 1 : dist); long large = 16 + (long)(std::log(dd / 16.0) / std::log(2048.0 / 16.0) * 16.0); bk = large < 31 ? large : 31; }
        p.bucket[g][rel] = (unsigned char)bk;
    }
#if N_LAUNCHES == 1
    p.lo = 0; p.hi = NPHASE;
    hipLaunchKernelGGL(fwd_kernel, dim3(grid), dim3(512), LDS_BYTES, stream, p);
#else
    for (int k = 0; k < NPHASE; ++k) { p.lo = k; p.hi = k + 1; hipLaunchKernelGGL(fwd_kernel, dim3(grid), dim3(512), LDS_BYTES, stream, p); }
#endif
}
```

```cpp
#include <hip/hip_runtime.h>
#include <cstdio>
#include <cstdint>
#include <cmath>

#ifndef N_LAUNCHES
#define N_LAUNCHES 1
#endif

#define GAS __attribute__((address_space(1)))
#define LAS __attribute__((address_space(3)))
typedef unsigned short bf16;
typedef float f32x2 __attribute__((ext_vector_type(2)));
typedef float f32x4 __attribute__((ext_vector_type(4)));
typedef float f32x16 __attribute__((ext_vector_type(16)));
typedef short bf16x8 __attribute__((ext_vector_type(8)));
typedef short bf16x4 __attribute__((ext_vector_type(4)));
typedef unsigned u32x4 __attribute__((ext_vector_type(4)));
typedef unsigned u32x2 __attribute__((ext_vector_type(2)));

constexpr int NB = 8, SEQ = 4096, T = NB * SEQ, D = 1024, DIN = 8704;
constexpr int C_XR = 0, C_GR = 1024, C_Q = 2048, C_K = 3584, C_V = 5120, C_GRNN = 6656, C_GATT = 7680;
constexpr int NE = 256, TOPK = 8, DE = 256;
constexpr int TCH = 128, NCH = SEQ / TCH;
constexpr int MAXT_R = 1280, SH_TILES = T / 256, MAXT = MAXT_R + SH_TILES;
constexpr float ALPHA = 1.18920711500272f, LN_EPS = 1e-5f;
constexpr int NPHASE = 13;

constexpr size_t MiB = 1u << 20;
constexpr size_t WS_CTL = 0, CTL_BYTES = 1 * MiB;
constexpr size_t WS_WINT = 1 * MiB;
constexpr size_t WS_WPRT = 18 * MiB;
constexpr size_t WS_WPAT = 20 * MiB;
constexpr size_t WS_WOT = 21 * MiB;
constexpr size_t WS_WRT = 23 * MiB;
constexpr size_t WS_HIST = 31 * MiB + 512 * 1024;
constexpr size_t WS_EIDX = 24 * MiB, WS_GATEW = 25 * MiB, WS_RANK = 26 * MiB, WS_SLOTOF = 27 * MiB, WS_TOKSLOT = 28 * MiB, WS_WSLOT = 30 * MiB;
constexpr size_t WS_XB = 32 * MiB;
constexpr size_t WS_YRNN = 32 * MiB;
constexpr size_t WS_HLOC = 96 * MiB;
constexpr size_t WS_MERGED = 96 * MiB;
constexpr size_t WS_CUMA = 160 * MiB;
constexpr size_t WS_AO = 224 * MiB;
constexpr size_t WS_YATT = 320 * MiB;
constexpr size_t WS_SUMA = 352 * MiB, WS_SUMH = 353 * MiB;
constexpr size_t WS_LSE = 354 * MiB;
constexpr size_t WS_PROJ = 360 * MiB;
constexpr size_t WS_PRELN = 700 * MiB;
constexpr size_t WS_WD = 32 * MiB;
constexpr size_t WS_H = 161 * MiB;
constexpr size_t WS_Y = 337 * MiB;
constexpr size_t WS_X1B = 337 * MiB;
constexpr size_t WS_WGU = 401 * MiB;
constexpr size_t WS_LOGITS = 658 * MiB;
constexpr size_t WS_END = 977 * MiB;
constexpr int CW_BAR = 4096, CW_CNT = 16384;

constexpr int RING_BYTES = 131072;
constexpr int L_TBASE = RING_BYTES;
constexpr int L_TILEE = L_TBASE + 1040;
constexpr int L_BTAB = L_TILEE + 2816;
constexpr int L_MISC = L_BTAB + 12672;
constexpr int L_LCNT = L_MISC + 64;
constexpr int L_BBASE = L_LCNT + 1024;
constexpr int LDS_BYTES = 151552;
static_assert(L_BBASE + 1024 <= LDS_BYTES, "LDS map");

__device__ __forceinline__ unsigned f2bf(float f) { unsigned u = __builtin_bit_cast(unsigned, f); return (u + 0x7fffu + ((u >> 16) & 1u)) >> 16; }
__device__ __forceinline__ unsigned pk2(float lo, float hi) { return f2bf(lo) | (f2bf(hi) << 16); }
__device__ __forceinline__ unsigned pk_fp8x4(float a, float b, float c, float d) {
    a = __builtin_amdgcn_fmed3f(a, -448.f, 448.f); b = __builtin_amdgcn_fmed3f(b, -448.f, 448.f); c = __builtin_amdgcn_fmed3f(c, -448.f, 448.f); d = __builtin_amdgcn_fmed3f(d, -448.f, 448.f);
    int w = 0; w = __builtin_amdgcn_cvt_pk_fp8_f32(a, b, w, false); w = __builtin_amdgcn_cvt_pk_fp8_f32(c, d, w, true); return (unsigned)w; }
__device__ __forceinline__ float bflo(unsigned w) { return __builtin_bit_cast(float, w << 16); }
__device__ __forceinline__ float bfhi(unsigned w) { return __builtin_bit_cast(float, w & 0xffff0000u); }
__device__ __forceinline__ float bf1(bf16 h) { return __builtin_bit_cast(float, (unsigned)h << 16); }
__device__ __forceinline__ float sigmoidf_(float x) { return 1.0f / (1.0f + __expf(-x)); }
__device__ __forceinline__ float gelu_tanh(float x) { const float z = 1.5957691216057308f * (x + 0.044715f * x * x * x); return x / (1.0f + __expf(-z)); }
__device__ __forceinline__ float wave_sum(float v) {
#pragma unroll
    for (int o = 1; o < 64; o <<= 1) v += __shfl_xor(v, o);
    return v;
}

__device__ __forceinline__ int lane_id() { return (int)__builtin_amdgcn_mbcnt_hi(~0u, __builtin_amdgcn_mbcnt_lo(~0u, 0u)); }
namespace pg8 {
#define PG8_LAS __attribute__((address_space(3)))
typedef unsigned short bf16_t;
constexpr int BM = 256, BK = 64, HALF = 128, HTB = HALF * BK * 2, STAGE_BYTES = 8 * HTB, NXCD = 8, WGM = 8;
__host__ __device__ __forceinline__ int lds_byte(int r, int c) { const int st = (r >> 4) * 2 + (c >> 5), rr = r & 15, cc = c & 31, ob = rr * 64 + cc * 2; return st * 1024 + (ob ^ (((ob >> 9) & 1) << 5)); }
__host__ __device__ __forceinline__ void stage_rc(int b, int& R, int& C) { const int st = b / 1024, sb = b % 1024, swz = sb ^ (((sb >> 9) & 1) << 5); R = (st >> 1) * 16 + swz / 64; C = (st & 1) * 32 + (swz % 64) / 2; }
__host__ __device__ __forceinline__ int perm32(int rho) { const int n = rho >> 4, i = rho & 15; return 8 * (i >> 2) + 4 * n + (i & 3); }

struct Unit { int pm, pn, pb; };
struct Gemm { const bf16_t* A; const bf16_t* Bt; int K; int sw, sa; };

struct StaticOrder {
    static constexpr bool GATHER = false;
    int nM, nN, nwg, G, c;
    __device__ void init(int M, int N, int G_, int c_) { nM = M / BM; nN = N / BM; nwg = nM * nN; G = G_; c = c_; }
    __device__ bool next(int i, Unit& u) const {
        const long L = (long)i * G + c; if (L >= nwg) return false;
        int wgid = (int)L; { const int q = nwg / NXCD, r = nwg % NXCD, xcd = wgid % NXCD, off = wgid / NXCD; wgid = (xcd < r ? xcd * (q + 1) : r * (q + 1) + (xcd - r) * q) + off; }
        const int nig = WGM * nN, gid = wgid / nig, fm = gid * WGM, gsz = (nM - fm) < WGM ? (nM - fm) : WGM;
        u.pm = fm + ((wgid % nig) % gsz); u.pn = (wgid % nig) / gsz; u.pb = u.pn; return true;
    }
    __device__ __forceinline__ unsigned arow(int) const { return 0u; }
};
template <bool GATHER_> struct GroupOrder {
    static constexpr bool GATHER = GATHER_;
    int nN, nwg, G, c; const LAS unsigned short* tile_e; const int* tok; unsigned rowbytes;
    __device__ bool next(int i, Unit& u) const {
        const long L = (long)i * G + c; if (L >= nwg) return false;
        u.pm = (int)L / nN; u.pn = (int)L % nN; u.pb = __builtin_amdgcn_readfirstlane((int)tile_e[u.pm]) * nN + u.pn; return true;
    }
    __device__ __forceinline__ unsigned arow(int slot) const { return (unsigned)tok[slot] * rowbytes; }
};

__device__ __forceinline__ unsigned cvt_pk_bf16(float lo, float hi) { unsigned r; asm volatile("v_cvt_pk_bf16_f32 %0, %1, %2" : "=v"(r) : "v"(lo), "v"(hi)); return r; }

typedef int i32x4 __attribute__((ext_vector_type(4)));
typedef int i32x8 __attribute__((ext_vector_type(8)));
__device__ __forceinline__ f32x4 mma8(bf16x8 w0, bf16x8 w1, bf16x8 a0, bf16x8 a1, f32x4 c, int sw, int sa) {
    const i32x8 W = __builtin_shufflevector(__builtin_bit_cast(i32x4, w0), __builtin_bit_cast(i32x4, w1), 0, 1, 2, 3, 4, 5, 6, 7);
    const i32x8 A = __builtin_shufflevector(__builtin_bit_cast(i32x4, a0), __builtin_bit_cast(i32x4, a1), 0, 1, 2, 3, 4, 5, 6, 7);
    (void)sw; (void)sa; return __builtin_amdgcn_mfma_scale_f32_16x16x128_f8f6f4(W, A, c, 0, 0, 0, 0, 0, 0);
}
template <class Epi, class Sched, bool ALIGN_EPI = false, bool FP8 = false>
__device__ __forceinline__ void gemm_phase(PG8_LAS unsigned char* lds, const Gemm g, const Sched& S, const Epi& E, int wid) {
    constexpr bool GA = Sched::GATHER;
    const int lane = lane_id(), tid = wid * 64 + lane, wr = wid >> 2, wc = wid & 3, fr = lane & 15, fq = lane >> 4;
    const int K = g.K, nt = K / BK;
    unsigned voffA[2], voffA1[2], voffB[2]; int RA[2], CA2[2];
#pragma unroll
    for (int i = 0; i < 2; ++i) { int R, C; stage_rc(tid * 16 + i * 8192, R, C); const int Rb = Epi::PERM ? ((R & ~31) + perm32(R & 31)) : R;
        RA[i] = R; CA2[i] = C * 2;
        voffA[i] = (unsigned)(R * K + C) * 2u; voffA1[i] = voffA[i]; voffB[i] = (unsigned)(Rb * K + C) * 2u; }
    const size_t kstep = (size_t)(BK * 2);
    const size_t hstep = (size_t)HALF * K * 2;
    const size_t tstep = 2 * hstep;
    const size_t hstepA = GA ? 0 : hstep;
    const unsigned ldsw = (unsigned)wid * 1024u;
    const unsigned ldsbase = (unsigned)(size_t)lds + ldsw;
    const int aoff = lds_byte(wr * 64 + fr, fq * 8), boff = lds_byte(wc * 32 + fr, fq * 8);
#define PG8_SA(b, h) (((b) * 2 + (h)) * HTB)
#define PG8_SB(b, h) ((4 + (b) * 2 + (h)) * HTB)
#define PG8_STAGE(bufoff, gbase, voff) do { _Pragma("unroll") for (int _i = 0; _i < 2; ++_i) { unsigned _keep; \
        asm volatile("s_mov_b32 %0, m0\n\ts_mov_b32 m0, %3\n\ts_nop 0\n\tglobal_load_lds_dwordx4 %1, %2\n\ts_mov_b32 m0, %0" : "=&s"(_keep) : "v"((voff)[_i]), "s"((const char*)(gbase)), "s"(ldsbase + (unsigned)((bufoff) + _i * 8192)) : "memory"); } } while (0)
#define PG8_LD16(off) (*(const PG8_LAS i32x4*)(lds + (off)))
#define PG8_LDA(dst, b, h) do { if constexpr (FP8) { _Pragma("unroll") for (int m = 0; m < 4; ++m) dst##8[m] = __builtin_shufflevector(PG8_LD16(PG8_SA(b, h) + aoff + m * 2048), PG8_LD16(PG8_SA(b, h) + aoff + m * 2048 + 1024), 0, 1, 2, 3, 4, 5, 6, 7); } \
        else { _Pragma("unroll") for (int m = 0; m < 4; ++m) _Pragma("unroll") for (int k = 0; k < 2; ++k) dst[m][k] = *(const PG8_LAS bf16x8*)(lds + PG8_SA(b, h) + aoff + m * 2048 + k * 1024); } } while (0)
#define PG8_LDB(dst, b, h) do { if constexpr (FP8) { _Pragma("unroll") for (int n = 0; n < 2; ++n) dst##8[n] = __builtin_shufflevector(PG8_LD16(PG8_SB(b, h) + boff + n * 2048), PG8_LD16(PG8_SB(b, h) + boff + n * 2048 + 1024), 0, 1, 2, 3, 4, 5, 6, 7); } \
        else { _Pragma("unroll") for (int n = 0; n < 2; ++n) _Pragma("unroll") for (int k = 0; k < 2; ++k) dst[n][k] = *(const PG8_LAS bf16x8*)(lds + PG8_SB(b, h) + boff + n * 2048 + k * 1024); } } while (0)
#define PG8_MMA(ai, bj, At, Bt) do { __builtin_amdgcn_s_setprio(1); \
        if constexpr (FP8) { _Pragma("unroll") for (int m = 0; m < 4; ++m) _Pragma("unroll") for (int n = 0; n < 2; ++n) acc[ai][bj][m][n] = __builtin_amdgcn_mfma_scale_f32_16x16x128_f8f6f4(Bt##8[n], At##8[m], acc[ai][bj][m][n], 0, 0, 0, 0, 0, 0); } \
        else { _Pragma("unroll") for (int m = 0; m < 4; ++m) _Pragma("unroll") for (int n = 0; n < 2; ++n) _Pragma("unroll") for (int k = 0; k < 2; ++k) \
        acc[ai][bj][m][n] = __builtin_amdgcn_mfma_f32_16x16x32_bf16(Bt[n][k], At[m][k], acc[ai][bj][m][n], 0, 0, 0); } __builtin_amdgcn_s_setprio(0); } while (0)
#define PG8_WAIT_V(n) asm volatile("s_waitcnt vmcnt(" #n ")" ::: "memory")
#define PG8_WAIT_L(n) asm volatile("s_waitcnt lgkmcnt(" #n ")" ::: "memory")
#define PG8_BAR __builtin_amdgcn_s_barrier()
#define PG8_SCHED __builtin_amdgcn_sched_barrier(0)
    Unit cur, nxt; int ui = 0;
    if (!S.next(0, cur)) return;
    f32x4 acc[2][2][4][2];
#pragma unroll
    for (int a = 0; a < 2; ++a)
#pragma unroll
        for (int b = 0; b < 2; ++b)
#pragma unroll
            for (int m = 0; m < 4; ++m)
#pragma unroll
                for (int n = 0; n < 2; ++n) acc[a][b][m][n] = (f32x4){0.f, 0.f, 0.f, 0.f};
    bf16x8 At[4][2], B0[2][2], B1[2][2]; i32x8 At8[4], B08[2], B18[2]; (void)At; (void)B0; (void)B1; (void)At8; (void)B08; (void)B18;
    const char* cA = GA ? (const char*)g.A : (const char*)g.A + (size_t)cur.pm * tstep; const char* cB = (const char*)g.Bt + (size_t)cur.pb * tstep;
    if constexpr (GA) {
#pragma unroll
        for (int i = 0; i < 2; ++i) { voffA[i] = S.arow(cur.pm * BM + RA[i]) + (unsigned)CA2[i]; voffA1[i] = S.arow(cur.pm * BM + HALF + RA[i]) + (unsigned)CA2[i]; }
    }
    PG8_STAGE(PG8_SB(0, 0), cB, voffB); PG8_STAGE(PG8_SB(0, 1), cB + hstep, voffB); PG8_STAGE(PG8_SA(0, 0), cA, voffA); PG8_STAGE(PG8_SA(0, 1), cA + hstepA, voffA1);
    if (wr == 1) PG8_BAR;
    PG8_WAIT_V(2); PG8_BAR;
    PG8_STAGE(PG8_SB(1, 0), cB + kstep, voffB); PG8_STAGE(PG8_SA(1, 0), cA + kstep, voffA); PG8_STAGE(PG8_SB(1, 1), cB + hstep + kstep, voffB);
    PG8_WAIT_V(6); PG8_BAR;
    for (;;) {
        const bool has_next = S.next(ui + 1, nxt);
        const char* nA = GA ? (const char*)g.A : (has_next ? (const char*)g.A + (size_t)nxt.pm * tstep : cA);
        const char* nB = has_next ? (const char*)g.Bt + (size_t)nxt.pb * tstep : cB;
#pragma clang loop unroll(disable)
        for (int t = 0; t < nt; t += 2) {
            const bool last = (t == nt - 2);
            const char* a1 = cA + (size_t)(t + 1) * kstep;
            const char* a2 = last ? nA : cA + (size_t)(t + 2) * kstep; const char* b2 = last ? nB : cB + (size_t)(t + 2) * kstep;
            const char* a3 = a2 + kstep; const char* b3 = b2 + kstep;
            unsigned nvA[2], nvA1[2];
            if constexpr (GA) {
                if (last && has_next) {
#pragma unroll
                    for (int i = 0; i < 2; ++i) { nvA[i] = S.arow(nxt.pm * BM + RA[i]) + (unsigned)CA2[i]; nvA1[i] = S.arow(nxt.pm * BM + HALF + RA[i]) + (unsigned)CA2[i]; }
                } else {
#pragma unroll
                    for (int i = 0; i < 2; ++i) { nvA[i] = voffA[i]; nvA1[i] = voffA1[i]; }
                }
            }
            PG8_LDB(B0, 0, 0); PG8_LDB(B1, 0, 1); PG8_SCHED; PG8_LDA(At, 0, 0); PG8_STAGE(PG8_SA(1, 1), a1 + hstepA, voffA1);
            if constexpr (GA) {
#pragma unroll
                for (int i = 0; i < 2; ++i) { voffA[i] = nvA[i]; voffA1[i] = nvA1[i]; }
            }
            PG8_WAIT_V(8); PG8_WAIT_L(0); PG8_BAR; PG8_MMA(0, 0, At, B0); PG8_MMA(0, 1, At, B1); PG8_BAR; PG8_SCHED;
            PG8_LDA(At, 0, 1); PG8_STAGE(PG8_SB(0, 0), b2, voffB); PG8_STAGE(PG8_SB(0, 1), b2 + hstep, voffB); PG8_STAGE(PG8_SA(0, 0), a2, voffA);
            PG8_WAIT_V(8); PG8_WAIT_L(0); PG8_BAR; PG8_MMA(1, 0, At, B0); PG8_MMA(1, 1, At, B1); PG8_BAR; PG8_SCHED;
            PG8_LDB(B0, 1, 0); PG8_LDB(B1, 1, 1); PG8_SCHED; PG8_LDA(At, 1, 0); PG8_STAGE(PG8_SA(0, 1), a2 + hstepA, voffA1);
            PG8_WAIT_V(8); PG8_WAIT_L(0); PG8_BAR; PG8_MMA(0, 0, At, B0); PG8_MMA(0, 1, At, B1); PG8_BAR; PG8_SCHED;
            PG8_LDA(At, 1, 1); PG8_STAGE(PG8_SB(1, 0), b3, voffB); PG8_STAGE(PG8_SB(1, 1), b3 + hstep, voffB); PG8_STAGE(PG8_SA(1, 0), a3, voffA);
            PG8_WAIT_V(8); PG8_WAIT_L(0); PG8_BAR; PG8_MMA(1, 0, At, B0); PG8_MMA(1, 1, At, B1); PG8_BAR; PG8_SCHED;
        }
        if constexpr (ALIGN_EPI) { if (wr == 0) PG8_BAR; }
        { Unit eu = cur; int efr = fr, efq = fq;
          asm volatile("" : "+s"(eu.pm), "+s"(eu.pn), "+s"(eu.pb)); asm volatile("" : "+v"(efr), "+v"(efq));
          E(acc, eu, wr, wc, efr, efq); }
        if (!has_next) break;
#pragma unroll
        for (int a = 0; a < 2; ++a)
#pragma unroll
            for (int b = 0; b < 2; ++b)
#pragma unroll
                for (int m = 0; m < 4; ++m)
#pragma unroll
                    for (int n = 0; n < 2; ++n) acc[a][b][m][n] = (f32x4){0.f, 0.f, 0.f, 0.f};
        cur = nxt; cA = nA; cB = nB; ++ui;
        if constexpr (ALIGN_EPI) { if (wr == 1) PG8_BAR; }
    }
    PG8_WAIT_V(0);
    if constexpr (!ALIGN_EPI) { if (wr == 0) PG8_BAR; }
    PG8_BAR;
#undef PG8_SA
#undef PG8_SB
#undef PG8_STAGE
#undef PG8_LDA
#undef PG8_LDB
#undef PG8_LD16
#undef PG8_MMA
#undef PG8_WAIT_V
#undef PG8_WAIT_L
#undef PG8_BAR
#undef PG8_SCHED
}

typedef const f32x4 (&AccRef)[2][2][4][2];

struct EpiInProj {
    static constexpr bool PERM = true;
    bf16_t* O; const float* bias; float os;
    __device__ __forceinline__ void operator()(AccRef acc, const Unit& u, int wr, int wc, int fr, int fq) const {
        const int row0 = u.pm * BM + wr * 64 + fr, col0 = u.pn * BM + wc * 32 + 8 * fq;
        const int kind = u.pn < 4 ? 0 : (u.pn < 8 ? 1 : (u.pn < 14 ? 2 : (u.pn < 26 ? 0 : 3)));
        f32x4 bv[2][2];
#pragma unroll
        for (int bj = 0; bj < 2; ++bj)
#pragma unroll
            for (int n = 0; n < 2; ++n) bv[bj][n] = *(const f32x4*)(bias + col0 + bj * HALF + 4 * n);
#pragma unroll
        for (int ai = 0; ai < 2; ++ai)
#pragma unroll
            for (int m = 0; m < 4; ++m) { bf16_t* rowp = O + (size_t)(row0 + ai * HALF + m * 16) * DIN + col0;
#pragma unroll
                for (int bj = 0; bj < 2; ++bj) { f32x4 v0 = acc[ai][bj][m][0] * os + bv[bj][0], v1 = acc[ai][bj][m][1] * os + bv[bj][1];
                    if (kind == 1) {
#pragma unroll
                        for (int j = 0; j < 4; ++j) { v0[j] = gelu_tanh(v0[j]); v1[j] = gelu_tanh(v1[j]); }
                    } else if (kind == 2) { v0 = v0 * 0.125f; v1 = v1 * 0.125f; }
                    else if (kind == 3) {
#pragma unroll
                        for (int j = 0; j < 4; ++j) { v0[j] = sigmoidf_(v0[j]); v1[j] = sigmoidf_(v1[j]); }
                    }
                    u32x4 w; w.x = cvt_pk_bf16(v0[0], v0[1]); w.y = cvt_pk_bf16(v0[2], v0[3]); w.z = cvt_pk_bf16(v1[0], v1[1]); w.w = cvt_pk_bf16(v1[2], v1[3]);
                    *(u32x4*)(rowp + bj * HALF) = w; } }
    }
};
struct EpiProjRnn {
    static constexpr bool PERM = false;
    const bf16_t* proj; float* part;
    __device__ __forceinline__ void operator()(AccRef acc, const Unit& u, int wr, int wc, int fr, int fq) const {
        const int row0 = u.pm * BM + wr * 64 + fr, col0 = u.pn * BM + wc * 32 + 4 * fq;
#pragma unroll
        for (int ai = 0; ai < 2; ++ai)
#pragma unroll
            for (int m = 0; m < 4; ++m) { const size_t row = (size_t)(row0 + ai * HALF + m * 16);
#pragma unroll
                for (int bj = 0; bj < 2; ++bj)
#pragma unroll
                    for (int n = 0; n < 2; ++n) { const int c = col0 + bj * HALF + n * 16;
                        const u32x2 gw = *(const u32x2*)(proj + row * DIN + C_GRNN + c);
                        const f32x4 gt = (f32x4){bflo(gw.x), bfhi(gw.x), bflo(gw.y), bfhi(gw.y)};
                        *(f32x4*)(part + row * D + c) = gt * acc[ai][bj][m][n]; } }
    }
};
struct EpiProjAtt {
    static constexpr bool PERM = false;
    const bf16_t* proj; const float* part; bf16_t* merged;
    __device__ __forceinline__ void operator()(AccRef acc, const Unit& u, int wr, int wc, int fr, int fq) const {
        const int row0 = u.pm * BM + wr * 64 + fr, col0 = u.pn * BM + wc * 32 + 4 * fq;
#pragma unroll
        for (int ai = 0; ai < 2; ++ai)
#pragma unroll
            for (int m = 0; m < 4; ++m) { const size_t row = (size_t)(row0 + ai * HALF + m * 16);
#pragma unroll
                for (int bj = 0; bj < 2; ++bj)
#pragma unroll
                    for (int n = 0; n < 2; ++n) { const int c = col0 + bj * HALF + n * 16;
                        const u32x2 gw = *(const u32x2*)(proj + row * DIN + C_GATT + c);
                        const f32x4 gt = (f32x4){bflo(gw.x), bfhi(gw.x), bflo(gw.y), bfhi(gw.y)};
                        const f32x4 v = *(const f32x4*)(part + row * D + c) + gt * acc[ai][bj][m][n];
                        u32x2 w; w.x = cvt_pk_bf16(v[0], v[1]); w.y = cvt_pk_bf16(v[2], v[3]);
                        *(u32x2*)(merged + row * D + c) = w; } }
    }
};
struct EpiF32Res {
    static constexpr bool PERM = false;
    const float* base; float* out; int ldc; float scale;
    __device__ __forceinline__ void operator()(AccRef acc, const Unit& u, int wr, int wc, int fr, int fq) const {
        const int row0 = u.pm * BM + wr * 64 + fr, col0 = u.pn * BM + wc * 32 + 4 * fq;
#pragma unroll
        for (int ai = 0; ai < 2; ++ai)
#pragma unroll
            for (int m = 0; m < 4; ++m) { const size_t off = (size_t)(row0 + ai * HALF + m * 16) * ldc + col0;
#pragma unroll
                for (int bj = 0; bj < 2; ++bj)
#pragma unroll
                    for (int n = 0; n < 2; ++n) { f32x4 v = acc[ai][bj][m][n];
                        if (base) v = v + *(const f32x4*)(base + off + bj * HALF + n * 16) * scale;
                        *(f32x4*)(out + off + bj * HALF + n * 16) = v; } }
    }
};
struct EpiGateUp {
    static constexpr bool PERM = true;
    bf16_t* H;
    __device__ __forceinline__ void operator()(AccRef acc, const Unit& u, int wr, int wc, int fr, int fq) const {
        const int row0 = u.pm * BM + wr * 64 + fr, col0 = u.pn * HALF + wc * 32 + 8 * fq;
#pragma unroll
        for (int ai = 0; ai < 2; ++ai)
#pragma unroll
            for (int m = 0; m < 4; ++m) { bf16_t* rowp = H + (size_t)(row0 + ai * HALF + m * 16) * DE + col0;
                f32x4 o[2];
#pragma unroll
                for (int n = 0; n < 2; ++n) { const f32x4 gt = acc[ai][0][m][n], up = acc[ai][1][m][n];
#pragma unroll
                    for (int j = 0; j < 4; ++j) o[n][j] = gt[j] / (1.0f + __expf(-gt[j])) * up[j]; }
                u32x4 w; w.x = cvt_pk_bf16(o[0][0], o[0][1]); w.y = cvt_pk_bf16(o[0][2], o[0][3]); w.z = cvt_pk_bf16(o[1][0], o[1][1]); w.w = cvt_pk_bf16(o[1][2], o[1][3]);
                *(u32x4*)rowp = w; }
    }
};
struct EpiDown {
    static constexpr bool PERM = true;
    bf16_t* Y; const float* wslot; float* out; int mt_r;
    __device__ __forceinline__ void operator()(AccRef acc, const Unit& u, int wr, int wc, int fr, int fq) const {
        const int col0 = u.pn * BM + wc * 32 + 8 * fq;
        if (u.pm < mt_r) {
            const int row0 = u.pm * BM + wr * 64 + fr;
#pragma unroll
            for (int ai = 0; ai < 2; ++ai)
#pragma unroll
                for (int m = 0; m < 4; ++m) { const size_t row = (size_t)(row0 + ai * HALF + m * 16); const float w8 = wslot[row]; bf16_t* rowp = Y + row * D + col0;
#pragma unroll
                    for (int bj = 0; bj < 2; ++bj) { const f32x4 v0 = acc[ai][bj][m][0] * w8, v1 = acc[ai][bj][m][1] * w8;
                        u32x4 w; w.x = cvt_pk_bf16(v0[0], v0[1]); w.y = cvt_pk_bf16(v0[2], v0[3]); w.z = cvt_pk_bf16(v1[0], v1[1]); w.w = cvt_pk_bf16(v1[2], v1[3]);
                        *(u32x4*)(rowp + bj * HALF) = w; } }
        } else {
            const int row0 = (u.pm - mt_r) * BM + wr * 64 + fr;
#pragma unroll
            for (int ai = 0; ai < 2; ++ai)
#pragma unroll
                for (int m = 0; m < 4; ++m) { float* rowp = out + (size_t)(row0 + ai * HALF + m * 16) * D + col0;
#pragma unroll
                    for (int bj = 0; bj < 2; ++bj)
#pragma unroll
                        for (int n = 0; n < 2; ++n) { float* p = rowp + bj * HALF + 4 * n; *(f32x4*)p = *(const f32x4*)p * ALPHA + acc[ai][bj][m][n]; } }
        }
    }
};
}

#define XB_TMO      128
#define XB_XCNT(j)  (256  + 64 * (j))
#define XB_XSUB(j)  (1280 + 64 * (j))
#define XB_XGEN(j)  (2304 + 64 * (j))
#define XB_TOP      3328
#define XB_TOPGEN   3392
#define XCD_BAR_WORDS 3456
#define XB_SPIN_CAP (1u << 18)
__device__ __forceinline__ unsigned xb_ld(unsigned* p)              { return __hip_atomic_load(p, __ATOMIC_RELAXED, __HIP_MEMORY_SCOPE_AGENT); }
__device__ __forceinline__ unsigned xb_add(unsigned* p, unsigned v) { return __hip_atomic_fetch_add(p, v, __ATOMIC_RELAXED, __HIP_MEMORY_SCOPE_AGENT); }
__device__ __forceinline__ unsigned xb_xcc_id() { return (unsigned)__builtin_amdgcn_s_getreg((3 << 11) | 20) & 0xFu; }
#define XB_SPIN(cond, bar) do { unsigned _sp = 0; while (cond) { __builtin_amdgcn_s_sleep(1); \
    if ((++_sp & 255u) == 0u) { if (xb_ld(&(bar)[XB_TMO])) break; if (_sp > XB_SPIN_CAP) { atomicAdd(&(bar)[XB_TMO], 1u); break; } } } } while (0)
struct XcdBarrier { unsigned* bar; unsigned x; volatile LAS unsigned* st; };
__device__ __forceinline__ XcdBarrier xcd_barrier_post(unsigned* bar, volatile LAS unsigned* st, bool t0) {
    XcdBarrier b; b.bar = bar; b.x = xb_xcc_id(); b.st = st;
    if (t0) (void)xb_add(&bar[XB_XCNT(b.x)], 1u);
    return b;
}
__device__ __forceinline__ void xcd_barrier_complete(unsigned* bar, unsigned x, unsigned& nloc, unsigned& nx) {
    const unsigned G = gridDim.x * gridDim.y * gridDim.z;
    unsigned sum, cnt, mine, sp = 0u;
    for (;;) {
        sum = 0u; cnt = 0u; mine = 0u;
#pragma unroll
        for (unsigned j = 0; j < 16; ++j) { const unsigned c = xb_ld(&bar[XB_XCNT(j)]); sum += c; cnt += (c > 0u) ? 1u : 0u; mine = (j == x) ? c : mine; }
        if (sum == G) break;
        __builtin_amdgcn_s_sleep(1);
        if ((++sp & 255u) == 0u) { if (xb_ld(&bar[XB_TMO])) break; if (sp > XB_SPIN_CAP) { atomicAdd(&bar[XB_TMO], 1u); break; } }
    }
    nloc = mine > 0u ? mine : 1u; nx = cnt > 0u ? cnt : 1u;
}
__device__ __forceinline__ void xcd_barrier(const XcdBarrier& b, bool t0) {
    asm volatile("s_waitcnt vmcnt(0)" ::: "memory");
    __syncthreads();
    if (t0) {
        unsigned* bar = b.bar;
        __builtin_amdgcn_s_waitcnt(0);
        unsigned nloc = b.st[0], nx = b.st[1];
        if (nloc == 0u) { xcd_barrier_complete(bar, b.x, nloc, nx); b.st[0] = nloc; b.st[1] = nx; }
        const unsigned old = xb_add(&bar[XB_XSUB(b.x)], 1u);
        const unsigned gen = old / nloc;
        if (old + 1u == (gen + 1u) * nloc) {
            __builtin_amdgcn_fence(__ATOMIC_RELEASE, "agent");
            asm volatile("s_waitcnt vmcnt(0)" ::: "memory");
            const unsigned og = xb_add(&bar[XB_TOP], 1u);
            const unsigned tg = og / nx;
            if (og + 1u == (tg + 1u) * nx) xb_add(&bar[XB_TOPGEN], 1u);
            else XB_SPIN(xb_ld(&bar[XB_TOPGEN]) == tg, bar);
            __builtin_amdgcn_fence(__ATOMIC_ACQUIRE, "agent");
            xb_add(&bar[XB_XGEN(b.x)], 1u);
            asm volatile("s_waitcnt vmcnt(0)" ::: "memory");
        } else {
            XB_SPIN(xb_ld(&bar[XB_XGEN(b.x)]) == gen, bar);
            __builtin_amdgcn_fence(__ATOMIC_ACQUIRE, "agent");
            asm volatile("s_waitcnt vmcnt(0)" ::: "memory");
        }
    }
    __syncthreads();
}

struct Params { const float* in[26]; float* out; unsigned char* ws; int lo, hi; unsigned char bucket[3][136]; };
static_assert(sizeof(Params) == 26 * 8 + 8 + 8 + 8 + 408, "Params has no padding holes");

__device__ __forceinline__ void tr128(const float* src, int ld_src, bf16* dst, int ld_dst, LAS float* tile, int tid) {
    f32x4 v[8];
#pragma unroll
    for (int it = 0; it < 8; ++it) { const int id = it * 512 + tid, k = id >> 5, c4 = id & 31; v[it] = *(const f32x4*)(src + (size_t)k * ld_src + c4 * 4); }
#pragma unroll
    for (int it = 0; it < 8; ++it) { const int id = it * 512 + tid, k = id >> 5, c4 = id & 31; LAS float* p = tile + k * 129 + c4 * 4; p[0] = v[it][0]; p[1] = v[it][1]; p[2] = v[it][2]; p[3] = v[it][3]; }
    __syncthreads();
#pragma unroll
    for (int it = 0; it < 4; ++it) { const int id = it * 512 + tid, n = id >> 4, kc = id & 15; const LAS float* s = tile + (kc * 8) * 129 + n;
        u32x4 o; o.x = pk2(s[0], s[129]); o.y = pk2(s[2 * 129], s[3 * 129]); o.z = pk2(s[4 * 129], s[5 * 129]); o.w = pk2(s[6 * 129], s[7 * 129]);
        *(u32x4*)(dst + (size_t)n * ld_dst + kc * 8) = o; }
    __syncthreads();
}
__device__ __forceinline__ void tr_matrix_item(const float* W, int K, int N, bf16* WT, int item, LAS float* tile, int tid) {
    const int nbn = N / 128, kb = item / nbn, nb = item % nbn;
    tr128(W + (size_t)kb * 128 * N + nb * 128, N, WT + (size_t)nb * 128 * K + kb * 128, K, tile, tid);
}

__device__ __forceinline__ void tr128_fp8(const float* src, int ld_src, unsigned char* dst, int ld_dst, float scale, LAS float* tile, int tid) {
    f32x4 v[8];
#pragma unroll
    for (int it = 0; it < 8; ++it) { const int id = it * 512 + tid, k = id >> 5, c4 = id & 31; v[it] = *(const f32x4*)(src + (size_t)k * ld_src + c4 * 4); }
#pragma unroll
    for (int it = 0; it < 8; ++it) { const int id = it * 512 + tid, k = id >> 5, c4 = id & 31; LAS float* p = tile + k * 129 + c4 * 4; p[0] = v[it][0]; p[1] = v[it][1]; p[2] = v[it][2]; p[3] = v[it][3]; }
    __syncthreads();
#pragma unroll
    for (int it = 0; it < 2; ++it) { const int id = it * 512 + tid, n = id >> 3, kc = id & 7; const LAS float* s = tile + (kc * 16) * 129 + n;
        u32x4 o;
#pragma unroll
        for (int w = 0; w < 4; ++w) o[w] = pk_fp8x4(s[(4 * w) * 129] * scale, s[(4 * w + 1) * 129] * scale, s[(4 * w + 2) * 129] * scale, s[(4 * w + 3) * 129] * scale);
        *(u32x4*)(dst + (size_t)n * ld_dst + kc * 16) = o; }
    __syncthreads();
}
__device__ __forceinline__ void tr_matrix_item_fp8(const float* W, int K, int N, unsigned char* WT, float scale, int item, LAS float* tile, int tid) {
    const int nbn = N / 128, kb = item / nbn, nb = item % nbn;
    tr128_fp8(W + (size_t)kb * 128 * N + nb * 128, N, WT + (size_t)nb * 128 * K + kb * 128, K, scale, tile, tid);
}

struct RgW { bf16x8 f[2][2][4]; };
__device__ __forceinline__ void rglru_load_w(const Params& p, int h, int lane, RgW& W) {
    const int r = lane & 31, hf = lane >> 5; const unsigned loff = (unsigned)(8 * hf * 64 + r);
#pragma unroll
    for (int gt = 0; gt < 2; ++gt) { const float* w = p.in[gt ? 7 : 5] + (size_t)h * 4096;
#pragma unroll
        for (int nn = 0; nn < 2; ++nn)
#pragma unroll
            for (int s = 0; s < 4; ++s) { float v[8];
#pragma unroll
                for (int j = 0; j < 8; ++j) v[j] = (w + (16 * s + j) * 64 + 32 * nn)[loff];
                u32x4 pk; pk.x = pk2(v[0], v[1]); pk.y = pk2(v[2], v[3]); pk.z = pk2(v[4], v[5]); pk.w = pk2(v[6], v[7]);
                W.f[gt][nn][s] = __builtin_bit_cast(bf16x8, pk); } }
}
template <int PASS>
__device__ __forceinline__ void rglru_item(const Params& p, int item, const RgW& W, LAS unsigned char* xcl, int lane) {
    const bf16* proj = (const bf16*)(p.ws + WS_PROJ);
    float* sumA = (float*)(p.ws + WS_SUMA); float* sumH = (float*)(p.ws + WS_SUMH);
    const int c = item % NCH, h = (item / NCH) % 16, b = item / (NCH * 16);
    const int r = lane & 31, hf = lane >> 5;
    const int chn = h * 64 + lane;
    const float cw0 = p.in[3][chn], cw1 = p.in[3][1024 + chn], cw2 = p.in[3][2048 + chn], cw3 = p.in[3][3072 + chn], cb = p.in[4][chn];
    float ba[2], bi[2], sp8[2], C[2], PT[2];
#pragma unroll
    for (int nn = 0; nn < 2; ++nn) { const int ch = h * 64 + 32 * nn + r; ba[nn] = p.in[6][ch]; bi[nn] = p.in[8][ch]; sp8[nn] = 8.0f * log1pf(expf(-p.in[9][ch])); C[nn] = 0.f; PT[nn] = 1.f; }
    if (PASS == 2) {
        for (int k = 0; k < c; ++k)
#pragma unroll
            for (int nn = 0; nn < 2; ++nn) { const size_t o = (size_t)(b * NCH + k) * D + h * 64 + 32 * nn + r; C[nn] = sumA[o] * C[nn] + sumH[o]; }
    }
    const int t0 = c * TCH;
    const bf16* xrb = proj + (size_t)(b * SEQ) * DIN + C_XR + h * 64;
    float xm3 = 0.f, xm2 = 0.f, xm1 = 0.f;
    if (t0 > 0) { xm3 = bf1((xrb + (size_t)(t0 - 3) * DIN)[lane]); xm2 = bf1((xrb + (size_t)(t0 - 2) * DIN)[lane]); xm1 = bf1((xrb + (size_t)(t0 - 1) * DIN)[lane]); }
    for (int tile = 0; tile < TCH / 32; ++tile) {
        const int tt0 = t0 + tile * 32;
        bf16 xv[32];
#pragma unroll
        for (int j = 0; j < 32; ++j) xv[j] = (xrb + (size_t)(tt0 + j) * DIN)[lane];
#pragma unroll
        for (int j = 0; j < 32; ++j) { const float x = bf1(xv[j]); const float xc = cb + cw0 * xm3 + cw1 * xm2 + cw2 * xm1 + cw3 * x; xm3 = xm2; xm2 = xm1; xm1 = x;
            *(LAS bf16*)(xcl + j * 144 + lane * 2) = (bf16)f2bf(xc); }
        asm volatile("s_waitcnt lgkmcnt(0)" ::: "memory");
        bf16x8 af[4];
#pragma unroll
        for (int s = 0; s < 4; ++s) af[s] = *(const LAS bf16x8*)(xcl + r * 144 + (16 * s + 8 * hf) * 2);
#pragma unroll
        for (int nn = 0; nn < 2; ++nn) {
            f32x16 ra, ri, xq;
#pragma unroll
            for (int i = 0; i < 16; ++i) { ra[i] = 0.f; ri[i] = 0.f; xq[i] = 0.f; }
#pragma unroll
            for (int s = 0; s < 4; ++s) { ra = __builtin_amdgcn_mfma_f32_32x32x16_bf16(af[s], W.f[0][nn][s], ra, 0, 0, 0); ri = __builtin_amdgcn_mfma_f32_32x32x16_bf16(af[s], W.f[1][nn][s], ri, 0, 0, 0); }
#pragma unroll
            for (int s2 = 0; s2 < 2; ++s2) { const int s = 2 * nn + s2; bf16x8 idf;
#pragma unroll
                for (int j = 0; j < 8; ++j) idf[j] = (16 * s + 8 * hf + j == 32 * nn + r) ? (short)0x3F80 : (short)0;
                xq = __builtin_amdgcn_mfma_f32_32x32x16_bf16(af[s], idf, xq, 0, 0, 0); }
            float av[16], uv[16];
#pragma unroll
            for (int i = 0; i < 16; ++i) {
                const float rg = 1.0f / (1.0f + __expf(-(ra[i] + ba[nn]))), ig = 1.0f / (1.0f + __expf(-(ri[i] + bi[nn])));
                const float la = -sp8[nn] * rg, a = __expf(la), x2 = 2.0f * la;
                const float om = (x2 > -0.06f) ? -x2 * (1.0f + x2 * (0.5f + x2 * (0.16666667f + x2 * 0.041666668f))) : 1.0f - __expf(x2);
                av[i] = a; uv[i] = sqrtf(om) * (ig * xq[i]); }
            float hl[16], pl[16];
#pragma unroll
            for (int q = 0; q < 4; ++q) { hl[4 * q] = uv[4 * q]; pl[4 * q] = av[4 * q];
#pragma unroll
                for (int j = 1; j < 4; ++j) { hl[4 * q + j] = av[4 * q + j] * hl[4 * q + j - 1] + uv[4 * q + j]; pl[4 * q + j] = pl[4 * q + j - 1] * av[4 * q + j]; } }
            float cin[4]; float Cc = C[nn];
#pragma unroll
            for (int s8 = 0; s8 < 8; ++s8) { const int q = s8 >> 1;
                const float cn = pl[4 * q + 3] * Cc + hl[4 * q + 3];
                if ((s8 & 1) == 0) { if (hf == 0) cin[q] = Cc; } else { if (hf == 1) cin[q] = Cc; }
                const unsigned cu = __builtin_bit_cast(unsigned, cn);
                auto sw = __builtin_amdgcn_permlane32_swap(cu, cu, false, false);
                Cc = __builtin_bit_cast(float, (s8 & 1) ? sw[1] : sw[0]); }
            C[nn] = Cc;
            if (PASS == 1) { float pp = pl[3] * pl[7] * pl[11] * pl[15]; const unsigned pu = __builtin_bit_cast(unsigned, pp);
                auto sw = __builtin_amdgcn_permlane32_swap(pu, pu, false, false); PT[nn] *= __builtin_bit_cast(float, sw[0]) * __builtin_bit_cast(float, sw[1]); }
            if (PASS == 2) {
                const bf16* gb = proj + (size_t)(b * SEQ + tt0) * DIN + C_GR + h * 64 + 32 * nn;
                bf16* yb = (bf16*)(p.ws + WS_YRNN) + (size_t)(b * SEQ + tt0) * D + h * 64 + 32 * nn;
                const unsigned lg = (unsigned)(4 * hf * DIN + r), ly = (unsigned)(4 * hf * D + r);
                bf16 gv[16];
#pragma unroll
                for (int i = 0; i < 16; ++i) gv[i] = (gb + (size_t)((i & 3) + 8 * (i >> 2)) * DIN)[lg];
#pragma unroll
                for (int i = 0; i < 16; ++i) { const float hv = hl[i] + pl[i] * cin[i >> 2]; (yb + (size_t)((i & 3) + 8 * (i >> 2)) * D)[ly] = (bf16)f2bf(hv * bf1(gv[i])); }
            }
        }
        asm volatile("s_waitcnt lgkmcnt(0)" ::: "memory");
    }
    if (PASS == 1 && hf == 0) {
#pragma unroll
        for (int nn = 0; nn < 2; ++nn) { const size_t o = (size_t)(b * NCH + c) * D + h * 64 + 32 * nn + r; sumA[o] = PT[nn]; sumH[o] = C[nn]; }
    }
}

__device__ __forceinline__ void attn_item(const Params& p, int item, LAS unsigned char* vt, const LAS float* btab_all, int lane) {
    const bf16* proj = (const bf16*)(p.ws + WS_PROJ);
    const int rq = item & 127, bh = item >> 7, head = bh % 24, b = bh / 24;
    const int g = head >> 3, hh = head & 7, dil = (g == 0) ? 1 : (g == 1 ? 4 : 16), nqb = 128 / dil;
    const int res = rq / nqb, qb = rq % nqb, l0 = qb * 32;
    const int r = lane & 31, hf = lane >> 5;
    const LAS float* btab = btab_all + (g * 8 + hh) * 132;
    const size_t tokbase = (size_t)b * SEQ;
    bf16x8 qf[4];
    { const bf16* qp = proj + (tokbase + (size_t)(l0 + r) * dil + res) * DIN + C_Q + head * 64 + 8 * hf;
#pragma unroll
      for (int s = 0; s < 4; ++s) qf[s] = *(const bf16x8*)(qp + 16 * s); }
    f32x16 o0, o1;
#pragma unroll
    for (int i = 0; i < 16; ++i) { o0[i] = 0.f; o1[i] = 0.f; }
    float mrun = -1e30f, lrun = 0.f;
    const bf16* kvb = proj + (tokbase + res) * DIN + head * 64;
    const unsigned lk = (unsigned)(r * dil * DIN + C_K + 8 * hf);
    const unsigned lv0 = (unsigned)((2 * (lane >> 3)) * dil * DIN + C_V + 8 * (lane & 7));
    const int kt_first = (l0 >= 128) ? 0 : (128 - l0) / 32;
    bf16x8 kf[4], kfn[4]; u32x4 va[2][2], van[2][2];
    { const bf16* tb = kvb + (size_t)(l0 - 128 + 32 * kt_first) * dil * DIN;
#pragma unroll
      for (int s = 0; s < 4; ++s) kfn[s] = *(const bf16x8*)(tb + lk + 16 * s);
#pragma unroll
      for (int it = 0; it < 2; ++it)
#pragma unroll
          for (int e = 0; e < 2; ++e) van[it][e] = *(const u32x4*)(tb + (size_t)(16 * it + e) * dil * DIN + lv0); }
    for (int kt = kt_first; kt < 5; ++kt) {
        const int k0 = l0 - 128 + 32 * kt;
#pragma unroll
        for (int s = 0; s < 4; ++s) { kf[s] = kfn[s]; asm volatile("" : "+v"(kf[s])); }
#pragma unroll
        for (int it = 0; it < 2; ++it)
#pragma unroll
            for (int e = 0; e < 2; ++e) { va[it][e] = van[it][e]; asm volatile("" : "+v"(va[it][e])); }
        if (kt < 4) { const bf16* tb = kvb + (size_t)(k0 + 32) * dil * DIN;
#pragma unroll
            for (int s = 0; s < 4; ++s) kfn[s] = *(const bf16x8*)(tb + lk + 16 * s);
#pragma unroll
            for (int it = 0; it < 2; ++it)
#pragma unroll
                for (int e = 0; e < 2; ++e) van[it][e] = *(const u32x4*)(tb + (size_t)(16 * it + e) * dil * DIN + lv0); }
        f32x16 st;
#pragma unroll
        for (int i = 0; i < 16; ++i) st[i] = 0.f;
#pragma unroll
        for (int s = 0; s < 4; ++s) st = __builtin_amdgcn_mfma_f32_32x32x16_bf16(kf[s], qf[s], st, 0, 0, 0);
#pragma unroll
        for (int it = 0; it < 2; ++it) { const int kp2 = (lane >> 3) + 8 * it, dc = lane & 7;
#pragma unroll
            for (int w = 0; w < 4; ++w) { const unsigned a0 = va[it][0][w], a1 = va[it][1][w];
                *(LAS unsigned*)(vt + (8 * dc + 2 * w) * 72 + 4 * kp2) = (a0 & 0xffffu) | (a1 << 16);
                *(LAS unsigned*)(vt + (8 * dc + 2 * w + 1) * 72 + 4 * kp2) = (a0 >> 16) | (a1 & 0xffff0000u); } }
        float sv[16]; float mt = -1e30f;
        const int relb = (l0 + r) - k0 - 4 * hf;
        float bsv[16];
#pragma unroll
        for (int i = 0; i < 16; ++i) bsv[i] = btab[relb - ((i & 3) + 8 * (i >> 2))];
#pragma unroll
        for (int i = 0; i < 16; ++i) { const int rel = relb - ((i & 3) + 8 * (i >> 2));
            const bool ok = (unsigned)rel <= 128u;
            sv[i] = ok ? st[i] + bsv[i] : -1e30f; mt = fmaxf(mt, sv[i]); }
        mt = fmaxf(mt, __shfl_xor(mt, 32));
        const float mnew = fmaxf(mrun, mt), al = __expf(mrun - mnew);
        float ps = 0.f; float pv[16];
#pragma unroll
        for (int i = 0; i < 16; ++i) { pv[i] = __expf(sv[i] - mnew); ps += pv[i]; }
        lrun = lrun * al + ps; mrun = mnew;
#pragma unroll
        for (int i = 0; i < 16; ++i) { o0[i] *= al; o1[i] *= al; }
        bf16x8 pf[2];
#pragma unroll
        for (int s = 0; s < 2; ++s) { u32x4 w; w.x = pg8::cvt_pk_bf16(pv[8 * s], pv[8 * s + 1]); w.y = pg8::cvt_pk_bf16(pv[8 * s + 2], pv[8 * s + 3]); w.z = pg8::cvt_pk_bf16(pv[8 * s + 4], pv[8 * s + 5]); w.w = pg8::cvt_pk_bf16(pv[8 * s + 6], pv[8 * s + 7]);
            pf[s] = __builtin_bit_cast(bf16x8, w); }
        asm volatile("s_waitcnt lgkmcnt(0)" ::: "memory");
#pragma unroll
        for (int s = 0; s < 2; ++s) {
            { const LAS unsigned char* q = vt + (r) * 72 + (16 * s + 4 * hf) * 2; u32x4 w; const u32x2 lo = *(const LAS u32x2*)q, hi = *(const LAS u32x2*)(q + 16); w.x = lo.x; w.y = lo.y; w.z = hi.x; w.w = hi.y;
              o0 = __builtin_amdgcn_mfma_f32_32x32x16_bf16(__builtin_bit_cast(bf16x8, w), pf[s], o0, 0, 0, 0); }
            { const LAS unsigned char* q = vt + (32 + r) * 72 + (16 * s + 4 * hf) * 2; u32x4 w; const u32x2 lo = *(const LAS u32x2*)q, hi = *(const LAS u32x2*)(q + 16); w.x = lo.x; w.y = lo.y; w.z = hi.x; w.w = hi.y;
              o1 = __builtin_amdgcn_mfma_f32_32x32x16_bf16(__builtin_bit_cast(bf16x8, w), pf[s], o1, 0, 0, 0); }
        }
        asm volatile("s_waitcnt lgkmcnt(0)" ::: "memory");
    }
    const float ltot = lrun + __shfl_xor(lrun, 32), inv = 1.0f / ltot;
    const size_t tok = tokbase + (size_t)(l0 + r) * dil + res;
    bf16* ao = (bf16*)(p.ws + WS_AO) + ((size_t)g * T + tok) * 512 + hh * 64;
#pragma unroll
    for (int q4 = 0; q4 < 4; ++q4) {
        u32x2 w; w.x = pk2(o0[4 * q4] * inv, o0[4 * q4 + 1] * inv); w.y = pk2(o0[4 * q4 + 2] * inv, o0[4 * q4 + 3] * inv);
        *(u32x2*)(ao + 8 * q4 + 4 * hf) = w;
        u32x2 w1; w1.x = pk2(o1[4 * q4] * inv, o1[4 * q4 + 1] * inv); w1.y = pk2(o1[4 * q4 + 2] * inv, o1[4 * q4 + 3] * inv);
        *(u32x2*)(ao + 32 + 8 * q4 + 4 * hf) = w1;
    }
    if (hf == 0) ((float*)(p.ws + WS_LSE))[((size_t)g * T + tok) * 8 + hh] = mrun + __logf(ltot);
}

__device__ __forceinline__ void build_tile_table(const LAS unsigned* lcnt, LAS unsigned char* lds, int tid) {
    LAS int* tbase = (LAS int*)(lds + L_TBASE); LAS unsigned short* tile_e = (LAS unsigned short*)(lds + L_TILEE);
    __syncthreads();
    if (tid == 0) { int acc = 0; for (int e = 0; e < NE; ++e) { tbase[e] = acc; acc += ((int)lcnt[e] + 255) >> 8; } tbase[NE] = acc; tbase[NE + 1] = acc + SH_TILES; }
    __syncthreads();
    if (tid < NE) { const int a = tbase[tid], bnd = tbase[tid + 1]; for (int i = a; i < bnd; ++i) tile_e[i] = (unsigned short)tid; }
    if (tid < SH_TILES) tile_e[tbase[NE] + tid] = (unsigned short)NE;
    __syncthreads();
}
__device__ __forceinline__ void build_tile_table_g(const Params& p, LAS unsigned char* lds, int tid) {
    LAS unsigned* lc = (LAS unsigned*)(lds + L_LCNT);
    const unsigned* cnt = (const unsigned*)(p.ws + WS_CTL) + CW_CNT;
    if (tid < NE) lc[tid] = cnt[tid];
    build_tile_table(lc, lds, tid);
}

__global__ void __launch_bounds__(512, 2) fwd_kernel(Params p) {
    extern __shared__ __attribute__((aligned(16))) unsigned char lds_raw[];
    LAS unsigned char* lds = (LAS unsigned char*)lds_raw;
    const int tid = threadIdx.x, lane = tid & 63, wave = __builtin_amdgcn_readfirstlane(tid >> 6);
    const int G = gridDim.x, bid = blockIdx.x;
    const int gw = bid * 8 + wave, NGW = G * 8;
    const size_t gtid = (size_t)bid * 512 + tid, NTH = (size_t)G * 512;
    unsigned char* ws = p.ws;
    volatile LAS unsigned* misc = (volatile LAS unsigned*)(lds + L_MISC);
    if (tid < 16) misc[tid] = 0u;
    { LAS float* bt = (LAS float*)(lds + L_BTAB);
      for (int i = tid; i < 3 * 8 * 132; i += 512) { const int g = i / (8 * 132), hh = (i / 132) % 8, rel = i % 132; bt[i] = (rel <= 128) ? p.in[12][(int)p.bucket[g][rel] * 24 + g * 8 + hh] : 0.f; } }
    __syncthreads();
#if N_LAUNCHES == 1
    XcdBarrier bar = xcd_barrier_post((unsigned*)(ws + WS_CTL) + CW_BAR, misc, tid == 0);
#define GRID_BAR() xcd_barrier(bar, wave == 0 && lane_id() == 0)
#else
#define GRID_BAR() do { } while (0)
#endif
    const int lo = p.lo, hi = p.hi;
#define IN(k) (lo <= (k) && (k) < hi)
#define SEAM(k) do { if (IN(k) && IN((k) + 1)) GRID_BAR(); } while (0)
#ifndef PROBE_PHASE
#define PROBE_PHASE -1
#endif
#define REPS(k) for (int _rep = 0; _rep < ((PROBE_PHASE == (k)) ? 2 : 1); ++_rep)
#define REP_BAR() do { if (_rep) GRID_BAR(); } while (0)
#define PHASE_LOCALS const int lane = lane_id(), tid = wave * 64 + lane; const size_t gtid = (size_t)bid * 512 + tid; (void)lane; (void)gtid;

    if (IN(0)) REPS(0) { REP_BAR(); PHASE_LOCALS
        LAS float* tile = (LAS float*)lds;
        for (int it = bid; it < 720; it += G) {
            int r = it;
            if (r < 544) { tr_matrix_item_fp8(p.in[1], 1024, DIN, ws + WS_WINT, 32.f, r, tile, tid); continue; } r -= 544;
            if (r < 64) { tr_matrix_item(p.in[10], 1024, 1024, (bf16*)(ws + WS_WPRT), r, tile, tid); continue; } r -= 64;
            if (r < 32) { tr_matrix_item(p.in[11], 512, 1024, (bf16*)(ws + WS_WPAT), r, tile, tid); continue; } r -= 32;
            if (r < 64) { tr_matrix_item(p.in[13], 1024, 1024, (bf16*)(ws + WS_WOT), r, tile, tid); continue; } r -= 64;
            tr_matrix_item(p.in[16], 1024, 256, (bf16*)(ws + WS_WRT), r, tile, tid);
        }
        const f32x4* x4 = (const f32x4*)p.in[0]; u32x4* xb = (u32x4*)(ws + WS_XB);
        for (size_t i = gtid; i < (size_t)T * D / 16; i += NTH) { const f32x4 a = x4[4 * i], b = x4[4 * i + 1], c = x4[4 * i + 2], d = x4[4 * i + 3];
            u32x4 o; o.x = pk_fp8x4(a[0], a[1], a[2], a[3]); o.y = pk_fp8x4(b[0], b[1], b[2], b[3]); o.z = pk_fp8x4(c[0], c[1], c[2], c[3]); o.w = pk_fp8x4(d[0], d[1], d[2], d[3]); xb[i] = o; }
    }
    SEAM(0);
    if (IN(1)) REPS(1) { REP_BAR(); PHASE_LOCALS
        pg8::Gemm g{(const bf16*)(ws + WS_XB), (const bf16*)(ws + WS_WINT), 512, 0x7A7A7A7A, 0x7F7F7F7F}; pg8::StaticOrder S; S.init(T, DIN, G, bid);
        pg8::EpiInProj E{(bf16*)(ws + WS_PROJ), p.in[2], 1.0f / 32.0f};
        pg8::gemm_phase<pg8::EpiInProj, pg8::StaticOrder, true, true>(lds, g, S, E, wave);
    }
    SEAM(1);
    if (IN(2)) REPS(2) { REP_BAR(); PHASE_LOCALS
        LAS unsigned char* vt = lds + wave * 4608;
        for (int rr = 0; rr < (PROBE_PHASE == 20 ? 2 : 1); ++rr)
        { RgW W; int hprev = -1;
          for (int it = gw; it < NB * 16 * NCH; it += NGW) { const int h = (it / NCH) % 16; if (h != hprev) { rglru_load_w(p, h, lane, W); hprev = h; } rglru_item<1>(p, it, W, vt, lane); } }
        const LAS float* bt = (const LAS float*)(lds + L_BTAB);
        for (int rr = 0; rr < (PROBE_PHASE == 21 ? 2 : 1); ++rr)
        for (int it = gw; it < NB * 24 * 128; it += NGW) attn_item(p, it, vt, bt, lane);
    }
    SEAM(2);
    if (IN(3)) REPS(3) { REP_BAR(); PHASE_LOCALS
        { RgW W; int hprev = -1; LAS unsigned char* xcl = lds + wave * 4608;
          for (int it = gw; it < NB * 16 * NCH; it += NGW) { const int h = (it / NCH) % 16; if (h != hprev) { rglru_load_w(p, h, lane, W); hprev = h; } rglru_item<2>(p, it, W, xcl, lane); } }
        const bf16* ao = (const bf16*)(ws + WS_AO); const float* lse = (const float*)(ws + WS_LSE); bf16* yatt = (bf16*)(ws + WS_YATT);
        for (size_t i = gtid; i < (size_t)T * 64; i += NTH) { const size_t t = i >> 6; const int c8 = (int)(i & 63), hh = c8 >> 3;
            const float l0 = lse[t * 8 + hh], l1 = lse[((size_t)T + t) * 8 + hh], l2 = lse[((size_t)2 * T + t) * 8 + hh];
            const float mx = fmaxf(l0, fmaxf(l1, l2)); float w0 = __expf(l0 - mx), w1 = __expf(l1 - mx), w2 = __expf(l2 - mx); const float inv = 1.0f / (w0 + w1 + w2); w0 *= inv; w1 *= inv; w2 *= inv;
            const u32x4 a = *(const u32x4*)(ao + t * 512 + c8 * 8), bq = *(const u32x4*)(ao + ((size_t)T + t) * 512 + c8 * 8), cq = *(const u32x4*)(ao + ((size_t)2 * T + t) * 512 + c8 * 8);
            u32x4 o;
#pragma unroll
            for (int w = 0; w < 4; ++w) o[w] = pk2(w0 * bflo(a[w]) + w1 * bflo(bq[w]) + w2 * bflo(cq[w]), w0 * bfhi(a[w]) + w1 * bfhi(bq[w]) + w2 * bfhi(cq[w]));
            *(u32x4*)(yatt + t * 512 + c8 * 8) = o; }
    }
    SEAM(3);
    if (IN(4)) REPS(4) { REP_BAR(); PHASE_LOCALS
        pg8::StaticOrder S; S.init(T, D, G, bid);
        { pg8::Gemm g{(const bf16*)(ws + WS_YRNN), (const bf16*)(ws + WS_WPRT), 1024, 0x7F7F7F7F, 0x7F7F7F7F};
          pg8::EpiProjRnn E{(const bf16*)(ws + WS_PROJ), p.out};
          pg8::gemm_phase<pg8::EpiProjRnn, pg8::StaticOrder, true>(lds, g, S, E, wave); }
        asm volatile("s_waitcnt vmcnt(0)" ::: "memory"); __syncthreads();
        { pg8::Gemm g{(const bf16*)(ws + WS_YATT), (const bf16*)(ws + WS_WPAT), 512, 0x7F7F7F7F, 0x7F7F7F7F};
          pg8::EpiProjAtt E{(const bf16*)(ws + WS_PROJ), p.out, (bf16*)(ws + WS_MERGED)};
          pg8::gemm_phase<pg8::EpiProjAtt, pg8::StaticOrder, true>(lds, g, S, E, wave); }
    }
    SEAM(4);
    if (IN(5)) REPS(5) { REP_BAR(); PHASE_LOCALS
        pg8::Gemm g{(const bf16*)(ws + WS_MERGED), (const bf16*)(ws + WS_WOT), 1024, 0x7F7F7F7F, 0x7F7F7F7F}; pg8::StaticOrder S; S.init(T, D, G, bid);
        pg8::EpiF32Res E{p.in[0], (float*)(ws + WS_PRELN), D, ALPHA};
        pg8::gemm_phase<pg8::EpiF32Res, pg8::StaticOrder, true>(lds, g, S, E, wave);
    }
    SEAM(5);
    if (IN(6)) REPS(6) { REP_BAR(); PHASE_LOCALS
        const float* preln = (const float*)(ws + WS_PRELN); bf16* x1b = (bf16*)(ws + WS_X1B);
        for (int row = gw; row < T; row += NGW) {
            const f32x4* xr = (const f32x4*)(preln + (size_t)row * D) + lane; f32x4 v[4]; float s = 0.f;
#pragma unroll
            for (int j = 0; j < 4; ++j) { v[j] = xr[64 * j]; s += (v[j][0] + v[j][1]) + (v[j][2] + v[j][3]); }
            const float mean = wave_sum(s) * (1.f / D); float s2 = 0.f;
#pragma unroll
            for (int j = 0; j < 4; ++j) { v[j] = v[j] - mean; s2 += (v[j][0] * v[j][0] + v[j][1] * v[j][1]) + (v[j][2] * v[j][2] + v[j][3] * v[j][3]); }
            const float rstd = 1.f / sqrtf(wave_sum(s2) * (1.f / D) + LN_EPS);
#pragma unroll
            for (int j = 0; j < 4; ++j) { const f32x4 gm = ((const f32x4*)p.in[14])[lane + 64 * j], bt = ((const f32x4*)p.in[15])[lane + 64 * j];
                const f32x4 o = v[j] * rstd * gm + bt;
                ((f32x4*)(p.out + (size_t)row * D))[lane + 64 * j] = o;
                u32x2 w; w.x = pk2(o[0], o[1]); w.y = pk2(o[2], o[3]); ((u32x2*)(x1b + (size_t)row * D))[lane + 64 * j] = w; }
        }
        __syncthreads();
        LAS float* tile = (LAS float*)lds;
        for (int it = bid; it < 257 * 48; it += G) {
            const int e = it / 48, r = it % 48;
            if (r < 32) { const int up = r >> 4, q = r & 15, kb = q >> 1, nbk = q & 1;
                const float* W = (e < NE) ? p.in[up ? 19 : 18] + (size_t)e * 1024 * 256 : p.in[up ? 22 : 21];
                tr128(W + (size_t)kb * 128 * 256 + nbk * 128, 256, (bf16*)(ws + WS_WGU) + ((size_t)e * 512 + nbk * 256 + up * 128) * 1024 + kb * 128, 1024, tile, tid);
            } else { const int q = r - 32, kb = q >> 3, nb = q & 7;
                const float* W = (e < NE) ? p.in[20] + (size_t)e * 256 * 1024 : p.in[23];
                tr128(W + (size_t)kb * 128 * 1024 + nb * 128, 1024, (bf16*)(ws + WS_WD) + ((size_t)e * 1024 + nb * 128) * 256 + kb * 128, 256, tile, tid); }
        }
    }
    SEAM(6);
    if (IN(7)) REPS(7) { REP_BAR(); PHASE_LOCALS
        pg8::Gemm g{(const bf16*)(ws + WS_X1B), (const bf16*)(ws + WS_WRT), 1024, 0x7F7F7F7F, 0x7F7F7F7F}; pg8::StaticOrder S; S.init(T, NE, G, bid);
        pg8::EpiF32Res E{nullptr, (float*)(ws + WS_LOGITS), NE, 0.f};
        pg8::gemm_phase<pg8::EpiF32Res, pg8::StaticOrder, true>(lds, g, S, E, wave);
    }
    SEAM(7);
    if (IN(8)) REPS(8) { REP_BAR(); PHASE_LOCALS
        const float* logits = (const float*)(ws + WS_LOGITS); LAS unsigned* lcnt = (LAS unsigned*)(lds + L_LCNT);
        __syncthreads(); if (tid < NE) lcnt[tid] = 0u; __syncthreads();
        int* eidx = (int*)(ws + WS_EIDX); float* gatew = (float*)(ws + WS_GATEW); int* rank = (int*)(ws + WS_RANK);
        const int g = lane & 7, tk = lane >> 3;
        float rb[32];
#pragma unroll
        for (int q = 0; q < 8; ++q) { const f32x4 r4 = ((const f32x4*)p.in[17])[g * 8 + q]; rb[4 * q] = r4[0]; rb[4 * q + 1] = r4[1]; rb[4 * q + 2] = r4[2]; rb[4 * q + 3] = r4[3]; }
        for (int task = gw; task < T / 8; task += NGW) {
            const int t = task * 8 + tk;
            const f32x4* z4 = (const f32x4*)(logits + (size_t)t * NE + g * 32);
            f32x4 zz[8];
#pragma unroll
            for (int q = 0; q < 8; ++q) zz[q] = z4[q];
            float sc[32], sel[32];
#pragma unroll
            for (int j = 0; j < 32; ++j) { sc[j] = 1.0f / (1.0f + __expf(-zz[j >> 2][j & 3])); sel[j] = sc[j] + rb[j]; }
            float m1 = fmaxf(sel[0], sel[1]), m2 = fminf(sel[0], sel[1]);
#pragma unroll
            for (int j = 2; j < 32; ++j) { const float v = sel[j]; m2 = fmaxf(m2, fminf(m1, v)); m1 = fmaxf(m1, v); }
            const float gs = m1 + m2; int rk = 0;
#pragma unroll
            for (int g3 = 0; g3 < 8; ++g3) { const float og = __shfl(gs, (lane & ~7) + g3); rk += (og > gs || (og == gs && g3 < g)) ? 1 : 0; }
            if (rk >= 4) {
#pragma unroll
                for (int j = 0; j < 32; ++j) sel[j] = -INFINITY;
            }
            int me = 0; float ms = 0.f, gsum = 0.f;
#pragma unroll
            for (int k = 0; k < 8; ++k) {
                float bv = sel[0], bs = sc[0]; int bj = 0;
#pragma unroll
                for (int j = 1; j < 32; ++j) { const bool gt = sel[j] > bv; bv = gt ? sel[j] : bv; bs = gt ? sc[j] : bs; bj = gt ? j : bj; }
                int bi = g * 32 + bj;
#pragma unroll
                for (int o = 1; o < 8; o <<= 1) { const float ov = __shfl_xor(bv, o), os = __shfl_xor(bs, o); const int oi = __shfl_xor(bi, o);
                    const bool tk2 = (ov > bv) || (ov == bv && oi < bi); bv = tk2 ? ov : bv; bs = tk2 ? os : bs; bi = tk2 ? oi : bi; }
                const bool own = (bi >> 5) == g; const int jj = bi & 31;
#pragma unroll
                for (int j = 0; j < 32; ++j) sel[j] = (own && j == jj) ? -INFINITY : sel[j];
                gsum += bs; if (g == k) { me = bi; ms = bs; }
            }
            const int rr = (int)__hip_atomic_fetch_add(&lcnt[me], 1u, __ATOMIC_RELAXED, __HIP_MEMORY_SCOPE_WORKGROUP);
            const size_t q = (size_t)t * 8 + g;
            eidx[q] = me; gatew[q] = ms * 2.5f / gsum; rank[q] = rr;
        }
        __syncthreads();
        if (tid < NE) ((unsigned*)(ws + WS_HIST))[(size_t)bid * NE + tid] = lcnt[tid];
    }
    SEAM(8);
    if (IN(9)) REPS(9) { REP_BAR(); PHASE_LOCALS
        LAS unsigned* lcnt = (LAS unsigned*)(lds + L_LCNT); LAS unsigned* bbase = (LAS unsigned*)(lds + L_BBASE);
        __syncthreads();
        { const u32x4* hist4 = (const u32x4*)(ws + WS_HIST); const int e4 = tid & 63, part = tid >> 6; u32x4 tot = (u32x4){0u, 0u, 0u, 0u}, bs = tot;
          const int per = (G + 7) / 8, b0 = part * per, b1 = (b0 + per < G) ? b0 + per : G;
#pragma unroll 8
          for (int b = b0; b < b1; ++b) { const u32x4 v = hist4[(size_t)b * 64 + e4]; tot += v; if (b < bid) bs += v; }
          LAS u32x4* pt = (LAS u32x4*)lds; pt[part * 64 + e4] = tot; pt[512 + part * 64 + e4] = bs; }
        __syncthreads();
        if (tid < NE) { const LAS unsigned* pw = (const LAS unsigned*)lds; unsigned tot = 0u, bs = 0u;
#pragma unroll
            for (int pp = 0; pp < 8; ++pp) { tot += pw[pp * 256 + tid]; bs += pw[2048 + pp * 256 + tid]; }
            lcnt[tid] = tot; bbase[tid] = bs; if (bid == 0) ((unsigned*)(ws + WS_CTL))[CW_CNT + tid] = tot; }
        build_tile_table(lcnt, lds, tid);
        const LAS int* tbase = (const LAS int*)(lds + L_TBASE);
        const int* eidx = (const int*)(ws + WS_EIDX); const float* gatew = (const float*)(ws + WS_GATEW); const int* rank = (const int*)(ws + WS_RANK);
        int* slotof = (int*)(ws + WS_SLOTOF); int* tokslot = (int*)(ws + WS_TOKSLOT); float* wslot = (float*)(ws + WS_WSLOT);
        for (int task = gw; task < T / 8; task += NGW) {
            const int t = task * 8 + (lane >> 3); const size_t q = (size_t)t * 8 + (lane & 7);
            const int e = eidx[q]; const int slot = tbase[e] * 256 + (int)bbase[e] + rank[q]; tokslot[slot] = t; wslot[slot] = gatew[q]; slotof[q] = slot; }
        for (size_t i = gtid; i < (size_t)NE * 256; i += NTH) { const int e = (int)(i >> 8), j = (int)(i & 255); const int s = (int)lcnt[e] + j; if (s < (tbase[e + 1] - tbase[e]) * 256) { tokslot[tbase[e] * 256 + s] = 0; wslot[tbase[e] * 256 + s] = 0.f; } }
        const int sb = tbase[NE] * 256;
        for (size_t i = gtid; i < (size_t)T; i += NTH) { tokslot[sb + i] = (int)i; }
    }
    SEAM(9);
    if (IN(10)) REPS(10) { REP_BAR(); PHASE_LOCALS
        build_tile_table_g(p, lds, tid);
        const LAS int* tbase = (const LAS int*)(lds + L_TBASE);
        pg8::GroupOrder<true> S; S.nN = 2; S.nwg = tbase[NE + 1] * 2; S.G = G; S.c = bid; S.tile_e = (const LAS unsigned short*)(lds + L_TILEE); S.tok = (const int*)(ws + WS_TOKSLOT); S.rowbytes = 2048u;
        pg8::Gemm g{(const bf16*)(ws + WS_X1B), (const bf16*)(ws + WS_WGU), 1024, 0x7F7F7F7F, 0x7F7F7F7F};
        pg8::EpiGateUp E{(bf16*)(ws + WS_H)};
        pg8::gemm_phase<pg8::EpiGateUp, pg8::GroupOrder<true>, true>(lds, g, S, E, wave);
    }
    SEAM(10);
    if (IN(11)) REPS(11) { REP_BAR(); PHASE_LOCALS
        build_tile_table_g(p, lds, tid);
        const LAS int* tbase = (const LAS int*)(lds + L_TBASE);
        pg8::GroupOrder<false> S; S.nN = 4; S.nwg = ((PROBE_PHASE == 11 && _rep == 0) ? tbase[NE] : tbase[NE + 1]) * 4; S.G = G; S.c = bid; S.tile_e = (const LAS unsigned short*)(lds + L_TILEE); S.tok = nullptr; S.rowbytes = 0u;
        pg8::Gemm g{(const bf16*)(ws + WS_H), (const bf16*)(ws + WS_WD), 256, 0x7F7F7F7F, 0x7F7F7F7F};
        pg8::EpiDown E{(bf16*)(ws + WS_Y), (const float*)(ws + WS_WSLOT), p.out, tbase[NE]};
        pg8::gemm_phase<pg8::EpiDown, pg8::GroupOrder<false>, true>(lds, g, S, E, wave);
    }
    SEAM(11);
    if (IN(12)) REPS(12) { REP_BAR(); PHASE_LOCALS
        const bf16* Y = (const bf16*)(ws + WS_Y); const int* slotof = (const int*)(ws + WS_SLOTOF);
        for (int t = gw; t < T; t += NGW) {
            float* orow = p.out + (size_t)t * D; float* wrow = (PROBE_PHASE == 12 && _rep == 0) ? (float*)(ws + WS_H) + (size_t)t * D : orow; float v[16];
            { const f32x4 a = *(const f32x4*)(orow + 8 * lane), b = *(const f32x4*)(orow + 8 * lane + 4), c = *(const f32x4*)(orow + 512 + 8 * lane), d = *(const f32x4*)(orow + 512 + 8 * lane + 4);
#pragma unroll
              for (int j = 0; j < 4; ++j) { v[j] = a[j]; v[4 + j] = b[j]; v[8 + j] = c[j]; v[12 + j] = d[j]; } }
            int sl[8];
#pragma unroll
            for (int k = 0; k < 8; ++k) sl[k] = slotof[(size_t)t * 8 + k];
#pragma unroll
            for (int k = 0; k < 8; ++k) { const bf16* yr = Y + (size_t)sl[k] * D; const u32x4 a = *(const u32x4*)(yr + 8 * lane), b = *(const u32x4*)(yr + 512 + 8 * lane);
#pragma unroll
                for (int w = 0; w < 4; ++w) { v[2 * w] += bflo(a[w]); v[2 * w + 1] += bfhi(a[w]); v[8 + 2 * w] += bflo(b[w]); v[8 + 2 * w + 1] += bfhi(b[w]); } }
            float s = 0.f;
#pragma unroll
            for (int j = 0; j < 16; ++j) s += v[j];
            const float mean = wave_sum(s) * (1.f / D); float s2 = 0.f;
#pragma unroll
            for (int j = 0; j < 16; ++j) { v[j] -= mean; s2 += v[j] * v[j]; }
            const float rstd = 1.f / sqrtf(wave_sum(s2) * (1.f / D) + LN_EPS);
            const float* gm = p.in[24]; const float* bt = p.in[25];
#pragma unroll
            for (int q = 0; q < 4; ++q) { const int c0 = (q >> 1) * 512 + 8 * lane + (q & 1) * 4; const f32x4 g4 = *(const f32x4*)(gm + c0), b4 = *(const f32x4*)(bt + c0); f32x4 o;
#pragma unroll
                for (int j = 0; j < 4; ++j) o[j] = v[4 * q + j] * rstd * g4[j] + b4[j];
                *(f32x4*)(wrow + c0) = o; }
        }
    }
#undef IN
#undef SEAM
}

extern "C" void kernel_launch(void* const* d_in, const int* in_sizes, int n_in, void* d_out, int out_size, void* d_ws, size_t ws_size, hipStream_t stream) {
    static int grid = 0;
    if (grid == 0) {
        if (n_in != 26 || in_sizes[0] != T * D || out_size != T * D || ws_size < WS_END) { fprintf(stderr, "kernel_launch: unexpected shapes / workspace (%d inputs, ws %zu < %zu)\n", n_in, ws_size, (size_t)WS_END); grid = -1; return; }
        int dev = 0, cus = 0, per_cu = 0;
        if (hipGetDevice(&dev) != hipSuccess || hipDeviceGetAttribute(&cus, hipDeviceAttributeMultiprocessorCount, dev) != hipSuccess) { grid = -1; return; }
        if (hipFuncSetAttribute((const void*)fwd_kernel, hipFuncAttributeMaxDynamicSharedMemorySize, LDS_BYTES) != hipSuccess) { fprintf(stderr, "kernel_launch: hipFuncSetAttribute failed\n"); grid = -1; return; }
        if (hipOccupancyMaxActiveBlocksPerMultiprocessor(&per_cu, (const void*)fwd_kernel, 512, LDS_BYTES) != hipSuccess || per_cu < 1) { fprintf(stderr, "kernel_launch: occupancy query says %d\n", per_cu); }
        (void)hipGetLastError();
        grid = cus;
    }
    if (grid < 0) return;
    (void)hipMemsetAsync((char*)d_ws + WS_CTL, 0, CTL_BYTES, stream);
    Params p{};
    for (int i = 0; i < 26; ++i) p.in[i] = (const float*)d_in[i];
    p.out = (float*)d_out; p.ws = (unsigned char*)d_ws;
    const int dils[3] = {1, 4, 16};
    for (int g = 0; g < 3; ++g) for (int rel = 0; rel <= 128; ++rel) {
        const long dist = (long)rel * dils[g]; long bk;
        if (dist < 16) bk = dist;
        else { const double dd = (double)(dist < 1 ? 1 : dist); long large = 16 + (long)(std::log(dd / 16.0) / std::log(2048.0 / 16.0) * 16.0); bk = large < 31 ? large : 31; }
        p.bucket[g][rel] = (unsigned char)bk;
    }
#if N_LAUNCHES == 1
    p.lo = 0; p.hi = NPHASE;
    hipLaunchKernelGGL(fwd_kernel, dim3(grid), dim3(512), LDS_BYTES, stream, p);
#else
    for (int k = 0; k < NPHASE; ++k) { p.lo = k; p.hi = k + 1; hipLaunchKernelGGL(fwd_kernel, dim3(grid), dim3(512), LDS_BYTES, stream, p); }
#endif
}
```

```cpp
#include <hip/hip_runtime.h>
#include <cstdio>
#include <cstdint>
#include <cmath>

#ifndef N_LAUNCHES
#define N_LAUNCHES 1
#endif

#define GAS __attribute__((address_space(1)))
#define LAS __attribute__((address_space(3)))
typedef unsigned short bf16;
typedef float f32x2 __attribute__((ext_vector_type(2)));
typedef float f32x4 __attribute__((ext_vector_type(4)));
typedef float f32x16 __attribute__((ext_vector_type(16)));
typedef short bf16x8 __attribute__((ext_vector_type(8)));
typedef short bf16x4 __attribute__((ext_vector_type(4)));
typedef unsigned u32x4 __attribute__((ext_vector_type(4)));
typedef unsigned u32x2 __attribute__((ext_vector_type(2)));

constexpr int NB = 8, SEQ = 4096, T = NB * SEQ, D = 1024, DIN = 8704;
constexpr int C_XR = 0, C_GR = 1024, C_Q = 2048, C_K = 3584, C_V = 5120, C_GRNN = 6656, C_GATT = 7680;
constexpr int NE = 256, TOPK = 8, DE = 256;
constexpr int TCH = 128, NCH = SEQ / TCH;
constexpr int MAXT_R = 1280, SH_TILES = T / 256, MAXT = MAXT_R + SH_TILES;
constexpr float ALPHA = 1.18920711500272f, LN_EPS = 1e-5f;
constexpr int NPHASE = 13;

constexpr size_t MiB = 1u << 20;
constexpr size_t WS_CTL = 0, CTL_BYTES = 1 * MiB;
constexpr size_t WS_WINT = 1 * MiB;
constexpr size_t WS_WPRT = 18 * MiB;
constexpr size_t WS_WPAT = 20 * MiB;
constexpr size_t WS_WOT = 21 * MiB;
constexpr size_t WS_WRT = 23 * MiB;
constexpr size_t WS_HIST = 31 * MiB + 512 * 1024;
constexpr size_t WS_EIDX = 24 * MiB, WS_GATEW = 25 * MiB, WS_RANK = 26 * MiB, WS_SLOTOF = 27 * MiB, WS_TOKSLOT = 28 * MiB, WS_WSLOT = 30 * MiB;
constexpr size_t WS_XB = 32 * MiB;
constexpr size_t WS_YRNN = 32 * MiB;
constexpr size_t WS_HLOC = 96 * MiB;
constexpr size_t WS_MERGED = 96 * MiB;
constexpr size_t WS_CUMA = 160 * MiB;
constexpr size_t WS_AO = 224 * MiB;
constexpr size_t WS_YATT = 320 * MiB;
constexpr size_t WS_SUMA = 352 * MiB, WS_SUMH = 353 * MiB;
constexpr size_t WS_LSE = 354 * MiB;
constexpr size_t WS_PROJ = 360 * MiB;
constexpr size_t WS_PRELN = 700 * MiB;
constexpr size_t WS_WD = 32 * MiB;
constexpr size_t WS_H = 161 * MiB;
constexpr size_t WS_Y = 337 * MiB;
constexpr size_t WS_X1B = 337 * MiB;
constexpr size_t WS_WGU = 401 * MiB;
constexpr size_t WS_X1B8 = 830 * MiB;
constexpr size_t WS_LOGITS = 658 * MiB;
constexpr size_t WS_END = 977 * MiB;
constexpr int CW_BAR = 4096, CW_CNT = 16384;

constexpr int RING_BYTES = 131072;
constexpr int L_TBASE = RING_BYTES;
constexpr int L_TILEE = L_TBASE + 1040;
constexpr int L_BTAB = L_TILEE + 2816;
constexpr int L_MISC = L_BTAB + 12672;
constexpr int L_LCNT = L_MISC + 64;
constexpr int L_BBASE = L_LCNT + 1024;
constexpr int L_STAMP = L_BBASE + 1024;
constexpr int LDS_BYTES = 151552;
static_assert(L_STAMP + 64 <= LDS_BYTES, "LDS map");

__device__ __forceinline__ unsigned f2bf(float f) { unsigned u = __builtin_bit_cast(unsigned, f); return (u + 0x7fffu + ((u >> 16) & 1u)) >> 16; }
__device__ __forceinline__ unsigned pk2(float lo, float hi) { return f2bf(lo) | (f2bf(hi) << 16); }
__device__ __forceinline__ unsigned pk_fp8x4(float a, float b, float c, float d) {
    a = __builtin_amdgcn_fmed3f(a, -448.f, 448.f); b = __builtin_amdgcn_fmed3f(b, -448.f, 448.f); c = __builtin_amdgcn_fmed3f(c, -448.f, 448.f); d = __builtin_amdgcn_fmed3f(d, -448.f, 448.f);
    int w = 0; w = __builtin_amdgcn_cvt_pk_fp8_f32(a, b, w, false); w = __builtin_amdgcn_cvt_pk_fp8_f32(c, d, w, true); return (unsigned)w; }
__device__ __forceinline__ float bflo(unsigned w) { return __builtin_bit_cast(float, w << 16); }
__device__ __forceinline__ float bfhi(unsigned w) { return __builtin_bit_cast(float, w & 0xffff0000u); }
__device__ __forceinline__ float bf1(bf16 h) { return __builtin_bit_cast(float, (unsigned)h << 16); }
__device__ __forceinline__ float sigmoidf_(float x) { return 1.0f / (1.0f + __expf(-x)); }
__device__ __forceinline__ float gelu_tanh(float x) { const float z = 1.5957691216057308f * (x + 0.044715f * x * x * x); return x / (1.0f + __expf(-z)); }
__device__ __forceinline__ float wave_sum(float v) {
#pragma unroll
    for (int o = 1; o < 64; o <<= 1) v += __shfl_xor(v, o);
    return v;
}

__device__ __forceinline__ int lane_id() { return (int)__builtin_amdgcn_mbcnt_hi(~0u, __builtin_amdgcn_mbcnt_lo(~0u, 0u)); }
namespace pg8 {
#define PG8_LAS __attribute__((address_space(3)))
typedef unsigned short bf16_t;
constexpr int BM = 256, BK = 64, HALF = 128, HTB = HALF * BK * 2, STAGE_BYTES = 8 * HTB, NXCD = 8, WGM = 8;
__host__ __device__ __forceinline__ int lds_byte(int r, int c) { const int st = (r >> 4) * 2 + (c >> 5), rr = r & 15, cc = c & 31, ob = rr * 64 + cc * 2; return st * 1024 + (ob ^ (((ob >> 9) & 1) << 5)); }
__host__ __device__ __forceinline__ void stage_rc(int b, int& R, int& C) { const int st = b / 1024, sb = b % 1024, swz = sb ^ (((sb >> 9) & 1) << 5); R = (st >> 1) * 16 + swz / 64; C = (st & 1) * 32 + (swz % 64) / 2; }
__host__ __device__ __forceinline__ int perm32(int rho) { const int n = rho >> 4, i = rho & 15; return 8 * (i >> 2) + 4 * n + (i & 3); }

struct Unit { int pm, pn, pb; };
struct Gemm { const bf16_t* A; const bf16_t* Bt; int K; int sw, sa; };

struct StaticOrder {
    static constexpr bool GATHER = false;
    int nM, nN, nwg, G, c;
    __device__ __forceinline__ void init(int M, int N, int G_, int c_) { nM = M / BM; nN = N / BM; nwg = nM * nN; G = G_; c = c_; }
    __device__ __forceinline__ bool next(int i, Unit& u) const {
        const long L = (long)i * G + c; if (L >= nwg) return false;
        int wgid = (int)L; { const int q = nwg / NXCD, r = nwg % NXCD, xcd = wgid % NXCD, off = wgid / NXCD; wgid = (xcd < r ? xcd * (q + 1) : r * (q + 1) + (xcd - r) * q) + off; }
        const int nig = WGM * nN, gid = wgid / nig, fm = gid * WGM, gsz = (nM - fm) < WGM ? (nM - fm) : WGM;
        u.pm = fm + ((wgid % nig) % gsz); u.pn = (wgid % nig) / gsz; u.pb = u.pn; return true;
    }
    __device__ __forceinline__ unsigned arow(int) const { return 0u; }
};
template <bool GATHER_> struct GroupOrder {
    static constexpr bool GATHER = GATHER_;
    int nN, nwg, G, c; const LAS unsigned short* tile_e; const int* tok; unsigned rowbytes;
    __device__ __forceinline__ bool next(int i, Unit& u) const {
        const long L = (long)i * G + c; if (L >= nwg) return false;
        u.pm = (int)L / nN; u.pn = (int)L % nN; u.pb = __builtin_amdgcn_readfirstlane((int)tile_e[u.pm]) * nN + u.pn; return true;
    }
    __device__ __forceinline__ unsigned arow(int slot) const { return (unsigned)tok[slot] * rowbytes; }
};

__device__ __forceinline__ unsigned cvt_pk_bf16(float lo, float hi) { unsigned r; asm volatile("v_cvt_pk_bf16_f32 %0, %1, %2" : "=v"(r) : "v"(lo), "v"(hi)); return r; }

typedef int i32x4 __attribute__((ext_vector_type(4)));
typedef int i32x8 __attribute__((ext_vector_type(8)));
__device__ __forceinline__ f32x4 mma8(bf16x8 w0, bf16x8 w1, bf16x8 a0, bf16x8 a1, f32x4 c, int sw, int sa) {
    const i32x8 W = __builtin_shufflevector(__builtin_bit_cast(i32x4, w0), __builtin_bit_cast(i32x4, w1), 0, 1, 2, 3, 4, 5, 6, 7);
    const i32x8 A = __builtin_shufflevector(__builtin_bit_cast(i32x4, a0), __builtin_bit_cast(i32x4, a1), 0, 1, 2, 3, 4, 5, 6, 7);
    (void)sw; (void)sa; return __builtin_amdgcn_mfma_scale_f32_16x16x128_f8f6f4(W, A, c, 0, 0, 0, 0, 0, 0);
}
template <class Epi, class Sched, bool ALIGN_EPI = false, bool FP8 = false>
__device__ __forceinline__ void gemm_phase(PG8_LAS unsigned char* lds, const Gemm g, const Sched& S, const Epi& E, int wid) {
    constexpr bool GA = Sched::GATHER;
    int lane_ = lane_id(); asm volatile("" : "+v"(lane_));
    const int lane = lane_, tid = wid * 64 + lane, wr = wid >> 2, wc = wid & 3, fr = lane & 15, fq = lane >> 4;
    const int K = g.K, nt = K / BK;
    unsigned voffA[2], voffA1[2], voffB[2];
#pragma unroll
    for (int i = 0; i < 2; ++i) { int R, C; stage_rc(tid * 16 + i * 8192, R, C); const int Rb = Epi::PERM ? ((R & ~31) + perm32(R & 31)) : R;
        voffA[i] = (unsigned)(R * K + C) * 2u; voffA1[i] = voffA[i]; voffB[i] = (unsigned)(Rb * K + C) * 2u; }
    const size_t kstep = (size_t)(BK * 2);
    const size_t hstep = (size_t)HALF * K * 2;
    const size_t tstep = 2 * hstep;
    const size_t hstepA = GA ? 0 : hstep;
    const unsigned ldsw = (unsigned)wid * 1024u;
    const unsigned ldsbase = (unsigned)(size_t)lds + ldsw;
    const int aoff = lds_byte(wr * 64 + fr, fq * 8), boff = lds_byte(wc * 32 + fr, fq * 8);
    unsigned abase = (unsigned)(size_t)lds + (unsigned)aoff, bbase = (unsigned)(size_t)lds + 65536u + (unsigned)boff;
    asm volatile("" : "+v"(abase), "+v"(bbase));
#define PG8_RDA(off) (*(const PG8_LAS i32x4*)(size_t)(abase + (unsigned)(off)))
#define PG8_RDB(off) (*(const PG8_LAS i32x4*)(size_t)(bbase + (unsigned)((off) - 65536)))
#define PG8_SA(b, h) (((b) * 2 + (h)) * HTB)
#define PG8_SB(b, h) ((4 + (b) * 2 + (h)) * HTB)
#define PG8_STAGE(bufoff, gbase, voff) do { _Pragma("unroll") for (int _i = 0; _i < 2; ++_i) { unsigned _keep; \
        asm volatile("s_mov_b32 %0, m0\n\ts_mov_b32 m0, %3\n\ts_nop 0\n\tglobal_load_lds_dwordx4 %1, %2\n\ts_mov_b32 m0, %0" : "=&s"(_keep) : "v"((voff)[_i]), "s"((const char*)(gbase)), "s"(ldsbase + (unsigned)((bufoff) + _i * 8192)) : "memory"); } } while (0)
#define PG8_LDA(dst, b, h) do { if constexpr (FP8) { _Pragma("unroll") for (int m = 0; m < 4; ++m) dst##8[m] = __builtin_shufflevector(PG8_RDA(PG8_SA(b, h) + m * 2048), PG8_RDA(PG8_SA(b, h) + m * 2048 + 1024), 0, 1, 2, 3, 4, 5, 6, 7); } \
        else { _Pragma("unroll") for (int m = 0; m < 4; ++m) _Pragma("unroll") for (int k = 0; k < 2; ++k) dst[m][k] = __builtin_bit_cast(bf16x8, PG8_RDA(PG8_SA(b, h) + m * 2048 + k * 1024)); } } while (0)
#define PG8_LDB(dst, b, h) do { if constexpr (FP8) { _Pragma("unroll") for (int n = 0; n < 2; ++n) dst##8[n] = __builtin_shufflevector(PG8_RDB(PG8_SB(b, h) + n * 2048), PG8_RDB(PG8_SB(b, h) + n * 2048 + 1024), 0, 1, 2, 3, 4, 5, 6, 7); } \
        else { _Pragma("unroll") for (int n = 0; n < 2; ++n) _Pragma("unroll") for (int k = 0; k < 2; ++k) dst[n][k] = __builtin_bit_cast(bf16x8, PG8_RDB(PG8_SB(b, h) + n * 2048 + k * 1024)); } } while (0)
#define PG8_MMA(ai, bj, At, Bt) do { __builtin_amdgcn_s_setprio(1); \
        if constexpr (FP8) { _Pragma("unroll") for (int m = 0; m < 4; ++m) _Pragma("unroll") for (int n = 0; n < 2; ++n) acc[ai][bj][m][n] = __builtin_amdgcn_mfma_scale_f32_16x16x128_f8f6f4(Bt##8[n], At##8[m], acc[ai][bj][m][n], 0, 0, 0, 0, 0, 0); } \
        else { _Pragma("unroll") for (int m = 0; m < 4; ++m) _Pragma("unroll") for (int n = 0; n < 2; ++n) _Pragma("unroll") for (int k = 0; k < 2; ++k) \
        acc[ai][bj][m][n] = __builtin_amdgcn_mfma_f32_16x16x32_bf16(Bt[n][k], At[m][k], acc[ai][bj][m][n], 0, 0, 0); } __builtin_amdgcn_s_setprio(0); } while (0)
#define PG8_WAIT_V(n) asm volatile("s_waitcnt vmcnt(" #n ")" ::: "memory")
#define PG8_WAIT_L(n) asm volatile("s_waitcnt lgkmcnt(" #n ")" ::: "memory")
#define PG8_BAR __builtin_amdgcn_s_barrier()
#define PG8_SCHED __builtin_amdgcn_sched_barrier(0)
    Unit cur, nxt; int ui = 0;
    if (!S.next(0, cur)) return;
    f32x4 acc[2][2][4][2];
#pragma unroll
    for (int a = 0; a < 2; ++a)
#pragma unroll
        for (int b = 0; b < 2; ++b)
#pragma unroll
            for (int m = 0; m < 4; ++m)
#pragma unroll
                for (int n = 0; n < 2; ++n) acc[a][b][m][n] = (f32x4){0.f, 0.f, 0.f, 0.f};
    bf16x8 At[4][2], B0[2][2], B1[2][2]; i32x8 At8[4], B08[2], B18[2]; (void)At; (void)B0; (void)B1; (void)At8; (void)B08; (void)B18;
    const char* cA = GA ? (const char*)g.A : (const char*)g.A + (size_t)cur.pm * tstep; const char* cB = (const char*)g.Bt + (size_t)cur.pb * tstep;
#define PG8_GATHER_OFFS(pm_) do { int _ln = lane_id(); asm volatile("" : "+v"(_ln)); int _R, _C; stage_rc((wid * 64 + _ln) * 16, _R, _C); \
        _Pragma("unroll") for (int _i = 0; _i < 2; ++_i) { voffA[_i] = S.arow((pm_) * BM + _R + 64 * _i) + (unsigned)(_C * 2); voffA1[_i] = S.arow((pm_) * BM + HALF + _R + 64 * _i) + (unsigned)(_C * 2); } } while (0)
    if constexpr (GA) PG8_GATHER_OFFS(cur.pm);
    PG8_STAGE(PG8_SB(0, 0), cB, voffB); PG8_STAGE(PG8_SB(0, 1), cB + hstep, voffB); PG8_STAGE(PG8_SA(0, 0), cA, voffA); PG8_STAGE(PG8_SA(0, 1), cA + hstepA, voffA1);
    if (wr == 1) PG8_BAR;
    PG8_WAIT_V(2); PG8_BAR;
    PG8_STAGE(PG8_SB(1, 0), cB + kstep, voffB); PG8_STAGE(PG8_SA(1, 0), cA + kstep, voffA); PG8_STAGE(PG8_SB(1, 1), cB + hstep + kstep, voffB);
    PG8_WAIT_V(6); PG8_BAR;
    for (;;) {
        const bool has_next = S.next(ui + 1, nxt);
        const char* nA = GA ? (const char*)g.A : (has_next ? (const char*)g.A + (size_t)nxt.pm * tstep : cA);
        const char* nB = has_next ? (const char*)g.Bt + (size_t)nxt.pb * tstep : cB;
#pragma clang loop unroll(disable)
        for (int t = 0; t < nt; t += 2) {
            const bool last = (t == nt - 2);
            const char* a1 = cA + (size_t)(t + 1) * kstep;
            const char* a2 = last ? nA : cA + (size_t)(t + 2) * kstep; const char* b2 = last ? nB : cB + (size_t)(t + 2) * kstep;
            const char* a3 = a2 + kstep; const char* b3 = b2 + kstep;
            PG8_LDB(B0, 0, 0); PG8_LDB(B1, 0, 1); PG8_SCHED; PG8_LDA(At, 0, 0); PG8_STAGE(PG8_SA(1, 1), a1 + hstepA, voffA1);
            if constexpr (GA) { if (last && has_next) PG8_GATHER_OFFS(nxt.pm); }
            PG8_WAIT_V(8); PG8_WAIT_L(0); PG8_BAR; PG8_MMA(0, 0, At, B0); PG8_MMA(0, 1, At, B1); PG8_BAR; PG8_SCHED;
            PG8_LDA(At, 0, 1); PG8_STAGE(PG8_SB(0, 0), b2, voffB); PG8_STAGE(PG8_SB(0, 1), b2 + hstep, voffB); PG8_STAGE(PG8_SA(0, 0), a2, voffA);
            PG8_WAIT_V(8); PG8_WAIT_L(0); PG8_BAR; PG8_MMA(1, 0, At, B0); PG8_MMA(1, 1, At, B1); PG8_BAR; PG8_SCHED;
            PG8_LDB(B0, 1, 0); PG8_LDB(B1, 1, 1); PG8_SCHED; PG8_LDA(At, 1, 0); PG8_STAGE(PG8_SA(0, 1), a2 + hstepA, voffA1);
            PG8_WAIT_V(8); PG8_WAIT_L(0); PG8_BAR; PG8_MMA(0, 0, At, B0); PG8_MMA(0, 1, At, B1); PG8_BAR; PG8_SCHED;
            PG8_LDA(At, 1, 1); PG8_STAGE(PG8_SB(1, 0), b3, voffB); PG8_STAGE(PG8_SB(1, 1), b3 + hstep, voffB); PG8_STAGE(PG8_SA(1, 0), a3, voffA);
            PG8_WAIT_V(8); PG8_WAIT_L(0); PG8_BAR; PG8_MMA(1, 0, At, B0); PG8_MMA(1, 1, At, B1); PG8_BAR; PG8_SCHED;
        }
        if constexpr (ALIGN_EPI) { if (wr == 0) PG8_BAR; }
        { Unit eu = cur; int efr = fr, efq = fq;
          asm volatile("" : "+s"(eu.pm), "+s"(eu.pn), "+s"(eu.pb)); asm volatile("" : "+v"(efr), "+v"(efq));
          E(acc, eu, wr, wc, efr, efq); }
        if (!has_next) break;
#pragma unroll
        for (int a = 0; a < 2; ++a)
#pragma unroll
            for (int b = 0; b < 2; ++b)
#pragma unroll
                for (int m = 0; m < 4; ++m)
#pragma unroll
                    for (int n = 0; n < 2; ++n) acc[a][b][m][n] = (f32x4){0.f, 0.f, 0.f, 0.f};
        cur = nxt; cA = nA; cB = nB; ++ui;
        if constexpr (ALIGN_EPI) { if (wr == 1) PG8_BAR; }
    }
    PG8_WAIT_V(0);
    if constexpr (!ALIGN_EPI) { if (wr == 0) PG8_BAR; }
    PG8_BAR;
#undef PG8_SA
#undef PG8_SB
#undef PG8_STAGE
#undef PG8_LDA
#undef PG8_LDB
#undef PG8_GATHER_OFFS
#undef PG8_RDA
#undef PG8_RDB
#undef PG8_MMA
#undef PG8_WAIT_V
#undef PG8_WAIT_L
#undef PG8_BAR
#undef PG8_SCHED
}

typedef const f32x4 (&AccRef)[2][2][4][2];

struct EpiInProj {
    static constexpr bool PERM = true;
    bf16_t* O; const float* bias; float os;
    __device__ __forceinline__ void operator()(AccRef acc, const Unit& u, int wr, int wc, int fr, int fq) const {
        const int row0 = u.pm * BM + wr * 64 + fr, col0 = u.pn * BM + wc * 32 + 8 * fq;
        const int kind = u.pn < 4 ? 0 : (u.pn < 8 ? 1 : (u.pn < 14 ? 2 : (u.pn < 26 ? 0 : 3)));
        f32x4 bv[2][2];
#pragma unroll
        for (int bj = 0; bj < 2; ++bj)
#pragma unroll
            for (int n = 0; n < 2; ++n) bv[bj][n] = *(const f32x4*)(bias + col0 + bj * HALF + 4 * n);
#pragma unroll
        for (int ai = 0; ai < 2; ++ai)
#pragma unroll
            for (int m = 0; m < 4; ++m) { bf16_t* rowp = O + (size_t)(row0 + ai * HALF + m * 16) * DIN + col0;
#pragma unroll
                for (int bj = 0; bj < 2; ++bj) { f32x4 v0 = acc[ai][bj][m][0] * os + bv[bj][0], v1 = acc[ai][bj][m][1] * os + bv[bj][1];
                    if (kind == 1) {
#pragma unroll
                        for (int j = 0; j < 4; ++j) { v0[j] = gelu_tanh(v0[j]); v1[j] = gelu_tanh(v1[j]); }
                    } else if (kind == 2) { v0 = v0 * 0.125f; v1 = v1 * 0.125f; }
                    else if (kind == 3) {
#pragma unroll
                        for (int j = 0; j < 4; ++j) { v0[j] = sigmoidf_(v0[j]); v1[j] = sigmoidf_(v1[j]); }
                    }
                    u32x4 w; w.x = cvt_pk_bf16(v0[0], v0[1]); w.y = cvt_pk_bf16(v0[2], v0[3]); w.z = cvt_pk_bf16(v1[0], v1[1]); w.w = cvt_pk_bf16(v1[2], v1[3]);
                    *(u32x4*)(rowp + bj * HALF) = w; } }
    }
};
struct EpiProjRnn {
    static constexpr bool PERM = true;
    const bf16_t* proj; float* part; float os;
    __device__ __forceinline__ void operator()(AccRef acc, const Unit& u, int wr, int wc, int fr, int fq) const {
        const int row0 = u.pm * BM + wr * 64 + fr, col0 = u.pn * BM + wc * 32 + 8 * fq;
#pragma unroll
        for (int ai = 0; ai < 2; ++ai)
#pragma unroll
            for (int m = 0; m < 4; ++m) { const size_t row = (size_t)(row0 + ai * HALF + m * 16);
#pragma unroll
                for (int bj = 0; bj < 2; ++bj) { const int c = col0 + bj * HALF;
                    const u32x4 gw = *(const u32x4*)(proj + row * DIN + C_GRNN + c);
                    const f32x4 g0 = (f32x4){bflo(gw.x), bfhi(gw.x), bflo(gw.y), bfhi(gw.y)} * os, g1 = (f32x4){bflo(gw.z), bfhi(gw.z), bflo(gw.w), bfhi(gw.w)} * os;
                    *(f32x4*)(part + row * D + c) = g0 * acc[ai][bj][m][0]; *(f32x4*)(part + row * D + c + 4) = g1 * acc[ai][bj][m][1]; } }
    }
};
struct EpiProjAtt {
    static constexpr bool PERM = true;
    const bf16_t* proj; const float* part; unsigned char* merged; float os;
    __device__ __forceinline__ void operator()(AccRef acc, const Unit& u, int wr, int wc, int fr, int fq) const {
        const int row0 = u.pm * BM + wr * 64 + fr, col0 = u.pn * BM + wc * 32 + 8 * fq;
#pragma unroll
        for (int ai = 0; ai < 2; ++ai)
#pragma unroll
            for (int m = 0; m < 4; ++m) { const size_t row = (size_t)(row0 + ai * HALF + m * 16);
#pragma unroll
                for (int bj = 0; bj < 2; ++bj) { const int c = col0 + bj * HALF;
                    const u32x4 gw = *(const u32x4*)(proj + row * DIN + C_GATT + c);
                    const f32x4 g0 = (f32x4){bflo(gw.x), bfhi(gw.x), bflo(gw.y), bfhi(gw.y)} * os, g1 = (f32x4){bflo(gw.z), bfhi(gw.z), bflo(gw.w), bfhi(gw.w)} * os;
                    const f32x4 v0 = (*(const f32x4*)(part + row * D + c) + g0 * acc[ai][bj][m][0]) * 16.0f, v1 = (*(const f32x4*)(part + row * D + c + 4) + g1 * acc[ai][bj][m][1]) * 16.0f;
                    u32x2 w; w.x = pk_fp8x4(v0[0], v0[1], v0[2], v0[3]); w.y = pk_fp8x4(v1[0], v1[1], v1[2], v1[3]);
                    *(u32x2*)(merged + row * D + c) = w; } }
    }
};
struct EpiF32Res {
    static constexpr bool PERM = false;
    const float* base; float* out; int ldc; float scale; float os;
    __device__ __forceinline__ void operator()(AccRef acc, const Unit& u, int wr, int wc, int fr, int fq) const {
        const int row0 = u.pm * BM + wr * 64 + fr, col0 = u.pn * BM + wc * 32 + 4 * fq;
#pragma unroll
        for (int ai = 0; ai < 2; ++ai)
#pragma unroll
            for (int m = 0; m < 4; ++m) { const size_t off = (size_t)(row0 + ai * HALF + m * 16) * ldc + col0;
#pragma unroll
                for (int bj = 0; bj < 2; ++bj)
#pragma unroll
                    for (int n = 0; n < 2; ++n) { f32x4 v = acc[ai][bj][m][n] * os;
                        if (base) v = v + *(const f32x4*)(base + off + bj * HALF + n * 16) * scale;
                        *(f32x4*)(out + off + bj * HALF + n * 16) = v; } }
    }
};
struct EpiGateUp {
    static constexpr bool PERM = true;
    bf16_t* H; float os;
    __device__ __forceinline__ void operator()(AccRef acc, const Unit& u, int wr, int wc, int fr, int fq) const {
        const int row0 = u.pm * BM + wr * 64 + fr, col0 = u.pn * HALF + wc * 32 + 8 * fq;
#pragma unroll
        for (int ai = 0; ai < 2; ++ai)
#pragma unroll
            for (int m = 0; m < 4; ++m) { bf16_t* rowp = H + (size_t)(row0 + ai * HALF + m * 16) * DE + col0;
                f32x4 o[2];
#pragma unroll
                for (int n = 0; n < 2; ++n) { const f32x4 gt = acc[ai][0][m][n] * os, up = acc[ai][1][m][n] * os;
#pragma unroll
                    for (int j = 0; j < 4; ++j) o[n][j] = gt[j] / (1.0f + __expf(-gt[j])) * up[j]; }
                u32x4 w; w.x = cvt_pk_bf16(o[0][0], o[0][1]); w.y = cvt_pk_bf16(o[0][2], o[0][3]); w.z = cvt_pk_bf16(o[1][0], o[1][1]); w.w = cvt_pk_bf16(o[1][2], o[1][3]);
                *(u32x4*)rowp = w; }
    }
};
struct EpiDown {
    static constexpr bool PERM = true;
    bf16_t* Y; const float* wslot; float* out; int mt_r;
    __device__ __forceinline__ void operator()(AccRef acc, const Unit& u, int wr, int wc, int fr, int fq) const {
        const int col0 = u.pn * BM + wc * 32 + 8 * fq;
        if (u.pm < mt_r) {
            const int row0 = u.pm * BM + wr * 64 + fr;
#pragma unroll
            for (int ai = 0; ai < 2; ++ai)
#pragma unroll
                for (int m = 0; m < 4; ++m) { const size_t row = (size_t)(row0 + ai * HALF + m * 16); const float w8 = wslot[row] * 64.0f; unsigned char* rowp = (unsigned char*)Y + row * D + col0;
#pragma unroll
                    for (int bj = 0; bj < 2; ++bj) { const f32x4 v0 = acc[ai][bj][m][0] * w8, v1 = acc[ai][bj][m][1] * w8;
                        u32x2 w; w.x = pk_fp8x4(v0[0], v0[1], v0[2], v0[3]); w.y = pk_fp8x4(v1[0], v1[1], v1[2], v1[3]);
                        *(u32x2*)(rowp + bj * HALF) = w; } }
        } else {
            const int row0 = (u.pm - mt_r) * BM + wr * 64 + fr;
#pragma unroll
            for (int ai = 0; ai < 2; ++ai)
#pragma unroll
                for (int m = 0; m < 4; ++m) { float* rowp = out + (size_t)(row0 + ai * HALF + m * 16) * D + col0;
#pragma unroll
                    for (int bj = 0; bj < 2; ++bj)
#pragma unroll
                        for (int n = 0; n < 2; ++n) { float* p = rowp + bj * HALF + 4 * n; *(f32x4*)p = *(const f32x4*)p * ALPHA + acc[ai][bj][m][n]; } }
        }
    }
};
}

#define XB_TMO      128
#define XB_XCNT(j)  (256  + 64 * (j))
#define XB_XSUB(j)  (1280 + 64 * (j))
#define XB_XGEN(j)  (2304 + 64 * (j))
#define XB_TOP      3328
#define XB_TOPGEN   3392
#define XCD_BAR_WORDS 3456
#define XB_SPIN_CAP (1u << 18)
__device__ __forceinline__ unsigned xb_ld(unsigned* p)              { return __hip_atomic_load(p, __ATOMIC_RELAXED, __HIP_MEMORY_SCOPE_AGENT); }
__device__ __forceinline__ unsigned xb_add(unsigned* p, unsigned v) { return __hip_atomic_fetch_add(p, v, __ATOMIC_RELAXED, __HIP_MEMORY_SCOPE_AGENT); }
__device__ __forceinline__ unsigned xb_xcc_id() { return (unsigned)__builtin_amdgcn_s_getreg((3 << 11) | 20) & 0xFu; }
#define XB_SPIN(cond, bar) do { unsigned _sp = 0; while (cond) { __builtin_amdgcn_s_sleep(1); \
    if ((++_sp & 255u) == 0u) { if (xb_ld(&(bar)[XB_TMO])) break; if (_sp > XB_SPIN_CAP) { atomicAdd(&(bar)[XB_TMO], 1u); break; } } } } while (0)
struct XcdBarrier { unsigned* bar; unsigned x; volatile LAS unsigned* st; };
__device__ __forceinline__ XcdBarrier xcd_barrier_post(unsigned* bar, volatile LAS unsigned* st, bool t0) {
    XcdBarrier b; b.bar = bar; b.x = xb_xcc_id(); b.st = st;
    if (t0) (void)xb_add(&bar[XB_XCNT(b.x)], 1u);
    return b;
}
__device__ __forceinline__ void xcd_barrier_complete(unsigned* bar, unsigned x, unsigned& nloc, unsigned& nx) {
    const unsigned G = gridDim.x * gridDim.y * gridDim.z;
    unsigned sum, cnt, mine, sp = 0u;
    for (;;) {
        sum = 0u; cnt = 0u; mine = 0u;
#pragma unroll
        for (unsigned j = 0; j < 16; ++j) { const unsigned c = xb_ld(&bar[XB_XCNT(j)]); sum += c; cnt += (c > 0u) ? 1u : 0u; mine = (j == x) ? c : mine; }
        if (sum == G) break;
        __builtin_amdgcn_s_sleep(1);
        if ((++sp & 255u) == 0u) { if (xb_ld(&bar[XB_TMO])) break; if (sp > XB_SPIN_CAP) { atomicAdd(&bar[XB_TMO], 1u); break; } }
    }
    nloc = mine > 0u ? mine : 1u; nx = cnt > 0u ? cnt : 1u;
}
__device__ __forceinline__ void xcd_barrier(const XcdBarrier& b, bool t0) {
    asm volatile("s_waitcnt vmcnt(0)" ::: "memory");
    __syncthreads();
    if (t0) {
        unsigned* bar = b.bar;
        __builtin_amdgcn_s_waitcnt(0);
        unsigned nloc = b.st[0], nx = b.st[1];
        if (nloc == 0u) { xcd_barrier_complete(bar, b.x, nloc, nx); b.st[0] = nloc; b.st[1] = nx; }
        const unsigned old = xb_add(&bar[XB_XSUB(b.x)], 1u);
        const unsigned gen = old / nloc;
        if (old + 1u == (gen + 1u) * nloc) {
            __builtin_amdgcn_fence(__ATOMIC_RELEASE, "agent");
            asm volatile("s_waitcnt vmcnt(0)" ::: "memory");
            const unsigned og = xb_add(&bar[XB_TOP], 1u);
            const unsigned tg = og / nx;
            if (og + 1u == (tg + 1u) * nx) xb_add(&bar[XB_TOPGEN], 1u);
            else XB_SPIN(xb_ld(&bar[XB_TOPGEN]) == tg, bar);
            __builtin_amdgcn_fence(__ATOMIC_ACQUIRE, "agent");
            xb_add(&bar[XB_XGEN(b.x)], 1u);
            asm volatile("s_waitcnt vmcnt(0)" ::: "memory");
        } else {
            XB_SPIN(xb_ld(&bar[XB_XGEN(b.x)]) == gen, bar);
            __builtin_amdgcn_fence(__ATOMIC_ACQUIRE, "agent");
            asm volatile("s_waitcnt vmcnt(0)" ::: "memory");
        }
    }
    __syncthreads();
}

struct Params { const float* in[26]; float* out; unsigned char* ws; int lo, hi; unsigned char bucket[3][136]; };
static_assert(sizeof(Params) == 26 * 8 + 8 + 8 + 8 + 408, "Params has no padding holes");

__device__ __forceinline__ void tr128(const float* src, int ld_src, bf16* dst, int ld_dst, LAS float* tile, int tid) {
    f32x4 v[8];
#pragma unroll
    for (int it = 0; it < 8; ++it) { const int id = it * 512 + tid, k = id >> 5, c4 = id & 31; v[it] = *(const f32x4*)(src + (size_t)k * ld_src + c4 * 4); }
#pragma unroll
    for (int it = 0; it < 8; ++it) { const int id = it * 512 + tid, k = id >> 5, c4 = id & 31; LAS float* p = tile + k * 129 + c4 * 4; p[0] = v[it][0]; p[1] = v[it][1]; p[2] = v[it][2]; p[3] = v[it][3]; }
    __syncthreads();
#pragma unroll
    for (int it = 0; it < 4; ++it) { const int id = it * 512 + tid, n = id >> 4, kc = id & 15; const LAS float* s = tile + (kc * 8) * 129 + n;
        u32x4 o; o.x = pk2(s[0], s[129]); o.y = pk2(s[2 * 129], s[3 * 129]); o.z = pk2(s[4 * 129], s[5 * 129]); o.w = pk2(s[6 * 129], s[7 * 129]);
        *(u32x4*)(dst + (size_t)n * ld_dst + kc * 8) = o; }
    __syncthreads();
}
__device__ __forceinline__ void tr_matrix_item(const float* W, int K, int N, bf16* WT, int item, LAS float* tile, int tid) {
    const int nbn = N / 128, kb = item / nbn, nb = item % nbn;
    tr128(W + (size_t)kb * 128 * N + nb * 128, N, WT + (size_t)nb * 128 * K + kb * 128, K, tile, tid);
}

__device__ __forceinline__ void tr128_fp8(const float* src, int ld_src, unsigned char* dst, int ld_dst, float scale, LAS float* tile, int tid) {
    f32x4 v[8];
#pragma unroll
    for (int it = 0; it < 8; ++it) { const int id = it * 512 + tid, k = id >> 5, c4 = id & 31; v[it] = *(const f32x4*)(src + (size_t)k * ld_src + c4 * 4); }
#pragma unroll
    for (int it = 0; it < 8; ++it) { const int id = it * 512 + tid, k = id >> 5, c4 = id & 31; LAS float* p = tile + k * 129 + c4 * 4; p[0] = v[it][0]; p[1] = v[it][1]; p[2] = v[it][2]; p[3] = v[it][3]; }
    __syncthreads();
#pragma unroll
    for (int it = 0; it < 2; ++it) { const int id = it * 512 + tid, n = id >> 3, kc = id & 7; const LAS float* s = tile + (kc * 16) * 129 + n;
        u32x4 o;
#pragma unroll
        for (int w = 0; w < 4; ++w) o[w] = pk_fp8x4(s[(4 * w) * 129] * scale, s[(4 * w + 1) * 129] * scale, s[(4 * w + 2) * 129] * scale, s[(4 * w + 3) * 129] * scale);
        *(u32x4*)(dst + (size_t)n * ld_dst + kc * 16) = o; }
    __syncthreads();
}
__device__ __forceinline__ void tr_matrix_item_fp8(const float* W, int K, int N, unsigned char* WT, float scale, int item, LAS float* tile, int tid) {
    const int nbn = N / 128, kb = item / nbn, nb = item % nbn;
    tr128_fp8(W + (size_t)kb * 128 * N + nb * 128, N, WT + (size_t)nb * 128 * K + kb * 128, K, scale, tile, tid);
}

struct RgW { bf16x8 f[2][2][4]; };
__device__ __forceinline__ void rglru_load_w(const Params& p, int h, int lane, RgW& W) {
    const int r = lane & 31, hf = lane >> 5; const unsigned loff = (unsigned)(8 * hf * 64 + r);
#pragma unroll
    for (int gt = 0; gt < 2; ++gt) { const float* w = p.in[gt ? 7 : 5] + (size_t)h * 4096;
#pragma unroll
        for (int nn = 0; nn < 2; ++nn)
#pragma unroll
            for (int s = 0; s < 4; ++s) { float v[8];
#pragma unroll
                for (int j = 0; j < 8; ++j) v[j] = (w + (16 * s + j) * 64 + 32 * nn)[loff];
                u32x4 pk; pk.x = pk2(v[0], v[1]); pk.y = pk2(v[2], v[3]); pk.z = pk2(v[4], v[5]); pk.w = pk2(v[6], v[7]);
                W.f[gt][nn][s] = __builtin_bit_cast(bf16x8, pk); } }
}
template <int PASS>
__device__ __forceinline__ void rglru_item(const Params& p, int item, const RgW& W, LAS unsigned char* xcl, int lane) {
    const bf16* proj = (const bf16*)(p.ws + WS_PROJ);
    float* sumA = (float*)(p.ws + WS_SUMA); float* sumH = (float*)(p.ws + WS_SUMH);
    const int c = item % NCH, h = (item / NCH) % 16, b = item / (NCH * 16);
    const int r = lane & 31, hf = lane >> 5;
    const int chn = h * 64 + lane;
    const float cw0 = p.in[3][chn], cw1 = p.in[3][1024 + chn], cw2 = p.in[3][2048 + chn], cw3 = p.in[3][3072 + chn], cb = p.in[4][chn];
    float ba[2], bi[2], sp8[2], C[2], PT[2];
#pragma unroll
    for (int nn = 0; nn < 2; ++nn) { const int ch = h * 64 + 32 * nn + r; ba[nn] = p.in[6][ch]; bi[nn] = p.in[8][ch]; sp8[nn] = 8.0f * log1pf(expf(-p.in[9][ch])); C[nn] = 0.f; PT[nn] = 1.f; }
    if (PASS == 2) {
        for (int k = 0; k < c; ++k)
#pragma unroll
            for (int nn = 0; nn < 2; ++nn) { const size_t o = (size_t)(b * NCH + k) * D + h * 64 + 32 * nn + r; C[nn] = sumA[o] * C[nn] + sumH[o]; }
    }
    const int t0 = c * TCH;
    const bf16* xrb = proj + (size_t)(b * SEQ) * DIN + C_XR + h * 64;
    const bf16* grb = proj + (size_t)(b * SEQ) * DIN + C_GR + h * 64;
    LAS unsigned char* XR = xcl + 4608; LAS unsigned char* GR = xcl + 9216; LAS unsigned char* Y8 = XR;
    float xm3 = 0.f, xm2 = 0.f, xm1 = 0.f;
    if (t0 > 0) { xm3 = bf1((xrb + (size_t)(t0 - 3) * DIN)[lane]); xm2 = bf1((xrb + (size_t)(t0 - 2) * DIN)[lane]); xm1 = bf1((xrb + (size_t)(t0 - 1) * DIN)[lane]); }
    const unsigned lrow = (unsigned)(lane >> 3), lch = (unsigned)(lane & 7);
    u32x4 xrq[4], grq[4];
#pragma unroll
    for (int it = 0; it < 4; ++it) { xrq[it] = *(const u32x4*)(xrb + (size_t)(t0 + 8 * it) * DIN + lrow * DIN + lch * 8);
        if (PASS == 2) grq[it] = *(const u32x4*)(grb + (size_t)(t0 + 8 * it) * DIN + lrow * DIN + lch * 8); }
    for (int tile = 0; tile < TCH / 32; ++tile) {
        const int tt0 = t0 + tile * 32;
#pragma unroll
        for (int it = 0; it < 4; ++it) { *(LAS u32x4*)(XR + (8 * it + lrow) * 144 + lch * 16) = xrq[it]; if (PASS == 2) *(LAS u32x4*)(GR + (8 * it + lrow) * 144 + lch * 16) = grq[it]; }
        if (tile + 1 < TCH / 32) {
#pragma unroll
            for (int it = 0; it < 4; ++it) { xrq[it] = *(const u32x4*)(xrb + (size_t)(tt0 + 32 + 8 * it) * DIN + lrow * DIN + lch * 8);
                if (PASS == 2) grq[it] = *(const u32x4*)(grb + (size_t)(tt0 + 32 + 8 * it) * DIN + lrow * DIN + lch * 8); }
        }
        asm volatile("s_waitcnt lgkmcnt(0)" ::: "memory");
#pragma unroll
        for (int j = 0; j < 32; ++j) { const float x = bf1(*(const LAS bf16*)(XR + j * 144 + lane * 2)); const float xc = cb + cw0 * xm3 + cw1 * xm2 + cw2 * xm1 + cw3 * x; xm3 = xm2; xm2 = xm1; xm1 = x;
            *(LAS bf16*)(xcl + j * 144 + lane * 2) = (bf16)f2bf(xc); }
        asm volatile("s_waitcnt lgkmcnt(0)" ::: "memory");
        bf16x8 af[4];
#pragma unroll
        for (int s = 0; s < 4; ++s) af[s] = *(const LAS bf16x8*)(xcl + r * 144 + (16 * s + 8 * hf) * 2);
#pragma unroll
        for (int nn = 0; nn < 2; ++nn) {
            f32x16 ra, ri, xq;
#pragma unroll
            for (int i = 0; i < 16; ++i) { ra[i] = 0.f; ri[i] = 0.f; xq[i] = 0.f; }
#pragma unroll
            for (int s = 0; s < 4; ++s) { ra = __builtin_amdgcn_mfma_f32_32x32x16_bf16(af[s], W.f[0][nn][s], ra, 0, 0, 0); ri = __builtin_amdgcn_mfma_f32_32x32x16_bf16(af[s], W.f[1][nn][s], ri, 0, 0, 0); }
#pragma unroll
            for (int s2 = 0; s2 < 2; ++s2) { const int s = 2 * nn + s2; bf16x8 idf;
#pragma unroll
                for (int j = 0; j < 8; ++j) idf[j] = (16 * s + 8 * hf + j == 32 * nn + r) ? (short)0x3F80 : (short)0;
                xq = __builtin_amdgcn_mfma_f32_32x32x16_bf16(af[s], idf, xq, 0, 0, 0); }
            float av[16], uv[16];
#pragma unroll
            for (int i = 0; i < 16; ++i) {
                const float rg = 1.0f / (1.0f + __expf(-(ra[i] + ba[nn]))), ig = 1.0f / (1.0f + __expf(-(ri[i] + bi[nn])));
                const float la = -sp8[nn] * rg, a = __expf(la), x2 = 2.0f * la;
                const float om = (x2 > -0.06f) ? -x2 * (1.0f + x2 * (0.5f + x2 * (0.16666667f + x2 * 0.041666668f))) : 1.0f - __expf(x2);
                av[i] = a; uv[i] = sqrtf(om) * (ig * xq[i]); }
            float hl[16], pl[16];
#pragma unroll
            for (int q = 0; q < 4; ++q) { hl[4 * q] = uv[4 * q]; pl[4 * q] = av[4 * q];
#pragma unroll
                for (int j = 1; j < 4; ++j) { hl[4 * q + j] = av[4 * q + j] * hl[4 * q + j - 1] + uv[4 * q + j]; pl[4 * q + j] = pl[4 * q + j - 1] * av[4 * q + j]; } }
            float cin[4]; float Cc = C[nn];
#pragma unroll
            for (int s8 = 0; s8 < 8; ++s8) { const int q = s8 >> 1;
                const float cn = pl[4 * q + 3] * Cc + hl[4 * q + 3];
                if ((s8 & 1) == 0) { if (hf == 0) cin[q] = Cc; } else { if (hf == 1) cin[q] = Cc; }
                const unsigned cu = __builtin_bit_cast(unsigned, cn);
                auto sw = __builtin_amdgcn_permlane32_swap(cu, cu, false, false);
                Cc = __builtin_bit_cast(float, (s8 & 1) ? sw[1] : sw[0]); }
            C[nn] = Cc;
            if (PASS == 1) { float pp = pl[3] * pl[7] * pl[11] * pl[15]; const unsigned pu = __builtin_bit_cast(unsigned, pp);
                auto sw = __builtin_amdgcn_permlane32_swap(pu, pu, false, false); PT[nn] *= __builtin_bit_cast(float, sw[0]) * __builtin_bit_cast(float, sw[1]); }
            if (PASS == 2) {
#pragma unroll
                for (int i = 0; i < 16; ++i) { const int tok = (i & 3) + 8 * (i >> 2) + 4 * hf; const float hv = hl[i] + pl[i] * cin[i >> 2];
                    const float gg = bf1(*(const LAS bf16*)(GR + tok * 144 + (32 * nn + r) * 2));
                    const float yv = __builtin_amdgcn_fmed3f(hv * gg * 16.0f, -448.f, 448.f);
                    *(LAS unsigned char*)(Y8 + tok * 80 + 32 * nn + r) = (unsigned char)__builtin_amdgcn_cvt_pk_fp8_f32(yv, 0.f, 0, false); }
            }
        }
        if (PASS == 2) {
            asm volatile("s_waitcnt lgkmcnt(0)" ::: "memory");
            unsigned char* yb = p.ws + WS_YRNN + (size_t)(b * SEQ + tt0) * D + h * 64;
#pragma unroll
            for (int it = 0; it < 2; ++it) { const int row = (lane >> 2) + 16 * it; *(u32x4*)(yb + (size_t)row * D + (lane & 3) * 16) = *(const LAS u32x4*)(Y8 + row * 80 + (lane & 3) * 16); }
        }
        asm volatile("s_waitcnt lgkmcnt(0)" ::: "memory");
    }
    if (PASS == 1 && hf == 0) {
#pragma unroll
        for (int nn = 0; nn < 2; ++nn) { const size_t o = (size_t)(b * NCH + c) * D + h * 64 + 32 * nn + r; sumA[o] = PT[nn]; sumH[o] = C[nn]; }
    }
}

__device__ __forceinline__ void attn_item(const Params& p, int item, LAS unsigned char* vt, const LAS float* btab_all, int lane) {
    const bf16* proj = (const bf16*)(p.ws + WS_PROJ);
    const int rq = item & 127, bh = item >> 7, head = bh % 24, b = bh / 24;
    const int g = head >> 3, hh = head & 7, dil = (g == 0) ? 1 : (g == 1 ? 4 : 16), nqb = 128 / dil;
    const int res = rq / nqb, qb = rq % nqb, l0 = qb * 32;
    const int r = lane & 31, hf = lane >> 5;
    const LAS float* btab = btab_all + (g * 8 + hh) * 132;
    const size_t tokbase = (size_t)b * SEQ;
    bf16x8 qf[4];
    { const bf16* qp = proj + (tokbase + (size_t)(l0 + r) * dil + res) * DIN + C_Q + head * 64 + 8 * hf;
#pragma unroll
      for (int s = 0; s < 4; ++s) qf[s] = *(const bf16x8*)(qp + 16 * s); }
    f32x16 o0, o1;
#pragma unroll
    for (int i = 0; i < 16; ++i) { o0[i] = 0.f; o1[i] = 0.f; }
    float mrun = -1e30f, lrun = 0.f;
    const bf16* kvb = proj + (tokbase + res) * DIN + head * 64;
    const unsigned lk = (unsigned)(r * dil * DIN + C_K + 8 * hf);
    const unsigned lv0 = (unsigned)((2 * (lane >> 3)) * dil * DIN + C_V + 8 * (lane & 7));
    const int kt_first = (l0 >= 128) ? 0 : (128 - l0) / 32;
    bf16x8 kf[4], kfn[4]; u32x4 va[2][2], van[2][2];
    { const bf16* tb = kvb + (size_t)(l0 - 128 + 32 * kt_first) * dil * DIN;
#pragma unroll
      for (int s = 0; s < 4; ++s) kfn[s] = *(const bf16x8*)(tb + lk + 16 * s);
#pragma unroll
      for (int it = 0; it < 2; ++it)
#pragma unroll
          for (int e = 0; e < 2; ++e) van[it][e] = *(const u32x4*)(tb + (size_t)(16 * it + e) * dil * DIN + lv0); }
    for (int kt = kt_first; kt < 5; ++kt) {
        const int k0 = l0 - 128 + 32 * kt;
#pragma unroll
        for (int s = 0; s < 4; ++s) { kf[s] = kfn[s]; asm volatile("" : "+v"(kf[s])); }
#pragma unroll
        for (int it = 0; it < 2; ++it)
#pragma unroll
            for (int e = 0; e < 2; ++e) { va[it][e] = van[it][e]; asm volatile("" : "+v"(va[it][e])); }
        if (kt < 4) { const bf16* tb = kvb + (size_t)(k0 + 32) * dil * DIN;
#pragma unroll
            for (int s = 0; s < 4; ++s) kfn[s] = *(const bf16x8*)(tb + lk + 16 * s);
#pragma unroll
            for (int it = 0; it < 2; ++it)
#pragma unroll
                for (int e = 0; e < 2; ++e) van[it][e] = *(const u32x4*)(tb + (size_t)(16 * it + e) * dil * DIN + lv0); }
        f32x16 st;
#pragma unroll
        for (int i = 0; i < 16; ++i) st[i] = 0.f;
#pragma unroll
        for (int s = 0; s < 4; ++s) st = __builtin_amdgcn_mfma_f32_32x32x16_bf16(kf[s], qf[s], st, 0, 0, 0);
#pragma unroll
        for (int it = 0; it < 2; ++it) { const int kp2 = (lane >> 3) + 8 * it, dc = lane & 7;
#pragma unroll
            for (int w = 0; w < 4; ++w) { const unsigned a0 = va[it][0][w], a1 = va[it][1][w];
                *(LAS unsigned*)(vt + (8 * dc + 2 * w) * 72 + 4 * kp2) = (a0 & 0xffffu) | (a1 << 16);
                *(LAS unsigned*)(vt + (8 * dc + 2 * w + 1) * 72 + 4 * kp2) = (a0 >> 16) | (a1 & 0xffff0000u); } }
        float sv[16]; float mt = -1e30f;
        const int relb = (l0 + r) - k0 - 4 * hf;
        float bsv[16];
#pragma unroll
        for (int i = 0; i < 16; ++i) bsv[i] = btab[relb - ((i & 3) + 8 * (i >> 2))];
#pragma unroll
        for (int i = 0; i < 16; ++i) { const int rel = relb - ((i & 3) + 8 * (i >> 2));
            const bool ok = (unsigned)rel <= 128u;
            sv[i] = ok ? st[i] + bsv[i] : -1e30f; mt = fmaxf(mt, sv[i]); }
        mt = fmaxf(mt, __shfl_xor(mt, 32));
        const float mnew = fmaxf(mrun, mt), al = __expf(mrun - mnew);
        float ps = 0.f; float pv[16];
#pragma unroll
        for (int i = 0; i < 16; ++i) { pv[i] = __expf(sv[i] - mnew); ps += pv[i]; }
        lrun = lrun * al + ps; mrun = mnew;
#pragma unroll
        for (int i = 0; i < 16; ++i) { o0[i] *= al; o1[i] *= al; }
        bf16x8 pf[2];
#pragma unroll
        for (int s = 0; s < 2; ++s) { u32x4 w; w.x = pg8::cvt_pk_bf16(pv[8 * s], pv[8 * s + 1]); w.y = pg8::cvt_pk_bf16(pv[8 * s + 2], pv[8 * s + 3]); w.z = pg8::cvt_pk_bf16(pv[8 * s + 4], pv[8 * s + 5]); w.w = pg8::cvt_pk_bf16(pv[8 * s + 6], pv[8 * s + 7]);
            pf[s] = __builtin_bit_cast(bf16x8, w); }
        asm volatile("s_waitcnt lgkmcnt(0)" ::: "memory");
#pragma unroll
        for (int s = 0; s < 2; ++s) {
            { const LAS unsigned char* q = vt + (r) * 72 + (16 * s + 4 * hf) * 2; u32x4 w; const u32x2 lo = *(const LAS u32x2*)q, hi = *(const LAS u32x2*)(q + 16); w.x = lo.x; w.y = lo.y; w.z = hi.x; w.w = hi.y;
              o0 = __builtin_amdgcn_mfma_f32_32x32x16_bf16(__builtin_bit_cast(bf16x8, w), pf[s], o0, 0, 0, 0); }
            { const LAS unsigned char* q = vt + (32 + r) * 72 + (16 * s + 4 * hf) * 2; u32x4 w; const u32x2 lo = *(const LAS u32x2*)q, hi = *(const LAS u32x2*)(q + 16); w.x = lo.x; w.y = lo.y; w.z = hi.x; w.w = hi.y;
              o1 = __builtin_amdgcn_mfma_f32_32x32x16_bf16(__builtin_bit_cast(bf16x8, w), pf[s], o1, 0, 0, 0); }
        }
        asm volatile("s_waitcnt lgkmcnt(0)" ::: "memory");
    }
    const float ltot = lrun + __shfl_xor(lrun, 32), inv = 1.0f / ltot;
    const size_t tok = tokbase + (size_t)(l0 + r) * dil + res;
    bf16* ao = (bf16*)(p.ws + WS_AO) + ((size_t)g * T + tok) * 512 + hh * 64;
#pragma unroll
    for (int q4 = 0; q4 < 4; ++q4) {
        u32x2 w; w.x = pk2(o0[4 * q4] * inv, o0[4 * q4 + 1] * inv); w.y = pk2(o0[4 * q4 + 2] * inv, o0[4 * q4 + 3] * inv);
        *(u32x2*)(ao + 8 * q4 + 4 * hf) = w;
        u32x2 w1; w1.x = pk2(o1[4 * q4] * inv, o1[4 * q4 + 1] * inv); w1.y = pk2(o1[4 * q4 + 2] * inv, o1[4 * q4 + 3] * inv);
        *(u32x2*)(ao + 32 + 8 * q4 + 4 * hf) = w1;
    }
    if (hf == 0) ((float*)(p.ws + WS_LSE))[((size_t)g * T + tok) * 8 + hh] = mrun + __logf(ltot);
}

__device__ __forceinline__ void build_tile_table(const LAS unsigned* lcnt, LAS unsigned char* lds, int tid) {
    LAS int* tbase = (LAS int*)(lds + L_TBASE); LAS unsigned short* tile_e = (LAS unsigned short*)(lds + L_TILEE);
    __syncthreads();
    if (tid < 64) { int n[4], s = 0;
#pragma unroll
        for (int j = 0; j < 4; ++j) { n[j] = ((int)lcnt[4 * tid + j] + 255) >> 8; s += n[j]; }
        int incl = s;
#pragma unroll
        for (int o = 1; o < 64; o <<= 1) { const int v = __shfl_up(incl, o); if (tid >= o) incl += v; }
        int ex = incl - s;
#pragma unroll
        for (int j = 0; j < 4; ++j) { tbase[4 * tid + j] = ex; ex += n[j]; }
        if (tid == 63) { tbase[NE] = incl; tbase[NE + 1] = incl + SH_TILES; } }
    __syncthreads();
    if (tid < NE) { const int a = tbase[tid], bnd = tbase[tid + 1]; for (int i = a; i < bnd; ++i) tile_e[i] = (unsigned short)tid; }
    if (tid < SH_TILES) tile_e[tbase[NE] + tid] = (unsigned short)NE;
    __syncthreads();
}
__device__ __forceinline__ void build_tile_table_g(const Params& p, LAS unsigned char* lds, int tid) {
    LAS unsigned* lc = (LAS unsigned*)(lds + L_LCNT);
    const unsigned* cnt = (const unsigned*)(p.ws + WS_CTL) + CW_CNT;
    if (tid < NE) lc[tid] = cnt[tid];
    build_tile_table(lc, lds, tid);
}

__global__ void __launch_bounds__(512, 2) fwd_kernel(Params p) {
    extern __shared__ __attribute__((aligned(16))) unsigned char lds_raw[];
    LAS unsigned char* lds = (LAS unsigned char*)lds_raw;
    const int tid = threadIdx.x, lane = tid & 63, wave = __builtin_amdgcn_readfirstlane(tid >> 6);
    const int G = gridDim.x, bid = blockIdx.x;
    const int gw = bid * 8 + wave, NGW = G * 8;
    const size_t gtid = (size_t)bid * 512 + tid, NTH = (size_t)G * 512;
    unsigned char* ws = p.ws;
    volatile LAS unsigned* misc = (volatile LAS unsigned*)(lds + L_MISC);
    if (tid < 16) misc[tid] = 0u;
    { LAS float* bt = (LAS float*)(lds + L_BTAB);
      for (int i = tid; i < 3 * 8 * 132; i += 512) { const int g = i / (8 * 132), hh = (i / 132) % 8, rel = i % 132; bt[i] = (rel <= 128) ? p.in[12][(int)p.bucket[g][rel] * 24 + g * 8 + hh] : 0.f; } }
    __syncthreads();
#if N_LAUNCHES == 1
    XcdBarrier bar = xcd_barrier_post((unsigned*)(ws + WS_CTL) + CW_BAR, misc, tid == 0);
#define GRID_BAR() xcd_barrier(bar, wave == 0 && lane_id() == 0)
#else
#define GRID_BAR() do { } while (0)
#endif
    const int lo = p.lo, hi = p.hi;
#define IN(k) (lo <= (k) && (k) < hi)
#define SEAM(k) do { if (IN(k) && IN((k) + 1)) GRID_BAR(); STAMP((k) + 1); } while (0)
#define STAMP(k) do { if (PROBE_PHASE >= 100 && wave == 0 && lane_id() == 0) ((volatile LAS unsigned*)(lds + L_STAMP))[(k)] = (unsigned)__builtin_amdgcn_s_memrealtime(); } while (0)
#ifndef PROBE_PHASE
#define PROBE_PHASE -1
#endif
#define REPS(k) for (int _rep = 0; _rep < ((PROBE_PHASE == (k)) ? 2 : 1); ++_rep)
#define REP_BAR() do { if (_rep) GRID_BAR(); } while (0)
#define PHASE_LOCALS const int lane = lane_id(), tid = wave * 64 + lane; const size_t gtid = (size_t)bid * 512 + tid; (void)lane; (void)gtid;

    STAMP(0);
    if (IN(0)) REPS(0) { REP_BAR(); PHASE_LOCALS
        LAS float* tile = (LAS float*)lds;
        for (int it = bid; it < 720; it += G) {
            int r = it;
            if (r < 544) { tr_matrix_item_fp8(p.in[1], 1024, DIN, ws + WS_WINT, 32.f, r, tile, tid); continue; } r -= 544;
            if (r < 64) { tr_matrix_item_fp8(p.in[10], 1024, 1024, ws + WS_WPRT, 32.f, r, tile, tid); continue; } r -= 64;
            if (r < 32) { tr_matrix_item_fp8(p.in[11], 512, 1024, ws + WS_WPAT, 32.f, r, tile, tid); continue; } r -= 32;
            if (r < 64) { tr_matrix_item_fp8(p.in[13], 1024, 1024, ws + WS_WOT, 32.f, r, tile, tid); continue; } r -= 64;
            tr_matrix_item(p.in[16], 1024, 256, (bf16*)(ws + WS_WRT), r, tile, tid);
        }
        const f32x4* x4 = (const f32x4*)p.in[0]; u32x4* xb = (u32x4*)(ws + WS_XB);
        for (size_t i = gtid; i < (size_t)T * D / 16; i += NTH) { const f32x4 a = x4[4 * i], b = x4[4 * i + 1], c = x4[4 * i + 2], d = x4[4 * i + 3];
            u32x4 o; o.x = pk_fp8x4(a[0], a[1], a[2], a[3]); o.y = pk_fp8x4(b[0], b[1], b[2], b[3]); o.z = pk_fp8x4(c[0], c[1], c[2], c[3]); o.w = pk_fp8x4(d[0], d[1], d[2], d[3]); xb[i] = o; }
    }
    SEAM(0);
    if (IN(1)) REPS(1) { REP_BAR(); PHASE_LOCALS
        pg8::Gemm g{(const bf16*)(ws + WS_XB), (const bf16*)(ws + WS_WINT), 512, 0x7A7A7A7A, 0x7F7F7F7F}; pg8::StaticOrder S; S.init(T, DIN, G, bid);
        pg8::EpiInProj E{(bf16*)(ws + WS_PROJ), p.in[2], 1.0f / 32.0f};
        pg8::gemm_phase<pg8::EpiInProj, pg8::StaticOrder, true, true>(lds, g, S, E, wave);
    }
    SEAM(1);
    if (IN(2)) REPS(2) { REP_BAR(); PHASE_LOCALS
        LAS unsigned char* vt = lds + wave * 14336;
        for (int rr = 0; rr < (PROBE_PHASE == 20 ? 2 : 1); ++rr)
        { RgW W; int hprev = -1;
          for (int it = gw; it < NB * 16 * NCH; it += NGW) { const int h = (it / NCH) % 16; if (h != hprev) { rglru_load_w(p, h, lane, W); hprev = h; } rglru_item<1>(p, it, W, vt, lane); } }
        const LAS float* bt = (const LAS float*)(lds + L_BTAB);
        for (int rr = 0; rr < (PROBE_PHASE == 21 ? 2 : 1); ++rr)
        for (int it = gw; it < NB * 24 * 128; it += NGW) attn_item(p, it, vt, bt, lane);
    }
    SEAM(2);
    if (IN(3)) REPS(3) { REP_BAR(); PHASE_LOCALS
        for (int rr = 0; rr < (PROBE_PHASE == 30 ? 2 : 1); ++rr)
        { RgW W; int hprev = -1; LAS unsigned char* xcl = lds + wave * 14336;
          for (int it = gw; it < NB * 16 * NCH; it += NGW) { const int h = (it / NCH) % 16; if (h != hprev) { rglru_load_w(p, h, lane, W); hprev = h; } rglru_item<2>(p, it, W, xcl, lane); } }
        const bf16* ao = (const bf16*)(ws + WS_AO); const float* lse = (const float*)(ws + WS_LSE); bf16* yatt = (bf16*)(ws + WS_YATT);
        for (int rr = 0; rr < (PROBE_PHASE == 31 ? 2 : 1); ++rr)
        for (size_t i = gtid; i < (size_t)T * 64; i += NTH) { const size_t t = i >> 6; const int c8 = (int)(i & 63), hh = c8 >> 3;
            const float l0 = lse[t * 8 + hh], l1 = lse[((size_t)T + t) * 8 + hh], l2 = lse[((size_t)2 * T + t) * 8 + hh];
            const float mx = fmaxf(l0, fmaxf(l1, l2)); float w0 = __expf(l0 - mx), w1 = __expf(l1 - mx), w2 = __expf(l2 - mx); const float inv = 1.0f / (w0 + w1 + w2); w0 *= inv; w1 *= inv; w2 *= inv;
            const u32x4 a = *(const u32x4*)(ao + t * 512 + c8 * 8), bq = *(const u32x4*)(ao + ((size_t)T + t) * 512 + c8 * 8), cq = *(const u32x4*)(ao + ((size_t)2 * T + t) * 512 + c8 * 8);
            float yv[8];
#pragma unroll
            for (int w = 0; w < 4; ++w) { yv[2 * w] = 16.0f * (w0 * bflo(a[w]) + w1 * bflo(bq[w]) + w2 * bflo(cq[w])); yv[2 * w + 1] = 16.0f * (w0 * bfhi(a[w]) + w1 * bfhi(bq[w]) + w2 * bfhi(cq[w])); }
            u32x2 o; o.x = pk_fp8x4(yv[0], yv[1], yv[2], yv[3]); o.y = pk_fp8x4(yv[4], yv[5], yv[6], yv[7]);
            *(u32x2*)((unsigned char*)yatt + t * 512 + c8 * 8) = o; }
    }
    SEAM(3);
    if (IN(4)) REPS(4) { REP_BAR(); PHASE_LOCALS
        pg8::StaticOrder S; S.init(T, D, G, bid);
        { pg8::Gemm g{(const bf16*)(ws + WS_YRNN), (const bf16*)(ws + WS_WPRT), 512, 0, 0};
          pg8::EpiProjRnn E{(const bf16*)(ws + WS_PROJ), p.out, 1.0f / 512.0f};
          pg8::gemm_phase<pg8::EpiProjRnn, pg8::StaticOrder, true, true>(lds, g, S, E, wave); }
        asm volatile("s_waitcnt vmcnt(0)" ::: "memory"); __syncthreads();
        { pg8::Gemm g{(const bf16*)(ws + WS_YATT), (const bf16*)(ws + WS_WPAT), 256, 0, 0};
          pg8::EpiProjAtt E{(const bf16*)(ws + WS_PROJ), p.out, ws + WS_MERGED, 1.0f / 512.0f};
          pg8::gemm_phase<pg8::EpiProjAtt, pg8::StaticOrder, true, true>(lds, g, S, E, wave); }
    }
    SEAM(4);
    if (IN(5)) REPS(5) { REP_BAR(); PHASE_LOCALS
        pg8::Gemm g{(const bf16*)(ws + WS_MERGED), (const bf16*)(ws + WS_WOT), 512, 0, 0}; pg8::StaticOrder S; S.init(T, D, G, bid);
        pg8::EpiF32Res E{p.in[0], (float*)(ws + WS_PRELN), D, ALPHA, 1.0f / 512.0f};
        pg8::gemm_phase<pg8::EpiF32Res, pg8::StaticOrder, true, true>(lds, g, S, E, wave);
    }
    SEAM(5);
    if (IN(6)) REPS(6) { REP_BAR(); PHASE_LOCALS
        const float* preln = (const float*)(ws + WS_PRELN); bf16* x1b = (bf16*)(ws + WS_X1B);
        for (int row = gw; row < T; row += NGW) {
            const f32x4* xr = (const f32x4*)(preln + (size_t)row * D) + lane; f32x4 v[4]; float s = 0.f;
#pragma unroll
            for (int j = 0; j < 4; ++j) { v[j] = xr[64 * j]; s += (v[j][0] + v[j][1]) + (v[j][2] + v[j][3]); }
            const float mean = wave_sum(s) * (1.f / D); float s2 = 0.f;
#pragma unroll
            for (int j = 0; j < 4; ++j) { v[j] = v[j] - mean; s2 += (v[j][0] * v[j][0] + v[j][1] * v[j][1]) + (v[j][2] * v[j][2] + v[j][3] * v[j][3]); }
            const float rstd = 1.f / sqrtf(wave_sum(s2) * (1.f / D) + LN_EPS);
#pragma unroll
            for (int j = 0; j < 4; ++j) { const f32x4 gm = ((const f32x4*)p.in[14])[lane + 64 * j], bt = ((const f32x4*)p.in[15])[lane + 64 * j];
                const f32x4 o = v[j] * rstd * gm + bt;
                ((f32x4*)(p.out + (size_t)row * D))[lane + 64 * j] = o;
                u32x2 w; w.x = pk2(o[0], o[1]); w.y = pk2(o[2], o[3]); ((u32x2*)(x1b + (size_t)row * D))[lane + 64 * j] = w;
                ((unsigned*)(ws + WS_X1B8 + (size_t)row * D))[lane + 64 * j] = pk_fp8x4(o[0], o[1], o[2], o[3]); }
        }
        __syncthreads();
        LAS float* tile = (LAS float*)lds;
        for (int it = bid; it < 257 * 48; it += G) {
            const int e = it / 48, r = it % 48;
            if (r < 32) { const int up = r >> 4, q = r & 15, kb = q >> 1, nbk = q & 1;
                const float* W = (e < NE) ? p.in[up ? 19 : 18] + (size_t)e * 1024 * 256 : p.in[up ? 22 : 21];
                tr128_fp8(W + (size_t)kb * 128 * 256 + nbk * 128, 256, ws + WS_WGU + ((size_t)e * 512 + nbk * 256 + up * 128) * 1024 + kb * 128, 1024, 32.f, tile, tid);
            } else { const int q = r - 32, kb = q >> 3, nb = q & 7;
                const float* W = (e < NE) ? p.in[20] + (size_t)e * 256 * 1024 : p.in[23];
                tr128(W + (size_t)kb * 128 * 1024 + nb * 128, 1024, (bf16*)(ws + WS_WD) + ((size_t)e * 1024 + nb * 128) * 256 + kb * 128, 256, tile, tid); }
        }
    }
    SEAM(6);
    if (IN(7)) REPS(7) { REP_BAR(); PHASE_LOCALS
        pg8::Gemm g{(const bf16*)(ws + WS_X1B), (const bf16*)(ws + WS_WRT), 1024, 0x7F7F7F7F, 0x7F7F7F7F}; pg8::StaticOrder S; S.init(T, NE, G, bid);
        pg8::EpiF32Res E{nullptr, (float*)(ws + WS_LOGITS), NE, 0.f, 1.0f};
        pg8::gemm_phase<pg8::EpiF32Res, pg8::StaticOrder, true>(lds, g, S, E, wave);
      { pg8::Unit ru; const bool has_unit = S.next(0, ru); const int tok0 = has_unit ? ru.pm * 256 : 0;
        const float* logits = (const float*)(ws + WS_LOGITS); LAS unsigned* lcnt = (LAS unsigned*)(lds + L_LCNT);
        __syncthreads(); if (tid < NE) lcnt[tid] = 0u; __syncthreads();
        int* eidx = (int*)(ws + WS_EIDX); float* gatew = (float*)(ws + WS_GATEW); int* rank = (int*)(ws + WS_RANK);
        const int g = lane & 7, tk = lane >> 3;
        float rb[32];
#pragma unroll
        for (int q = 0; q < 8; ++q) { const f32x4 r4 = ((const f32x4*)p.in[17])[g * 8 + q]; rb[4 * q] = r4[0]; rb[4 * q + 1] = r4[1]; rb[4 * q + 2] = r4[2]; rb[4 * q + 3] = r4[3]; }
        for (int task = wave; task < (has_unit ? 32 : 0); task += 8) {
            const int t = tok0 + task * 8 + tk;
            const f32x4* z4 = (const f32x4*)(logits + (size_t)t * NE + g * 32);
            f32x4 zz[8];
#pragma unroll
            for (int q = 0; q < 8; ++q) zz[q] = z4[q];
            float sc[32], sel[32];
#pragma unroll
            for (int j = 0; j < 32; ++j) { sc[j] = 1.0f / (1.0f + __expf(-zz[j >> 2][j & 3])); sel[j] = sc[j] + rb[j]; }
            float m1 = fmaxf(sel[0], sel[1]), m2 = fminf(sel[0], sel[1]);
#pragma unroll
            for (int j = 2; j < 32; ++j) { const float v = sel[j]; m2 = fmaxf(m2, fminf(m1, v)); m1 = fmaxf(m1, v); }
            const float gs = m1 + m2; int rk = 0;
#pragma unroll
            for (int g3 = 0; g3 < 8; ++g3) { const float og = __shfl(gs, (lane & ~7) + g3); rk += (og > gs || (og == gs && g3 < g)) ? 1 : 0; }
            if (rk >= 4) {
#pragma unroll
                for (int j = 0; j < 32; ++j) sel[j] = -INFINITY;
            }
            int me = 0; float ms = 0.f, gsum = 0.f;
#pragma unroll
            for (int k = 0; k < 8; ++k) {
                float bv = sel[0], bs = sc[0]; int bj = 0;
#pragma unroll
                for (int j = 1; j < 32; ++j) { const bool gt = sel[j] > bv; bv = gt ? sel[j] : bv; bs = gt ? sc[j] : bs; bj = gt ? j : bj; }
                int bi = g * 32 + bj;
#pragma unroll
                for (int o = 1; o < 8; o <<= 1) { const float ov = __shfl_xor(bv, o), os = __shfl_xor(bs, o); const int oi = __shfl_xor(bi, o);
                    const bool tk2 = (ov > bv) || (ov == bv && oi < bi); bv = tk2 ? ov : bv; bs = tk2 ? os : bs; bi = tk2 ? oi : bi; }
                const bool own = (bi >> 5) == g; const int jj = bi & 31;
#pragma unroll
                for (int j = 0; j < 32; ++j) sel[j] = (own && j == jj) ? -INFINITY : sel[j];
                gsum += bs; if (g == k) { me = bi; ms = bs; }
            }
            const int rr = (int)__hip_atomic_fetch_add(&lcnt[me], 1u, __ATOMIC_RELAXED, __HIP_MEMORY_SCOPE_WORKGROUP);
            const size_t q = (size_t)t * 8 + g;
            eidx[q] = me; gatew[q] = ms * 2.5f / gsum; rank[q] = rr;
        }
        __syncthreads();
        if (tid < NE) ((unsigned*)(ws + WS_HIST))[(size_t)bid * NE + tid] = lcnt[tid];
      }
    }
    SEAM(7);
    if (IN(9)) REPS(9) { REP_BAR(); PHASE_LOCALS
        LAS unsigned* lcnt = (LAS unsigned*)(lds + L_LCNT); LAS unsigned* bbase = (LAS unsigned*)(lds + L_BBASE);
        __syncthreads();
        { const u32x4* hist4 = (const u32x4*)(ws + WS_HIST); const int e4 = tid & 63, part = tid >> 6; u32x4 tot = (u32x4){0u, 0u, 0u, 0u}, bs = tot;
          const int per = (G + 7) / 8, b0 = part * per, b1 = (b0 + per < G) ? b0 + per : G;
#pragma unroll 8
          for (int b = b0; b < b1; ++b) { const u32x4 v = hist4[(size_t)b * 64 + e4]; tot += v; if (b < bid) bs += v; }
          LAS u32x4* pt = (LAS u32x4*)lds; pt[part * 64 + e4] = tot; pt[512 + part * 64 + e4] = bs; }
        __syncthreads();
        if (tid < NE) { const LAS unsigned* pw = (const LAS unsigned*)lds; unsigned tot = 0u, bs = 0u;
#pragma unroll
            for (int pp = 0; pp < 8; ++pp) { tot += pw[pp * 256 + tid]; bs += pw[2048 + pp * 256 + tid]; }
            lcnt[tid] = tot; bbase[tid] = bs; if (bid == 0) ((unsigned*)(ws + WS_CTL))[CW_CNT + tid] = tot; }
        build_tile_table(lcnt, lds, tid);
        const LAS int* tbase = (const LAS int*)(lds + L_TBASE);
        const int* eidx = (const int*)(ws + WS_EIDX); const float* gatew = (const float*)(ws + WS_GATEW); const int* rank = (const int*)(ws + WS_RANK);
        int* slotof = (int*)(ws + WS_SLOTOF); int* tokslot = (int*)(ws + WS_TOKSLOT); float* wslot = (float*)(ws + WS_WSLOT);
        pg8::StaticOrder RS; RS.init(T, NE, G, bid); pg8::Unit ru; const bool has_unit = RS.next(0, ru);
        for (int task = wave; task < (has_unit ? 32 : 0); task += 8) {
            const int t = ru.pm * 256 + task * 8 + (lane >> 3); const size_t q = (size_t)t * 8 + (lane & 7);
            const int e = eidx[q]; const int slot = tbase[e] * 256 + (int)bbase[e] + rank[q]; tokslot[slot] = t; wslot[slot] = gatew[q]; slotof[q] = slot; }
        for (size_t i = gtid; i < (size_t)NE * 256; i += NTH) { const int e = (int)(i >> 8), j = (int)(i & 255); const int s = (int)lcnt[e] + j; if (s < (tbase[e + 1] - tbase[e]) * 256) { tokslot[tbase[e] * 256 + s] = 0; wslot[tbase[e] * 256 + s] = 0.f; } }
        const int sb = tbase[NE] * 256;
        for (size_t i = gtid; i < (size_t)T; i += NTH) { tokslot[sb + i] = (int)i; }
    }
    SEAM(9);
    if (IN(10)) REPS(10) { REP_BAR(); PHASE_LOCALS
        build_tile_table_g(p, lds, tid);
        const LAS int* tbase = (const LAS int*)(lds + L_TBASE);
        pg8::GroupOrder<true> S; S.nN = 2; S.nwg = tbase[NE + 1] * 2; S.G = G; S.c = bid; S.tile_e = (const LAS unsigned short*)(lds + L_TILEE); S.tok = (const int*)(ws + WS_TOKSLOT); S.rowbytes = 1024u;
        pg8::Gemm g{(const bf16*)(ws + WS_X1B8), (const bf16*)(ws + WS_WGU), 512, 0, 0};
        pg8::EpiGateUp E{(bf16*)(ws + WS_H), 1.0f / 32.0f};
        pg8::gemm_phase<pg8::EpiGateUp, pg8::GroupOrder<true>, true, true>(lds, g, S, E, wave);
    }
    SEAM(10);
    if (IN(11)) REPS(11) { REP_BAR(); PHASE_LOCALS
        build_tile_table_g(p, lds, tid);
        const LAS int* tbase = (const LAS int*)(lds + L_TBASE);
        pg8::GroupOrder<false> S; S.nN = 4; S.nwg = ((PROBE_PHASE == 11 && _rep == 0) ? tbase[NE] : tbase[NE + 1]) * 4; S.G = G; S.c = bid; S.tile_e = (const LAS unsigned short*)(lds + L_TILEE); S.tok = nullptr; S.rowbytes = 0u;
        pg8::Gemm g{(const bf16*)(ws + WS_H), (const bf16*)(ws + WS_WD), 256, 0x7F7F7F7F, 0x7F7F7F7F};
        pg8::EpiDown E{(bf16*)(ws + WS_Y), (const float*)(ws + WS_WSLOT), p.out, tbase[NE]};
        pg8::gemm_phase<pg8::EpiDown, pg8::GroupOrder<false>, true>(lds, g, S, E, wave);
    }
    SEAM(11);
    if (IN(12)) REPS(12) { REP_BAR(); PHASE_LOCALS
        const bf16* Y = (const bf16*)(ws + WS_Y); const int* slotof = (const int*)(ws + WS_SLOTOF);
        for (int t = gw; t < T; t += NGW) {
            float* orow = p.out + (size_t)t * D; float* wrow = (PROBE_PHASE == 12 && _rep == 0) ? (float*)(ws + WS_H) + (size_t)t * D : orow; float v[16];
            { const f32x4 a = *(const f32x4*)(orow + 8 * lane), b = *(const f32x4*)(orow + 8 * lane + 4), c = *(const f32x4*)(orow + 512 + 8 * lane), d = *(const f32x4*)(orow + 512 + 8 * lane + 4);
#pragma unroll
              for (int j = 0; j < 4; ++j) { v[j] = a[j]; v[4 + j] = b[j]; v[8 + j] = c[j]; v[12 + j] = d[j]; } }
            int sl[8];
#pragma unroll
            for (int k = 0; k < 8; ++k) sl[k] = slotof[(size_t)t * 8 + k];
#pragma unroll
            for (int k = 0; k < 8; ++k) { const unsigned char* yr = (const unsigned char*)Y + (size_t)sl[k] * D; const u32x2 a = *(const u32x2*)(yr + 8 * lane), b = *(const u32x2*)(yr + 512 + 8 * lane);
#pragma unroll
                for (int w = 0; w < 2; ++w) {
                    const f32x2 a0 = __builtin_amdgcn_cvt_pk_f32_fp8((int)a[w], false), a1 = __builtin_amdgcn_cvt_pk_f32_fp8((int)a[w], true), b0 = __builtin_amdgcn_cvt_pk_f32_fp8((int)b[w], false), b1 = __builtin_amdgcn_cvt_pk_f32_fp8((int)b[w], true);
                    v[4 * w] += a0[0] * 0.015625f; v[4 * w + 1] += a0[1] * 0.015625f; v[4 * w + 2] += a1[0] * 0.015625f; v[4 * w + 3] += a1[1] * 0.015625f;
                    v[8 + 4 * w] += b0[0] * 0.015625f; v[8 + 4 * w + 1] += b0[1] * 0.015625f; v[8 + 4 * w + 2] += b1[0] * 0.015625f; v[8 + 4 * w + 3] += b1[1] * 0.015625f; } }
            float s = 0.f;
#pragma unroll
            for (int j = 0; j < 16; ++j) s += v[j];
            const float mean = wave_sum(s) * (1.f / D); float s2 = 0.f;
#pragma unroll
            for (int j = 0; j < 16; ++j) { v[j] -= mean; s2 += v[j] * v[j]; }
            const float rstd = 1.f / sqrtf(wave_sum(s2) * (1.f / D) + LN_EPS);
            const float* gm = p.in[24]; const float* bt = p.in[25];
#pragma unroll
            for (int q = 0; q < 4; ++q) { const int c0 = (q >> 1) * 512 + 8 * lane + (q & 1) * 4; const f32x4 g4 = *(const f32x4*)(gm + c0), b4 = *(const f32x4*)(bt + c0); f32x4 o;
#pragma unroll
                for (int j = 0; j < 4; ++j) o[j] = v[4 * q + j] * rstd * g4[j] + b4[j];
                *(f32x4*)(wrow + c0) = o; }
        }
    }
    STAMP(13);
    if (PROBE_PHASE >= 100 && wave == 0 && lane_id() == 0) {
        volatile LAS unsigned* st = (volatile LAS unsigned*)(lds + L_STAMP);
        const unsigned d = (PROBE_PHASE == 200) ? st[13] - st[0] : (PROBE_PHASE == 201) ? st[7] - st[0] : (PROBE_PHASE == 202) ? st[13] - st[7] : st[PROBE_PHASE - 100 + 1] - st[PROBE_PHASE - 100], t0 = (unsigned)__builtin_amdgcn_s_memrealtime();
        while ((unsigned)__builtin_amdgcn_s_memrealtime() - t0 < d) __builtin_amdgcn_s_sleep(8);
    }
#undef IN
#undef SEAM
}

extern "C" void kernel_launch(void* const* d_in, const int* in_sizes, int n_in, void* d_out, int out_size, void* d_ws, size_t ws_size, hipStream_t stream) {
    static int grid = 0;
    if (grid == 0) {
        if (n_in != 26 || in_sizes[0] != T * D || out_size != T * D || ws_size < WS_END) { fprintf(stderr, "kernel_launch: unexpected shapes / workspace (%d inputs, ws %zu < %zu)\n", n_in, ws_size, (size_t)WS_END); grid = -1; return; }
        int dev = 0, cus = 0, per_cu = 0;
        if (hipGetDevice(&dev) != hipSuccess || hipDeviceGetAttribute(&cus, hipDeviceAttributeMultiprocessorCount, dev) != hipSuccess) { grid = -1; return; }
        if (hipFuncSetAttribute((const void*)fwd_kernel, hipFuncAttributeMaxDynamicSharedMemorySize, LDS_BYTES) != hipSuccess) { fprintf(stderr, "kernel_launch: hipFuncSetAttribute failed\n"); grid = -1; return; }
        if (hipOccupancyMaxActiveBlocksPerMultiprocessor(&per_cu, (const void*)fwd_kernel, 512, LDS_BYTES) != hipSuccess || per_cu < 1) { fprintf(stderr, "kernel_launch: occupancy query says %d\n", per_cu); }
        (void)hipGetLastError();
        grid = cus;
    }
    if (grid < 0) return;
    (void)hipMemsetAsync((char*)d_ws + WS_CTL, 0, CTL_BYTES, stream);
    Params p{};
    for (int i = 0; i < 26; ++i) p.in[i] = (const float*)d_in[i];
    p.out = (float*)d_out; p.ws = (unsigned char*)d_ws;
    const int dils[3] = {1, 4, 16};
    for (int g = 0; g < 3; ++g) for (int rel = 0; rel <= 128; ++rel) {
        const long dist = (long)rel * dils[g]; long bk;
        if (dist < 16) bk = dist;
        else { const double dd = (double)(dist < 1 ? 1 : dist); long large = 16 + (long)(std::log(dd / 16.0) / std::log(2048.0 / 16.0) * 16.0); bk = large < 31 ? large : 31; }
        p.bucket[g][rel] = (unsigned char)bk;
    }
#if N_LAUNCHES == 1
    p.lo = 0; p.hi = NPHASE;
    hipLaunchKernelGGL(fwd_kernel, dim3(grid), dim3(512), LDS_BYTES, stream, p);
#else
    for (int k = 0; k < NPHASE; ++k) { p.lo = k; p.hi = k + 1; hipLaunchKernelGGL(fwd_kernel, dim3(grid), dim3(512), LDS_BYTES, stream, p); }
#endif
}
```

```cpp
#include <hip/hip_runtime.h>
#include <cstdio>
#include <cstdint>
#include <cmath>

#ifndef N_LAUNCHES
#define N_LAUNCHES 1
#endif

#define GAS __attribute__((address_space(1)))
#define LAS __attribute__((address_space(3)))
typedef unsigned short bf16;
typedef float f32x2 __attribute__((ext_vector_type(2)));
typedef float f32x4 __attribute__((ext_vector_type(4)));
typedef float f32x16 __attribute__((ext_vector_type(16)));
typedef short bf16x8 __attribute__((ext_vector_type(8)));
typedef short bf16x4 __attribute__((ext_vector_type(4)));
typedef unsigned u32x4 __attribute__((ext_vector_type(4)));
typedef unsigned u32x2 __attribute__((ext_vector_type(2)));

constexpr int NB = 8, SEQ = 4096, T = NB * SEQ, D = 1024, DIN = 8704;
constexpr int C_XR = 0, C_GR = 1024, C_Q = 2048, C_K = 3584, C_V = 5120, C_GRNN = 6656, C_GATT = 7680;
constexpr int NE = 256, TOPK = 8, DE = 256;
constexpr int TCH = 128, NCH = SEQ / TCH;
constexpr int MAXT_R = 1280, SH_TILES = T / 256, MAXT = MAXT_R + SH_TILES;
constexpr float ALPHA = 1.18920711500272f, LN_EPS = 1e-5f;
constexpr int NPHASE = 13;

constexpr size_t MiB = 1u << 20;
constexpr size_t WS_CTL = 0, CTL_BYTES = 1 * MiB;
constexpr size_t WS_WINT = 1 * MiB;
constexpr size_t WS_WPRT = 18 * MiB;
constexpr size_t WS_WPAT = 20 * MiB;
constexpr size_t WS_WOT = 21 * MiB;
constexpr size_t WS_WRT = 23 * MiB;
constexpr size_t WS_HIST = 31 * MiB + 512 * 1024;
constexpr size_t WS_EIDX = 24 * MiB, WS_GATEW = 25 * MiB, WS_RANK = 26 * MiB, WS_SLOTOF = 27 * MiB, WS_TOKSLOT = 28 * MiB, WS_WSLOT = 30 * MiB;
constexpr size_t WS_XB = 32 * MiB;
constexpr size_t WS_YRNN = 32 * MiB;
constexpr size_t WS_HLOC = 96 * MiB;
constexpr size_t WS_MERGED = 96 * MiB;
constexpr size_t WS_CUMA = 160 * MiB;
constexpr size_t WS_AO = 224 * MiB;
constexpr size_t WS_YATT = 320 * MiB;
constexpr size_t WS_SUMA = 352 * MiB, WS_SUMH = 353 * MiB;
constexpr size_t WS_LSE = 354 * MiB;
constexpr size_t WS_PROJ = 360 * MiB;
constexpr size_t WS_PRELN = 700 * MiB;
constexpr size_t WS_WD = 32 * MiB;
constexpr size_t WS_H = 161 * MiB;
constexpr size_t WS_Y = 337 * MiB;
constexpr size_t WS_X1B = 337 * MiB;
constexpr size_t WS_WGU = 401 * MiB;
constexpr size_t WS_X1B8 = 830 * MiB;
constexpr size_t WS_LOGITS = 658 * MiB;
constexpr size_t WS_END = 977 * MiB;
constexpr int CW_BAR = 4096, CW_CNT = 16384;

constexpr int RING_BYTES = 131072;
constexpr int L_TBASE = RING_BYTES;
constexpr int L_TILEE = L_TBASE + 1040;
constexpr int L_BTAB = L_TILEE + 2816;
constexpr int L_MISC = L_BTAB + 12672;
constexpr int L_LCNT = L_MISC + 64;
constexpr int L_BBASE = L_LCNT + 1024;
constexpr int L_STAMP = L_BBASE + 1024;
constexpr int LDS_BYTES = 151552;
static_assert(L_STAMP + 64 <= LDS_BYTES, "LDS map");

__device__ __forceinline__ unsigned f2bf(float f) { unsigned u = __builtin_bit_cast(unsigned, f); return (u + 0x7fffu + ((u >> 16) & 1u)) >> 16; }
__device__ __forceinline__ unsigned pk2(float lo, float hi) { return f2bf(lo) | (f2bf(hi) << 16); }
__device__ __forceinline__ unsigned pk_fp8x4(float a, float b, float c, float d) {
    a = __builtin_amdgcn_fmed3f(a, -448.f, 448.f); b = __builtin_amdgcn_fmed3f(b, -448.f, 448.f); c = __builtin_amdgcn_fmed3f(c, -448.f, 448.f); d = __builtin_amdgcn_fmed3f(d, -448.f, 448.f);
    int w = 0; w = __builtin_amdgcn_cvt_pk_fp8_f32(a, b, w, false); w = __builtin_amdgcn_cvt_pk_fp8_f32(c, d, w, true); return (unsigned)w; }
__device__ __forceinline__ float bflo(unsigned w) { return __builtin_bit_cast(float, w << 16); }
__device__ __forceinline__ float bfhi(unsigned w) { return __builtin_bit_cast(float, w & 0xffff0000u); }
__device__ __forceinline__ float bf1(bf16 h) { return __builtin_bit_cast(float, (unsigned)h << 16); }
__device__ __forceinline__ float sigmoidf_(float x) { return 1.0f / (1.0f + __expf(-x)); }
__device__ __forceinline__ float gelu_tanh(float x) { const float z = 1.5957691216057308f * (x + 0.044715f * x * x * x); return x / (1.0f + __expf(-z)); }
__device__ __forceinline__ float wave_sum(float v) {
#pragma unroll
    for (int o = 1; o < 64; o <<= 1) v += __shfl_xor(v, o);
    return v;
}

__device__ __forceinline__ int lane_id() { return (int)__builtin_amdgcn_mbcnt_hi(~0u, __builtin_amdgcn_mbcnt_lo(~0u, 0u)); }
namespace pg8 {
#define PG8_LAS __attribute__((address_space(3)))
typedef unsigned short bf16_t;
constexpr int BM = 256, BK = 64, HALF = 128, HTB = HALF * BK * 2, STAGE_BYTES = 8 * HTB, NXCD = 8, WGM = 8;
__host__ __device__ __forceinline__ int lds_byte(int r, int c) { const int st = (r >> 4) * 2 + (c >> 5), rr = r & 15, cc = c & 31, ob = rr * 64 + cc * 2; return st * 1024 + (ob ^ (((ob >> 9) & 1) << 5)); }
__host__ __device__ __forceinline__ void stage_rc(int b, int& R, int& C) { const int st = b / 1024, sb = b % 1024, swz = sb ^ (((sb >> 9) & 1) << 5); R = (st >> 1) * 16 + swz / 64; C = (st & 1) * 32 + (swz % 64) / 2; }
__host__ __device__ __forceinline__ int perm32(int rho) { const int n = rho >> 4, i = rho & 15; return 8 * (i >> 2) + 4 * n + (i & 3); }

struct Unit { int pm, pn, pb; };
struct Gemm { const bf16_t* A; const bf16_t* Bt; int K; int sw, sa; };

struct StaticOrder {
    static constexpr bool GATHER = false;
    int nM, nN, nwg, G, c;
    __device__ __forceinline__ void init(int M, int N, int G_, int c_) { nM = M / BM; nN = N / BM; nwg = nM * nN; G = G_; c = c_; }
    __device__ __forceinline__ bool next(int i, Unit& u) const {
        const long L = (long)i * G + c; if (L >= nwg) return false;
        int wgid = (int)L; { const int q = nwg / NXCD, r = nwg % NXCD, xcd = wgid % NXCD, off = wgid / NXCD; wgid = (xcd < r ? xcd * (q + 1) : r * (q + 1) + (xcd - r) * q) + off; }
        const int nig = WGM * nN, gid = wgid / nig, fm = gid * WGM, gsz = (nM - fm) < WGM ? (nM - fm) : WGM;
        u.pm = fm + ((wgid % nig) % gsz); u.pn = (wgid % nig) / gsz; u.pb = u.pn; return true;
    }
    __device__ __forceinline__ unsigned arow(int) const { return 0u; }
};
template <bool GATHER_> struct GroupOrder {
    static constexpr bool GATHER = GATHER_;
    int nN, nwg, G, c; const LAS unsigned short* tile_e; const int* tok; unsigned rowbytes;
    __device__ __forceinline__ bool next(int i, Unit& u) const {
        const long L = (long)i * G + c; if (L >= nwg) return false;
        u.pm = (int)L / nN; u.pn = (int)L % nN; u.pb = __builtin_amdgcn_readfirstlane((int)tile_e[u.pm]) * nN + u.pn; return true;
    }
    __device__ __forceinline__ unsigned arow(int slot) const { return (unsigned)tok[slot] * rowbytes; }
};

__device__ __forceinline__ unsigned cvt_pk_bf16(float lo, float hi) { unsigned r; asm volatile("v_cvt_pk_bf16_f32 %0, %1, %2" : "=v"(r) : "v"(lo), "v"(hi)); return r; }

typedef int i32x4 __attribute__((ext_vector_type(4)));
typedef int i32x8 __attribute__((ext_vector_type(8)));
__device__ __forceinline__ f32x4 mma8(bf16x8 w0, bf16x8 w1, bf16x8 a0, bf16x8 a1, f32x4 c, int sw, int sa) {
    const i32x8 W = __builtin_shufflevector(__builtin_bit_cast(i32x4, w0), __builtin_bit_cast(i32x4, w1), 0, 1, 2, 3, 4, 5, 6, 7);
    const i32x8 A = __builtin_shufflevector(__builtin_bit_cast(i32x4, a0), __builtin_bit_cast(i32x4, a1), 0, 1, 2, 3, 4, 5, 6, 7);
    (void)sw; (void)sa; return __builtin_amdgcn_mfma_scale_f32_16x16x128_f8f6f4(W, A, c, 0, 0, 0, 0, 0, 0);
}
template <class Epi, class Sched, bool ALIGN_EPI = false, bool FP8 = false>
__device__ __forceinline__ void gemm_phase(PG8_LAS unsigned char* lds, const Gemm g, const Sched& S, const Epi& E, int wid) {
    constexpr bool GA = Sched::GATHER;
    int lane_ = lane_id(); asm volatile("" : "+v"(lane_));
    const int lane = lane_, tid = wid * 64 + lane, wr = wid >> 2, wc = wid & 3, fr = lane & 15, fq = lane >> 4;
    const int K = g.K, nt = K / BK;
    unsigned voffA[2], voffA1[2], voffB[2];
#pragma unroll
    for (int i = 0; i < 2; ++i) { int R, C; stage_rc(tid * 16 + i * 8192, R, C); const int Rb = Epi::PERM ? ((R & ~31) + perm32(R & 31)) : R;
        voffA[i] = (unsigned)(R * K + C) * 2u; voffA1[i] = voffA[i]; voffB[i] = (unsigned)(Rb * K + C) * 2u; }
    const size_t kstep = (size_t)(BK * 2);
    const size_t hstep = (size_t)HALF * K * 2;
    const size_t tstep = 2 * hstep;
    const size_t hstepA = GA ? 0 : hstep;
    const unsigned ldsw = (unsigned)wid * 1024u;
    const unsigned ldsbase = (unsigned)(size_t)lds + ldsw;
    const int aoff = lds_byte(wr * 64 + fr, fq * 8), boff = lds_byte(wc * 32 + fr, fq * 8);
    unsigned abase = (unsigned)(size_t)lds + (unsigned)aoff, bbase = (unsigned)(size_t)lds + 65536u + (unsigned)boff;
    asm volatile("" : "+v"(abase), "+v"(bbase));
#define PG8_RDA(off) (*(const PG8_LAS i32x4*)(size_t)(abase + (unsigned)(off)))
#define PG8_RDB(off) (*(const PG8_LAS i32x4*)(size_t)(bbase + (unsigned)((off) - 65536)))
#define PG8_SA(b, h) (((b) * 2 + (h)) * HTB)
#define PG8_SB(b, h) ((4 + (b) * 2 + (h)) * HTB)
#define PG8_STAGE(bufoff, gbase, voff) do { _Pragma("unroll") for (int _i = 0; _i < 2; ++_i) { unsigned _keep; \
        asm volatile("s_mov_b32 %0, m0\n\ts_mov_b32 m0, %3\n\ts_nop 0\n\tglobal_load_lds_dwordx4 %1, %2\n\ts_mov_b32 m0, %0" : "=&s"(_keep) : "v"((voff)[_i]), "s"((const char*)(gbase)), "s"(ldsbase + (unsigned)((bufoff) + _i * 8192)) : "memory"); } } while (0)
#define PG8_LDA(dst, b, h) do { if constexpr (FP8) { _Pragma("unroll") for (int m = 0; m < 4; ++m) dst##8[m] = __builtin_shufflevector(PG8_RDA(PG8_SA(b, h) + m * 2048), PG8_RDA(PG8_SA(b, h) + m * 2048 + 1024), 0, 1, 2, 3, 4, 5, 6, 7); } \
        else { _Pragma("unroll") for (int m = 0; m < 4; ++m) _Pragma("unroll") for (int k = 0; k < 2; ++k) dst[m][k] = __builtin_bit_cast(bf16x8, PG8_RDA(PG8_SA(b, h) + m * 2048 + k * 1024)); } } while (0)
#define PG8_LDB(dst, b, h) do { if constexpr (FP8) { _Pragma("unroll") for (int n = 0; n < 2; ++n) dst##8[n] = __builtin_shufflevector(PG8_RDB(PG8_SB(b, h) + n * 2048), PG8_RDB(PG8_SB(b, h) + n * 2048 + 1024), 0, 1, 2, 3, 4, 5, 6, 7); } \
        else { _Pragma("unroll") for (int n = 0; n < 2; ++n) _Pragma("unroll") for (int k = 0; k < 2; ++k) dst[n][k] = __builtin_bit_cast(bf16x8, PG8_RDB(PG8_SB(b, h) + n * 2048 + k * 1024)); } } while (0)
#define PG8_MMA(ai, bj, At, Bt) do { __builtin_amdgcn_s_setprio(1); \
        if constexpr (FP8) { _Pragma("unroll") for (int m = 0; m < 4; ++m) _Pragma("unroll") for (int n = 0; n < 2; ++n) acc[ai][bj][m][n] = __builtin_amdgcn_mfma_scale_f32_16x16x128_f8f6f4(Bt##8[n], At##8[m], acc[ai][bj][m][n], 0, 0, 0, 0, 0, 0); } \
        else { _Pragma("unroll") for (int m = 0; m < 4; ++m) _Pragma("unroll") for (int n = 0; n < 2; ++n) _Pragma("unroll") for (int k = 0; k < 2; ++k) \
        acc[ai][bj][m][n] = __builtin_amdgcn_mfma_f32_16x16x32_bf16(Bt[n][k], At[m][k], acc[ai][bj][m][n], 0, 0, 0); } __builtin_amdgcn_s_setprio(0); } while (0)
#define PG8_WAIT_V(n) asm volatile("s_waitcnt vmcnt(" #n ")" ::: "memory")
#define PG8_WAIT_L(n) asm volatile("s_waitcnt lgkmcnt(" #n ")" ::: "memory")
#define PG8_BAR __builtin_amdgcn_s_barrier()
#define PG8_SCHED __builtin_amdgcn_sched_barrier(0)
    Unit cur, nxt; int ui = 0;
    if (!S.next(0, cur)) return;
    f32x4 acc[2][2][4][2];
#pragma unroll
    for (int a = 0; a < 2; ++a)
#pragma unroll
        for (int b = 0; b < 2; ++b)
#pragma unroll
            for (int m = 0; m < 4; ++m)
#pragma unroll
                for (int n = 0; n < 2; ++n) acc[a][b][m][n] = (f32x4){0.f, 0.f, 0.f, 0.f};
    bf16x8 At[4][2], B0[2][2], B1[2][2]; i32x8 At8[4], B08[2], B18[2]; (void)At; (void)B0; (void)B1; (void)At8; (void)B08; (void)B18;
    const char* cA = GA ? (const char*)g.A : (const char*)g.A + (size_t)cur.pm * tstep; const char* cB = (const char*)g.Bt + (size_t)cur.pb * tstep;
#define PG8_GATHER_OFFS(pm_) do { int _ln = lane_id(); asm volatile("" : "+v"(_ln)); int _R, _C; stage_rc((wid * 64 + _ln) * 16, _R, _C); \
        _Pragma("unroll") for (int _i = 0; _i < 2; ++_i) { voffA[_i] = S.arow((pm_) * BM + _R + 64 * _i) + (unsigned)(_C * 2); voffA1[_i] = S.arow((pm_) * BM + HALF + _R + 64 * _i) + (unsigned)(_C * 2); } } while (0)
    if constexpr (GA) PG8_GATHER_OFFS(cur.pm);
    PG8_STAGE(PG8_SB(0, 0), cB, voffB); PG8_STAGE(PG8_SB(0, 1), cB + hstep, voffB); PG8_STAGE(PG8_SA(0, 0), cA, voffA); PG8_STAGE(PG8_SA(0, 1), cA + hstepA, voffA1);
    if (wr == 1) PG8_BAR;
    PG8_WAIT_V(2); PG8_BAR;
    PG8_STAGE(PG8_SB(1, 0), cB + kstep, voffB); PG8_STAGE(PG8_SA(1, 0), cA + kstep, voffA); PG8_STAGE(PG8_SB(1, 1), cB + hstep + kstep, voffB);
    PG8_WAIT_V(6); PG8_BAR;
    for (;;) {
        const bool has_next = S.next(ui + 1, nxt);
        const char* nA = GA ? (const char*)g.A : (has_next ? (const char*)g.A + (size_t)nxt.pm * tstep : cA);
        const char* nB = has_next ? (const char*)g.Bt + (size_t)nxt.pb * tstep : cB;
#pragma clang loop unroll(disable)
        for (int t = 0; t < nt; t += 2) {
            const bool last = (t == nt - 2);
            const char* a1 = cA + (size_t)(t + 1) * kstep;
            const char* a2 = last ? nA : cA + (size_t)(t + 2) * kstep; const char* b2 = last ? nB : cB + (size_t)(t + 2) * kstep;
            const char* a3 = a2 + kstep; const char* b3 = b2 + kstep;
            PG8_LDB(B0, 0, 0); PG8_LDB(B1, 0, 1); PG8_SCHED; PG8_LDA(At, 0, 0); PG8_STAGE(PG8_SA(1, 1), a1 + hstepA, voffA1);
            if constexpr (GA) { if (last && has_next) PG8_GATHER_OFFS(nxt.pm); }
            PG8_WAIT_V(8); PG8_WAIT_L(0); PG8_BAR; PG8_MMA(0, 0, At, B0); PG8_MMA(0, 1, At, B1); PG8_BAR; PG8_SCHED;
            PG8_LDA(At, 0, 1); PG8_STAGE(PG8_SB(0, 0), b2, voffB); PG8_STAGE(PG8_SB(0, 1), b2 + hstep, voffB); PG8_STAGE(PG8_SA(0, 0), a2, voffA);
            PG8_WAIT_V(8); PG8_WAIT_L(0); PG8_BAR; PG8_MMA(1, 0, At, B0); PG8_MMA(1, 1, At, B1); PG8_BAR; PG8_SCHED;
            PG8_LDB(B0, 1, 0); PG8_LDB(B1, 1, 1); PG8_SCHED; PG8_LDA(At, 1, 0); PG8_STAGE(PG8_SA(0, 1), a2 + hstepA, voffA1);
            PG8_WAIT_V(8); PG8_WAIT_L(0); PG8_BAR; PG8_MMA(0, 0, At, B0); PG8_MMA(0, 1, At, B1); PG8_BAR; PG8_SCHED;
            PG8_LDA(At, 1, 1); PG8_STAGE(PG8_SB(1, 0), b3, voffB); PG8_STAGE(PG8_SB(1, 1), b3 + hstep, voffB); PG8_STAGE(PG8_SA(1, 0), a3, voffA);
            PG8_WAIT_V(8); PG8_WAIT_L(0); PG8_BAR; PG8_MMA(1, 0, At, B0); PG8_MMA(1, 1, At, B1); PG8_BAR; PG8_SCHED;
        }
        if constexpr (ALIGN_EPI) { if (wr == 0) PG8_BAR; }
        { Unit eu = cur; int efr = fr, efq = fq;
          asm volatile("" : "+s"(eu.pm), "+s"(eu.pn), "+s"(eu.pb)); asm volatile("" : "+v"(efr), "+v"(efq));
          E(acc, eu, wr, wc, efr, efq); }
        if (!has_next) break;
#pragma unroll
        for (int a = 0; a < 2; ++a)
#pragma unroll
            for (int b = 0; b < 2; ++b)
#pragma unroll
                for (int m = 0; m < 4; ++m)
#pragma unroll
                    for (int n = 0; n < 2; ++n) acc[a][b][m][n] = (f32x4){0.f, 0.f, 0.f, 0.f};
        cur = nxt; cA = nA; cB = nB; ++ui;
        if constexpr (ALIGN_EPI) { if (wr == 1) PG8_BAR; }
    }
    PG8_WAIT_V(0);
    if constexpr (!ALIGN_EPI) { if (wr == 0) PG8_BAR; }
    PG8_BAR;
#undef PG8_SA
#undef PG8_SB
#undef PG8_STAGE
#undef PG8_LDA
#undef PG8_LDB
#undef PG8_GATHER_OFFS
#undef PG8_RDA
#undef PG8_RDB
#undef PG8_MMA
#undef PG8_WAIT_V
#undef PG8_WAIT_L
#undef PG8_BAR
#undef PG8_SCHED
}

typedef const f32x4 (&AccRef)[2][2][4][2];

struct EpiInProj {
    static constexpr bool PERM = true;
    bf16_t* O; const float* bias; float os;
    __device__ __forceinline__ void operator()(AccRef acc, const Unit& u, int wr, int wc, int fr, int fq) const {
        const int row0 = u.pm * BM + wr * 64 + fr, col0 = u.pn * BM + wc * 32 + 8 * fq;
        const int kind = u.pn < 4 ? 0 : (u.pn < 8 ? 1 : (u.pn < 14 ? 2 : (u.pn < 26 ? 0 : 3)));
        f32x4 bv[2][2];
#pragma unroll
        for (int bj = 0; bj < 2; ++bj)
#pragma unroll
            for (int n = 0; n < 2; ++n) bv[bj][n] = *(const f32x4*)(bias + col0 + bj * HALF + 4 * n);
#pragma unroll
        for (int ai = 0; ai < 2; ++ai)
#pragma unroll
            for (int m = 0; m < 4; ++m) { bf16_t* rowp = O + (size_t)(row0 + ai * HALF + m * 16) * DIN + col0;
#pragma unroll
                for (int bj = 0; bj < 2; ++bj) { f32x4 v0 = acc[ai][bj][m][0] * os + bv[bj][0], v1 = acc[ai][bj][m][1] * os + bv[bj][1];
                    if (kind == 1) {
#pragma unroll
                        for (int j = 0; j < 4; ++j) { v0[j] = gelu_tanh(v0[j]); v1[j] = gelu_tanh(v1[j]); }
                    } else if (kind == 2) { v0 = v0 * 0.125f; v1 = v1 * 0.125f; }
                    else if (kind == 3) {
#pragma unroll
                        for (int j = 0; j < 4; ++j) { v0[j] = sigmoidf_(v0[j]); v1[j] = sigmoidf_(v1[j]); }
                    }
                    u32x4 w; w.x = cvt_pk_bf16(v0[0], v0[1]); w.y = cvt_pk_bf16(v0[2], v0[3]); w.z = cvt_pk_bf16(v1[0], v1[1]); w.w = cvt_pk_bf16(v1[2], v1[3]);
                    *(u32x4*)(rowp + bj * HALF) = w; } }
    }
};
struct EpiProjRnn {
    static constexpr bool PERM = true;
    const bf16_t* proj; float* part; float os;
    __device__ __forceinline__ void operator()(AccRef acc, const Unit& u, int wr, int wc, int fr, int fq) const {
        const int row0 = u.pm * BM + wr * 64 + fr, col0 = u.pn * BM + wc * 32 + 8 * fq;
#pragma unroll
        for (int ai = 0; ai < 2; ++ai)
#pragma unroll
            for (int m = 0; m < 4; ++m) { const size_t row = (size_t)(row0 + ai * HALF + m * 16);
#pragma unroll
                for (int bj = 0; bj < 2; ++bj) { const int c = col0 + bj * HALF;
                    const u32x4 gw = *(const u32x4*)(proj + row * DIN + C_GRNN + c);
                    const f32x4 g0 = (f32x4){bflo(gw.x), bfhi(gw.x), bflo(gw.y), bfhi(gw.y)} * os, g1 = (f32x4){bflo(gw.z), bfhi(gw.z), bflo(gw.w), bfhi(gw.w)} * os;
                    *(f32x4*)(part + row * D + c) = g0 * acc[ai][bj][m][0]; *(f32x4*)(part + row * D + c + 4) = g1 * acc[ai][bj][m][1]; } }
    }
};
struct EpiProjAtt {
    static constexpr bool PERM = true;
    const bf16_t* proj; const float* part; unsigned char* merged; float os;
    __device__ __forceinline__ void operator()(AccRef acc, const Unit& u, int wr, int wc, int fr, int fq) const {
        const int row0 = u.pm * BM + wr * 64 + fr, col0 = u.pn * BM + wc * 32 + 8 * fq;
#pragma unroll
        for (int ai = 0; ai < 2; ++ai)
#pragma unroll
            for (int m = 0; m < 4; ++m) { const size_t row = (size_t)(row0 + ai * HALF + m * 16);
#pragma unroll
                for (int bj = 0; bj < 2; ++bj) { const int c = col0 + bj * HALF;
                    const u32x4 gw = *(const u32x4*)(proj + row * DIN + C_GATT + c);
                    const f32x4 g0 = (f32x4){bflo(gw.x), bfhi(gw.x), bflo(gw.y), bfhi(gw.y)} * os, g1 = (f32x4){bflo(gw.z), bfhi(gw.z), bflo(gw.w), bfhi(gw.w)} * os;
                    const f32x4 v0 = (*(const f32x4*)(part + row * D + c) + g0 * acc[ai][bj][m][0]) * 16.0f, v1 = (*(const f32x4*)(part + row * D + c + 4) + g1 * acc[ai][bj][m][1]) * 16.0f;
                    u32x2 w; w.x = pk_fp8x4(v0[0], v0[1], v0[2], v0[3]); w.y = pk_fp8x4(v1[0], v1[1], v1[2], v1[3]);
                    *(u32x2*)(merged + row * D + c) = w; } }
    }
};
struct EpiF32Res {
    static constexpr bool PERM = false;
    const float* base; float* out; int ldc; float scale; float os;
    __device__ __forceinline__ void operator()(AccRef acc, const Unit& u, int wr, int wc, int fr, int fq) const {
        const int row0 = u.pm * BM + wr * 64 + fr, col0 = u.pn * BM + wc * 32 + 4 * fq;
#pragma unroll
        for (int ai = 0; ai < 2; ++ai)
#pragma unroll
            for (int m = 0; m < 4; ++m) { const size_t off = (size_t)(row0 + ai * HALF + m * 16) * ldc + col0;
#pragma unroll
                for (int bj = 0; bj < 2; ++bj)
#pragma unroll
                    for (int n = 0; n < 2; ++n) { f32x4 v = acc[ai][bj][m][n] * os;
                        if (base) v = v + *(const f32x4*)(base + off + bj * HALF + n * 16) * scale;
                        *(f32x4*)(out + off + bj * HALF + n * 16) = v; } }
    }
};
struct EpiGateUp {
    static constexpr bool PERM = true;
    bf16_t* H; float os;
    __device__ __forceinline__ void operator()(AccRef acc, const Unit& u, int wr, int wc, int fr, int fq) const {
        const int row0 = u.pm * BM + wr * 64 + fr, col0 = u.pn * HALF + wc * 32 + 8 * fq;
#pragma unroll
        for (int ai = 0; ai < 2; ++ai)
#pragma unroll
            for (int m = 0; m < 4; ++m) { bf16_t* rowp = H + (size_t)(row0 + ai * HALF + m * 16) * DE + col0;
                f32x4 o[2];
#pragma unroll
                for (int n = 0; n < 2; ++n) { const f32x4 gt = acc[ai][0][m][n] * os, up = acc[ai][1][m][n] * os;
#pragma unroll
                    for (int j = 0; j < 4; ++j) o[n][j] = gt[j] / (1.0f + __expf(-gt[j])) * up[j]; }
                u32x4 w; w.x = cvt_pk_bf16(o[0][0], o[0][1]); w.y = cvt_pk_bf16(o[0][2], o[0][3]); w.z = cvt_pk_bf16(o[1][0], o[1][1]); w.w = cvt_pk_bf16(o[1][2], o[1][3]);
                *(u32x4*)rowp = w; }
    }
};
struct EpiDown {
    static constexpr bool PERM = true;
    bf16_t* Y; const float* wslot; float* out; int mt_r;
    __device__ __forceinline__ void operator()(AccRef acc, const Unit& u, int wr, int wc, int fr, int fq) const {
        const int col0 = u.pn * BM + wc * 32 + 8 * fq;
        if (u.pm < mt_r) {
            const int row0 = u.pm * BM + wr * 64 + fr;
#pragma unroll
            for (int ai = 0; ai < 2; ++ai)
#pragma unroll
                for (int m = 0; m < 4; ++m) { const size_t row = (size_t)(row0 + ai * HALF + m * 16); const float w8 = wslot[row] * 64.0f; unsigned char* rowp = (unsigned char*)Y + row * D + col0;
#pragma unroll
                    for (int bj = 0; bj < 2; ++bj) { const f32x4 v0 = acc[ai][bj][m][0] * w8, v1 = acc[ai][bj][m][1] * w8;
                        u32x2 w; w.x = pk_fp8x4(v0[0], v0[1], v0[2], v0[3]); w.y = pk_fp8x4(v1[0], v1[1], v1[2], v1[3]);
                        *(u32x2*)(rowp + bj * HALF) = w; } }
        } else {
            const int row0 = (u.pm - mt_r) * BM + wr * 64 + fr;
#pragma unroll
            for (int ai = 0; ai < 2; ++ai)
#pragma unroll
                for (int m = 0; m < 4; ++m) { float* rowp = out + (size_t)(row0 + ai * HALF + m * 16) * D + col0;
#pragma unroll
                    for (int bj = 0; bj < 2; ++bj)
#pragma unroll
                        for (int n = 0; n < 2; ++n) { float* p = rowp + bj * HALF + 4 * n; *(f32x4*)p = *(const f32x4*)p * ALPHA + acc[ai][bj][m][n]; } }
        }
    }
};
}

#define XB_TMO      128
#define XB_XCNT(j)  (256  + 64 * (j))
#define XB_XSUB(j)  (1280 + 64 * (j))
#define XB_XGEN(j)  (2304 + 64 * (j))
#define XB_TOP      3328
#define XB_TOPGEN   3392
#define XCD_BAR_WORDS 3456
#define XB_SPIN_CAP (1u << 18)
__device__ __forceinline__ unsigned xb_ld(unsigned* p)              { return __hip_atomic_load(p, __ATOMIC_RELAXED, __HIP_MEMORY_SCOPE_AGENT); }
__device__ __forceinline__ unsigned xb_add(unsigned* p, unsigned v) { return __hip_atomic_fetch_add(p, v, __ATOMIC_RELAXED, __HIP_MEMORY_SCOPE_AGENT); }
__device__ __forceinline__ unsigned xb_xcc_id() { return (unsigned)__builtin_amdgcn_s_getreg((3 << 11) | 20) & 0xFu; }
#define XB_SPIN(cond, bar) do { unsigned _sp = 0; while (cond) { __builtin_amdgcn_s_sleep(1); \
    if ((++_sp & 255u) == 0u) { if (xb_ld(&(bar)[XB_TMO])) break; if (_sp > XB_SPIN_CAP) { atomicAdd(&(bar)[XB_TMO], 1u); break; } } } } while (0)
struct XcdBarrier { unsigned* bar; unsigned x; volatile LAS unsigned* st; };
__device__ __forceinline__ XcdBarrier xcd_barrier_post(unsigned* bar, volatile LAS unsigned* st, bool t0) {
    XcdBarrier b; b.bar = bar; b.x = xb_xcc_id(); b.st = st;
    if (t0) (void)xb_add(&bar[XB_XCNT(b.x)], 1u);
    return b;
}
__device__ __forceinline__ void xcd_barrier_complete(unsigned* bar, unsigned x, unsigned& nloc, unsigned& nx) {
    const unsigned G = gridDim.x * gridDim.y * gridDim.z;
    unsigned sum, cnt, mine, sp = 0u;
    for (;;) {
        sum = 0u; cnt = 0u; mine = 0u;
#pragma unroll
        for (unsigned j = 0; j < 16; ++j) { const unsigned c = xb_ld(&bar[XB_XCNT(j)]); sum += c; cnt += (c > 0u) ? 1u : 0u; mine = (j == x) ? c : mine; }
        if (sum == G) break;
        __builtin_amdgcn_s_sleep(1);
        if ((++sp & 255u) == 0u) { if (xb_ld(&bar[XB_TMO])) break; if (sp > XB_SPIN_CAP) { atomicAdd(&bar[XB_TMO], 1u); break; } }
    }
    nloc = mine > 0u ? mine : 1u; nx = cnt > 0u ? cnt : 1u;
}
__device__ __forceinline__ void xcd_barrier(const XcdBarrier& b, bool t0) {
    asm volatile("s_waitcnt vmcnt(0)" ::: "memory");
    __syncthreads();
    if (t0) {
        unsigned* bar = b.bar;
        __builtin_amdgcn_s_waitcnt(0);
        unsigned nloc = b.st[0], nx = b.st[1];
        if (nloc == 0u) { xcd_barrier_complete(bar, b.x, nloc, nx); b.st[0] = nloc; b.st[1] = nx; }
        const unsigned old = xb_add(&bar[XB_XSUB(b.x)], 1u);
        const unsigned gen = old / nloc;
        if (old + 1u == (gen + 1u) * nloc) {
            __builtin_amdgcn_fence(__ATOMIC_RELEASE, "agent");
            asm volatile("s_waitcnt vmcnt(0)" ::: "memory");
            const unsigned og = xb_add(&bar[XB_TOP], 1u);
            const unsigned tg = og / nx;
            if (og + 1u == (tg + 1u) * nx) xb_add(&bar[XB_TOPGEN], 1u);
            else XB_SPIN(xb_ld(&bar[XB_TOPGEN]) == tg, bar);
            __builtin_amdgcn_fence(__ATOMIC_ACQUIRE, "agent");
            xb_add(&bar[XB_XGEN(b.x)], 1u);
            asm volatile("s_waitcnt vmcnt(0)" ::: "memory");
        } else {
            XB_SPIN(xb_ld(&bar[XB_XGEN(b.x)]) == gen, bar);
            __builtin_amdgcn_fence(__ATOMIC_ACQUIRE, "agent");
            asm volatile("s_waitcnt vmcnt(0)" ::: "memory");
        }
    }
    __syncthreads();
}

struct Params { const float* in[26]; float* out; unsigned char* ws; int lo, hi; unsigned char bucket[3][136]; };
static_assert(sizeof(Params) == 26 * 8 + 8 + 8 + 8 + 408, "Params has no padding holes");

__device__ __forceinline__ void tr128(const float* src, int ld_src, bf16* dst, int ld_dst, LAS float* tile, int tid) {
    f32x4 v[8];
#pragma unroll
    for (int it = 0; it < 8; ++it) { const int id = it * 512 + tid, k = id >> 5, c4 = id & 31; v[it] = *(const f32x4*)(src + (size_t)k * ld_src + c4 * 4); }
#pragma unroll
    for (int it = 0; it < 8; ++it) { const int id = it * 512 + tid, k = id >> 5, c4 = id & 31; LAS float* p = tile + k * 129 + c4 * 4; p[0] = v[it][0]; p[1] = v[it][1]; p[2] = v[it][2]; p[3] = v[it][3]; }
    __syncthreads();
#pragma unroll
    for (int it = 0; it < 4; ++it) { const int id = it * 512 + tid, n = id >> 4, kc = id & 15; const LAS float* s = tile + (kc * 8) * 129 + n;
        u32x4 o; o.x = pk2(s[0], s[129]); o.y = pk2(s[2 * 129], s[3 * 129]); o.z = pk2(s[4 * 129], s[5 * 129]); o.w = pk2(s[6 * 129], s[7 * 129]);
        *(u32x4*)(dst + (size_t)n * ld_dst + kc * 8) = o; }
    __syncthreads();
}
__device__ __forceinline__ void tr_matrix_item(const float* W, int K, int N, bf16* WT, int item, LAS float* tile, int tid) {
    const int nbn = N / 128, kb = item / nbn, nb = item % nbn;
    tr128(W + (size_t)kb * 128 * N + nb * 128, N, WT + (size_t)nb * 128 * K + kb * 128, K, tile, tid);
}

__device__ __forceinline__ void tr128_fp8(const float* src, int ld_src, unsigned char* dst, int ld_dst, float scale, LAS float* tile, int tid) {
    f32x4 v[8];
#pragma unroll
    for (int it = 0; it < 8; ++it) { const int id = it * 512 + tid, k = id >> 5, c4 = id & 31; v[it] = *(const f32x4*)(src + (size_t)k * ld_src + c4 * 4); }
#pragma unroll
    for (int it = 0; it < 8; ++it) { const int id = it * 512 + tid, k = id >> 5, c4 = id & 31; LAS float* p = tile + k * 129 + c4 * 4; p[0] = v[it][0]; p[1] = v[it][1]; p[2] = v[it][2]; p[3] = v[it][3]; }
    __syncthreads();
#pragma unroll
    for (int it = 0; it < 2; ++it) { const int id = it * 512 + tid, n = id >> 3, kc = id & 7; const LAS float* s = tile + (kc * 16) * 129 + n;
        u32x4 o;
#pragma unroll
        for (int w = 0; w < 4; ++w) o[w] = pk_fp8x4(s[(4 * w) * 129] * scale, s[(4 * w + 1) * 129] * scale, s[(4 * w + 2) * 129] * scale, s[(4 * w + 3) * 129] * scale);
        *(u32x4*)(dst + (size_t)n * ld_dst + kc * 16) = o; }
    __syncthreads();
}
__device__ __forceinline__ void tr_matrix_item_fp8(const float* W, int K, int N, unsigned char* WT, float scale, int item, LAS float* tile, int tid) {
    const int nbn = N / 128, kb = item / nbn, nb = item % nbn;
    tr128_fp8(W + (size_t)kb * 128 * N + nb * 128, N, WT + (size_t)nb * 128 * K + kb * 128, K, scale, tile, tid);
}

struct RgW { bf16x8 f[2][2][4]; };
__device__ __forceinline__ void rglru_load_w(const Params& p, int h, int lane, RgW& W) {
    const int r = lane & 31, hf = lane >> 5; const unsigned loff = (unsigned)(8 * hf * 64 + r);
#pragma unroll
    for (int gt = 0; gt < 2; ++gt) { const float* w = p.in[gt ? 7 : 5] + (size_t)h * 4096;
#pragma unroll
        for (int nn = 0; nn < 2; ++nn)
#pragma unroll
            for (int s = 0; s < 4; ++s) { float v[8];
#pragma unroll
                for (int j = 0; j < 8; ++j) v[j] = (w + (16 * s + j) * 64 + 32 * nn)[loff];
                u32x4 pk; pk.x = pk2(v[0], v[1]); pk.y = pk2(v[2], v[3]); pk.z = pk2(v[4], v[5]); pk.w = pk2(v[6], v[7]);
                W.f[gt][nn][s] = __builtin_bit_cast(bf16x8, pk); } }
}
template <int PASS>
__device__ __forceinline__ void rglru_item(const Params& p, int item, const RgW& W, LAS unsigned char* xcl, int lane) {
    const bf16* proj = (const bf16*)(p.ws + WS_PROJ);
    float* sumA = (float*)(p.ws + WS_SUMA); float* sumH = (float*)(p.ws + WS_SUMH);
    const int c = item % NCH, h = (item / NCH) % 16, b = item / (NCH * 16);
    const int r = lane & 31, hf = lane >> 5;
    const int chn = h * 64 + lane;
    const float cw0 = p.in[3][chn], cw1 = p.in[3][1024 + chn], cw2 = p.in[3][2048 + chn], cw3 = p.in[3][3072 + chn], cb = p.in[4][chn];
    float ba[2], bi[2], sp8[2], C[2], PT[2];
#pragma unroll
    for (int nn = 0; nn < 2; ++nn) { const int ch = h * 64 + 32 * nn + r; ba[nn] = p.in[6][ch]; bi[nn] = p.in[8][ch]; sp8[nn] = 8.0f * log1pf(expf(-p.in[9][ch])); C[nn] = 0.f; PT[nn] = 1.f; }
    if (PASS == 2) {
        for (int k = 0; k < c; ++k)
#pragma unroll
            for (int nn = 0; nn < 2; ++nn) { const size_t o = (size_t)(b * NCH + k) * D + h * 64 + 32 * nn + r; C[nn] = sumA[o] * C[nn] + sumH[o]; }
    }
    const int t0 = c * TCH;
    const bf16* xrb = proj + (size_t)(b * SEQ) * DIN + C_XR + h * 64;
    const bf16* grb = proj + (size_t)(b * SEQ) * DIN + C_GR + h * 64;
    LAS unsigned char* XR = xcl + 4608; LAS unsigned char* GR = xcl + 9216; LAS unsigned char* Y8 = XR;
    float xm3 = 0.f, xm2 = 0.f, xm1 = 0.f;
    if (t0 > 0) { xm3 = bf1((xrb + (size_t)(t0 - 3) * DIN)[lane]); xm2 = bf1((xrb + (size_t)(t0 - 2) * DIN)[lane]); xm1 = bf1((xrb + (size_t)(t0 - 1) * DIN)[lane]); }
    const unsigned lrow = (unsigned)(lane >> 3), lch = (unsigned)(lane & 7);
    u32x4 xrq[4], grq[4];
#pragma unroll
    for (int it = 0; it < 4; ++it) { xrq[it] = *(const u32x4*)(xrb + (size_t)(t0 + 8 * it) * DIN + lrow * DIN + lch * 8);
        if (PASS == 2) grq[it] = *(const u32x4*)(grb + (size_t)(t0 + 8 * it) * DIN + lrow * DIN + lch * 8); }
    for (int tile = 0; tile < TCH / 32; ++tile) {
        const int tt0 = t0 + tile * 32;
#pragma unroll
        for (int it = 0; it < 4; ++it) { *(LAS u32x4*)(XR + (8 * it + lrow) * 144 + lch * 16) = xrq[it]; if (PASS == 2) *(LAS u32x4*)(GR + (8 * it + lrow) * 144 + lch * 16) = grq[it]; }
        if (tile + 1 < TCH / 32) {
#pragma unroll
            for (int it = 0; it < 4; ++it) { xrq[it] = *(const u32x4*)(xrb + (size_t)(tt0 + 32 + 8 * it) * DIN + lrow * DIN + lch * 8);
                if (PASS == 2) grq[it] = *(const u32x4*)(grb + (size_t)(tt0 + 32 + 8 * it) * DIN + lrow * DIN + lch * 8); }
        }
        asm volatile("s_waitcnt lgkmcnt(0)" ::: "memory");
#pragma unroll
        for (int j = 0; j < 32; ++j) { const float x = bf1(*(const LAS bf16*)(XR + j * 144 + lane * 2)); const float xc = cb + cw0 * xm3 + cw1 * xm2 + cw2 * xm1 + cw3 * x; xm3 = xm2; xm2 = xm1; xm1 = x;
            *(LAS bf16*)(xcl + j * 144 + lane * 2) = (bf16)f2bf(xc); }
        asm volatile("s_waitcnt lgkmcnt(0)" ::: "memory");
        bf16x8 af[4];
#pragma unroll
        for (int s = 0; s < 4; ++s) af[s] = *(const LAS bf16x8*)(xcl + r * 144 + (16 * s + 8 * hf) * 2);
#pragma unroll
        for (int nn = 0; nn < 2; ++nn) {
            f32x16 ra, ri, xq;
#pragma unroll
            for (int i = 0; i < 16; ++i) { ra[i] = 0.f; ri[i] = 0.f; xq[i] = 0.f; }
#pragma unroll
            for (int s = 0; s < 4; ++s) { ra = __builtin_amdgcn_mfma_f32_32x32x16_bf16(af[s], W.f[0][nn][s], ra, 0, 0, 0); ri = __builtin_amdgcn_mfma_f32_32x32x16_bf16(af[s], W.f[1][nn][s], ri, 0, 0, 0); }
#pragma unroll
            for (int s2 = 0; s2 < 2; ++s2) { const int s = 2 * nn + s2; bf16x8 idf;
#pragma unroll
                for (int j = 0; j < 8; ++j) idf[j] = (16 * s + 8 * hf + j == 32 * nn + r) ? (short)0x3F80 : (short)0;
                xq = __builtin_amdgcn_mfma_f32_32x32x16_bf16(af[s], idf, xq, 0, 0, 0); }
            float av[16], uv[16];
#pragma unroll
            for (int i = 0; i < 16; ++i) {
                const float rg = 1.0f / (1.0f + __expf(-(ra[i] + ba[nn]))), ig = 1.0f / (1.0f + __expf(-(ri[i] + bi[nn])));
                const float la = -sp8[nn] * rg, a = __expf(la), x2 = 2.0f * la;
                const float om = (x2 > -0.06f) ? -x2 * (1.0f + x2 * (0.5f + x2 * (0.16666667f + x2 * 0.041666668f))) : 1.0f - __expf(x2);
                av[i] = a; uv[i] = sqrtf(om) * (ig * xq[i]); }
            float hl[16], pl[16];
#pragma unroll
            for (int q = 0; q < 4; ++q) { hl[4 * q] = uv[4 * q]; pl[4 * q] = av[4 * q];
#pragma unroll
                for (int j = 1; j < 4; ++j) { hl[4 * q + j] = av[4 * q + j] * hl[4 * q + j - 1] + uv[4 * q + j]; pl[4 * q + j] = pl[4 * q + j - 1] * av[4 * q + j]; } }
            float cin[4]; float Cc = C[nn];
#pragma unroll
            for (int s8 = 0; s8 < 8; ++s8) { const int q = s8 >> 1;
                const float cn = pl[4 * q + 3] * Cc + hl[4 * q + 3];
                if ((s8 & 1) == 0) { if (hf == 0) cin[q] = Cc; } else { if (hf == 1) cin[q] = Cc; }
                const unsigned cu = __builtin_bit_cast(unsigned, cn);
                auto sw = __builtin_amdgcn_permlane32_swap(cu, cu, false, false);
                Cc = __builtin_bit_cast(float, (s8 & 1) ? sw[1] : sw[0]); }
            C[nn] = Cc;
            if (PASS == 1) { float pp = pl[3] * pl[7] * pl[11] * pl[15]; const unsigned pu = __builtin_bit_cast(unsigned, pp);
                auto sw = __builtin_amdgcn_permlane32_swap(pu, pu, false, false); PT[nn] *= __builtin_bit_cast(float, sw[0]) * __builtin_bit_cast(float, sw[1]); }
            if (PASS == 2) {
#pragma unroll
                for (int i = 0; i < 16; ++i) { const int tok = (i & 3) + 8 * (i >> 2) + 4 * hf; const float hv = hl[i] + pl[i] * cin[i >> 2];
                    const float gg = bf1(*(const LAS bf16*)(GR + tok * 144 + (32 * nn + r) * 2));
                    const float yv = __builtin_amdgcn_fmed3f(hv * gg * 16.0f, -448.f, 448.f);
                    *(LAS unsigned char*)(Y8 + tok * 80 + 32 * nn + r) = (unsigned char)__builtin_amdgcn_cvt_pk_fp8_f32(yv, 0.f, 0, false); }
            }
        }
        if (PASS == 2) {
            asm volatile("s_waitcnt lgkmcnt(0)" ::: "memory");
            unsigned char* yb = p.ws + WS_YRNN + (size_t)(b * SEQ + tt0) * D + h * 64;
#pragma unroll
            for (int it = 0; it < 2; ++it) { const int row = (lane >> 2) + 16 * it; *(u32x4*)(yb + (size_t)row * D + (lane & 3) * 16) = *(const LAS u32x4*)(Y8 + row * 80 + (lane & 3) * 16); }
        }
        asm volatile("s_waitcnt lgkmcnt(0)" ::: "memory");
    }
    if (PASS == 1 && hf == 0) {
#pragma unroll
        for (int nn = 0; nn < 2; ++nn) { const size_t o = (size_t)(b * NCH + c) * D + h * 64 + 32 * nn + r; sumA[o] = PT[nn]; sumH[o] = C[nn]; }
    }
}

__device__ __forceinline__ void attn_item(const Params& p, int item, LAS unsigned char* vt, const LAS float* btab_all, int lane) {
    const bf16* proj = (const bf16*)(p.ws + WS_PROJ);
    const int rq = item & 127, bh = item >> 7, head = bh % 24, b = bh / 24;
    const int g = head >> 3, hh = head & 7, dil = (g == 0) ? 1 : (g == 1 ? 4 : 16), nqb = 128 / dil;
    const int res = rq / nqb, qb = rq % nqb, l0 = qb * 32;
    const int r = lane & 31, hf = lane >> 5;
    const LAS float* btab = btab_all + (g * 8 + hh) * 132;
    const size_t tokbase = (size_t)b * SEQ;
    bf16x8 qf[4];
    { const bf16* qp = proj + (tokbase + (size_t)(l0 + r) * dil + res) * DIN + C_Q + head * 64 + 8 * hf;
#pragma unroll
      for (int s = 0; s < 4; ++s) qf[s] = *(const bf16x8*)(qp + 16 * s); }
    f32x16 o0, o1;
#pragma unroll
    for (int i = 0; i < 16; ++i) { o0[i] = 0.f; o1[i] = 0.f; }
    float mrun = -1e30f, lrun = 0.f;
    const bf16* kvb = proj + (tokbase + res) * DIN + head * 64;
    const unsigned lk = (unsigned)(r * dil * DIN + C_K + 8 * hf);
    const unsigned lv0 = (unsigned)((2 * (lane >> 3)) * dil * DIN + C_V + 8 * (lane & 7));
    const int kt_first = (l0 >= 128) ? 0 : (128 - l0) / 32;
    bf16x8 kf[4], kfn[4]; u32x4 va[2][2], van[2][2];
    { const bf16* tb = kvb + (size_t)(l0 - 128 + 32 * kt_first) * dil * DIN;
#pragma unroll
      for (int s = 0; s < 4; ++s) kfn[s] = *(const bf16x8*)(tb + lk + 16 * s);
#pragma unroll
      for (int it = 0; it < 2; ++it)
#pragma unroll
          for (int e = 0; e < 2; ++e) van[it][e] = *(const u32x4*)(tb + (size_t)(16 * it + e) * dil * DIN + lv0); }
    for (int kt = kt_first; kt < 5; ++kt) {
        const int k0 = l0 - 128 + 32 * kt;
#pragma unroll
        for (int s = 0; s < 4; ++s) { kf[s] = kfn[s]; asm volatile("" : "+v"(kf[s])); }
#pragma unroll
        for (int it = 0; it < 2; ++it)
#pragma unroll
            for (int e = 0; e < 2; ++e) { va[it][e] = van[it][e]; asm volatile("" : "+v"(va[it][e])); }
        if (kt < 4) { const bf16* tb = kvb + (size_t)(k0 + 32) * dil * DIN;
#pragma unroll
            for (int s = 0; s < 4; ++s) kfn[s] = *(const bf16x8*)(tb + lk + 16 * s);
#pragma unroll
            for (int it = 0; it < 2; ++it)
#pragma unroll
                for (int e = 0; e < 2; ++e) van[it][e] = *(const u32x4*)(tb + (size_t)(16 * it + e) * dil * DIN + lv0); }
        f32x16 st;
#pragma unroll
        for (int i = 0; i < 16; ++i) st[i] = 0.f;
#pragma unroll
        for (int s = 0; s < 4; ++s) st = __builtin_amdgcn_mfma_f32_32x32x16_bf16(kf[s], qf[s], st, 0, 0, 0);
#pragma unroll
        for (int it = 0; it < 2; ++it) { const int kp2 = (lane >> 3) + 8 * it, dc = lane & 7;
#pragma unroll
            for (int w = 0; w < 4; ++w) { const unsigned a0 = va[it][0][w], a1 = va[it][1][w];
                *(LAS unsigned*)(vt + (8 * dc + 2 * w) * 72 + 4 * kp2) = (a0 & 0xffffu) | (a1 << 16);
                *(LAS unsigned*)(vt + (8 * dc + 2 * w + 1) * 72 + 4 * kp2) = (a0 >> 16) | (a1 & 0xffff0000u); } }
        float sv[16]; float mt = -1e30f;
        const int relb = (l0 + r) - k0 - 4 * hf;
        float bsv[16];
#pragma unroll
        for (int i = 0; i < 16; ++i) bsv[i] = btab[relb - ((i & 3) + 8 * (i >> 2))];
#pragma unroll
        for (int i = 0; i < 16; ++i) { const int rel = relb - ((i & 3) + 8 * (i >> 2));
            const bool ok = (unsigned)rel <= 128u;
            sv[i] = ok ? st[i] + bsv[i] : -1e30f; mt = fmaxf(mt, sv[i]); }
        mt = fmaxf(mt, __shfl_xor(mt, 32));
        const float mnew = fmaxf(mrun, mt), al = __expf(mrun - mnew);
        float ps = 0.f; float pv[16];
#pragma unroll
        for (int i = 0; i < 16; ++i) { pv[i] = __expf(sv[i] - mnew); ps += pv[i]; }
        lrun = lrun * al + ps; mrun = mnew;
#pragma unroll
        for (int i = 0; i < 16; ++i) { o0[i] *= al; o1[i] *= al; }
        bf16x8 pf[2];
#pragma unroll
        for (int s = 0; s < 2; ++s) { u32x4 w; w.x = pg8::cvt_pk_bf16(pv[8 * s], pv[8 * s + 1]); w.y = pg8::cvt_pk_bf16(pv[8 * s + 2], pv[8 * s + 3]); w.z = pg8::cvt_pk_bf16(pv[8 * s + 4], pv[8 * s + 5]); w.w = pg8::cvt_pk_bf16(pv[8 * s + 6], pv[8 * s + 7]);
            pf[s] = __builtin_bit_cast(bf16x8, w); }
        asm volatile("s_waitcnt lgkmcnt(0)" ::: "memory");
#pragma unroll
        for (int s = 0; s < 2; ++s) {
            { const LAS unsigned char* q = vt + (r) * 72 + (16 * s + 4 * hf) * 2; u32x4 w; const u32x2 lo = *(const LAS u32x2*)q, hi = *(const LAS u32x2*)(q + 16); w.x = lo.x; w.y = lo.y; w.z = hi.x; w.w = hi.y;
              o0 = __builtin_amdgcn_mfma_f32_32x32x16_bf16(__builtin_bit_cast(bf16x8, w), pf[s], o0, 0, 0, 0); }
            { const LAS unsigned char* q = vt + (32 + r) * 72 + (16 * s + 4 * hf) * 2; u32x4 w; const u32x2 lo = *(const LAS u32x2*)q, hi = *(const LAS u32x2*)(q + 16); w.x = lo.x; w.y = lo.y; w.z = hi.x; w.w = hi.y;
              o1 = __builtin_amdgcn_mfma_f32_32x32x16_bf16(__builtin_bit_cast(bf16x8, w), pf[s], o1, 0, 0, 0); }
        }
        asm volatile("s_waitcnt lgkmcnt(0)" ::: "memory");
    }
    const float ltot = lrun + __shfl_xor(lrun, 32), inv = 1.0f / ltot;
    const size_t tok = tokbase + (size_t)(l0 + r) * dil + res;
    bf16* ao = (bf16*)(p.ws + WS_AO) + ((size_t)g * T + tok) * 512 + hh * 64;
#pragma unroll
    for (int q4 = 0; q4 < 4; ++q4) {
        u32x2 w; w.x = pk2(o0[4 * q4] * inv, o0[4 * q4 + 1] * inv); w.y = pk2(o0[4 * q4 + 2] * inv, o0[4 * q4 + 3] * inv);
        *(u32x2*)(ao + 8 * q4 + 4 * hf) = w;
        u32x2 w1; w1.x = pk2(o1[4 * q4] * inv, o1[4 * q4 + 1] * inv); w1.y = pk2(o1[4 * q4 + 2] * inv, o1[4 * q4 + 3] * inv);
        *(u32x2*)(ao + 32 + 8 * q4 + 4 * hf) = w1;
    }
    if (hf == 0) ((float*)(p.ws + WS_LSE))[((size_t)g * T + tok) * 8 + hh] = mrun + __logf(ltot);
}

constexpr int AT_KPITCH = 144, AT_VPITCH = 776, AT_VOFF = 12 * 32 * AT_KPITCH;
struct AtItem { int head, b, g, hh, dil, res, l0g, jmin; };
__device__ __forceinline__ AtItem at_decode(int item) {
    AtItem a; const int grp = item & 15, bh = item >> 4; a.head = bh % 24; a.b = bh / 24; a.g = a.head >> 3; a.hh = a.head & 7; a.dil = (a.g == 0) ? 1 : (a.g == 1 ? 4 : 16);
    const int nqb = 128 / a.dil, rq0 = grp * 8; a.res = rq0 / nqb; a.l0g = (rq0 % nqb) * 32; a.jmin = (a.l0g >= 128) ? 0 : (128 - a.l0g) / 32; return a;
}
__device__ __forceinline__ void at_load(const Params& p, const AtItem& a, int wave, int lane, u32x4 (&kq)[2][4], u32x4 (&vq)[2][4]) {
    const bf16* kvb = (const bf16*)(p.ws + WS_PROJ) + ((size_t)a.b * SEQ + a.res) * DIN + a.head * 64;
    const unsigned lk = (unsigned)((lane >> 3) * a.dil * DIN + C_K + 8 * (lane & 7));
    const unsigned lv0 = (unsigned)((2 * (lane >> 3)) * a.dil * DIN + C_V + 8 * (lane & 7));
#pragma unroll
    for (int tt = 0; tt < 2; ++tt) { const int j = wave + 8 * tt;
        if (j < 12 && j >= a.jmin) { const bf16* tb = kvb + (size_t)(a.l0g - 128 + 32 * j) * a.dil * DIN;
#pragma unroll
            for (int it = 0; it < 4; ++it) kq[tt][it] = *(const u32x4*)(tb + (size_t)(8 * it) * a.dil * DIN + lk);
#pragma unroll
            for (int it = 0; it < 2; ++it)
#pragma unroll
                for (int e = 0; e < 2; ++e) vq[tt][2 * it + e] = *(const u32x4*)(tb + (size_t)(16 * it + e) * a.dil * DIN + lv0); } }
}
__device__ __forceinline__ void at_write(const AtItem& a, int wave, int lane, LAS unsigned char* Kl, LAS unsigned char* Vl, const u32x4 (&kq)[2][4], const u32x4 (&vq)[2][4]) {
#pragma unroll
    for (int tt = 0; tt < 2; ++tt) { const int j = wave + 8 * tt;
        if (j < 12 && j >= a.jmin) {
#pragma unroll
            for (int it = 0; it < 4; ++it) *(LAS u32x4*)(Kl + (32 * j + 8 * it + (lane >> 3)) * AT_KPITCH + (lane & 7) * 16) = kq[tt][it];
#pragma unroll
            for (int it = 0; it < 2; ++it) { const int kp2 = (lane >> 3) + 8 * it, dc = lane & 7;
#pragma unroll
                for (int w = 0; w < 4; ++w) { const unsigned a0 = vq[tt][2 * it][w], a1 = vq[tt][2 * it + 1][w];
                    *(LAS unsigned*)(Vl + (8 * dc + 2 * w) * AT_VPITCH + (32 * j + 2 * kp2) * 2) = (a0 & 0xffffu) | (a1 << 16);
                    *(LAS unsigned*)(Vl + (8 * dc + 2 * w + 1) * AT_VPITCH + (32 * j + 2 * kp2) * 2) = (a0 >> 16) | (a1 & 0xffff0000u); } } } }
}
__device__ __forceinline__ void attn_block_phase(const Params& p, LAS unsigned char* lds, const LAS float* btab_all, int wave, int lane, int bid, int G, int nitems) {
  const bf16* proj = (const bf16*)(p.ws + WS_PROJ);
  LAS unsigned char* Kl = lds; LAS unsigned char* Vl = lds + AT_VOFF;
  const int r = lane & 31, hf = lane >> 5;
  u32x4 kq[2][4], vq[2][4]; bf16x8 qn[4];
#define AT_LOADQ(a_) do { const bf16* _qp = proj + ((size_t)(a_).b * SEQ + (size_t)((a_).l0g + 32 * wave + r) * (a_).dil + (a_).res) * DIN + C_Q + (a_).head * 64 + 8 * hf; \
        _Pragma("unroll") for (int _s = 0; _s < 4; ++_s) qn[_s] = *(const bf16x8*)(_qp + 16 * _s); } while (0)
  if (bid < nitems) { const AtItem a0 = at_decode(bid); AT_LOADQ(a0); at_load(p, a0, wave, lane, kq, vq); }
  for (int item = bid; item < nitems; item += G) {
    const AtItem a = at_decode(item);
    const int head = a.head, g = a.g, hh = a.hh, dil = a.dil, res = a.res, l0g = a.l0g;
    const LAS float* btab = btab_all + (g * 8 + hh) * 132;
    const size_t tokbase = (size_t)a.b * SEQ;
    at_write(a, wave, lane, Kl, Vl, kq, vq);
    const int l0 = l0g + 32 * wave;
    bf16x8 qf[4];
#pragma unroll
    for (int s = 0; s < 4; ++s) { qf[s] = qn[s]; asm volatile("" : "+v"(qf[s])); }
    if (item + G < nitems) { const AtItem an = at_decode(item + G); AT_LOADQ(an); at_load(p, an, wave, lane, kq, vq); }
    asm volatile("s_waitcnt lgkmcnt(0)" ::: "memory"); __builtin_amdgcn_s_barrier(); asm volatile("" ::: "memory");
    f32x16 o0, o1;
#pragma unroll
    for (int i = 0; i < 16; ++i) { o0[i] = 0.f; o1[i] = 0.f; }
    float mrun = -1e30f, lrun = 0.f;
    const int kt_first = (l0 >= 128) ? 0 : (128 - l0) / 32;
    for (int kt = kt_first; kt < 5; ++kt) {
        const int j = wave + kt, k0 = l0 - 128 + 32 * kt;
        bf16x8 kf[4];
#pragma unroll
        for (int s = 0; s < 4; ++s) kf[s] = *(const LAS bf16x8*)(Kl + (32 * j + r) * AT_KPITCH + (16 * s + 8 * hf) * 2);
        const int relb = (l0 + r) - k0 - 4 * hf;
        float bsv[16];
#pragma unroll
        for (int i = 0; i < 16; ++i) bsv[i] = btab[relb - ((i & 3) + 8 * (i >> 2))];
        f32x16 st;
#pragma unroll
        for (int i = 0; i < 16; ++i) st[i] = 0.f;
#pragma unroll
        for (int s = 0; s < 4; ++s) st = __builtin_amdgcn_mfma_f32_32x32x16_bf16(kf[s], qf[s], st, 0, 0, 0);
        u32x4 vf[2][2];
#pragma unroll
        for (int s = 0; s < 2; ++s)
#pragma unroll
            for (int dt = 0; dt < 2; ++dt) { const LAS unsigned char* q = Vl + (32 * dt + r) * AT_VPITCH + (32 * j + 16 * s + 4 * hf) * 2; const u32x2 lo = *(const LAS u32x2*)q, hi = *(const LAS u32x2*)(q + 16);
                vf[s][dt] = (u32x4){lo.x, lo.y, hi.x, hi.y}; }
        float sv[16]; float mt = -1e30f;
#pragma unroll
        for (int i = 0; i < 16; ++i) { const int rel = relb - ((i & 3) + 8 * (i >> 2)); const bool ok = (unsigned)rel <= 128u; sv[i] = ok ? st[i] + bsv[i] : -1e30f; mt = fmaxf(mt, sv[i]); }
        mt = fmaxf(mt, __shfl_xor(mt, 32));
        const float mnew = fmaxf(mrun, mt), al = __expf(mrun - mnew);
        float ps = 0.f; float pv[16];
#pragma unroll
        for (int i = 0; i < 16; ++i) { pv[i] = __expf(sv[i] - mnew); ps += pv[i]; }
        lrun = lrun * al + ps; mrun = mnew;
#pragma unroll
        for (int i = 0; i < 16; ++i) { o0[i] *= al; o1[i] *= al; }
#pragma unroll
        for (int s = 0; s < 2; ++s) { u32x4 w; w.x = pg8::cvt_pk_bf16(pv[8 * s], pv[8 * s + 1]); w.y = pg8::cvt_pk_bf16(pv[8 * s + 2], pv[8 * s + 3]); w.z = pg8::cvt_pk_bf16(pv[8 * s + 4], pv[8 * s + 5]); w.w = pg8::cvt_pk_bf16(pv[8 * s + 6], pv[8 * s + 7]);
            const bf16x8 pf = __builtin_bit_cast(bf16x8, w);
            o0 = __builtin_amdgcn_mfma_f32_32x32x16_bf16(__builtin_bit_cast(bf16x8, vf[s][0]), pf, o0, 0, 0, 0);
            o1 = __builtin_amdgcn_mfma_f32_32x32x16_bf16(__builtin_bit_cast(bf16x8, vf[s][1]), pf, o1, 0, 0, 0); }
    }
    const float ltot = lrun + __shfl_xor(lrun, 32), inv = 1.0f / ltot;
    const size_t tok = tokbase + (size_t)(l0 + r) * dil + res;
    bf16* ao = (bf16*)(p.ws + WS_AO) + ((size_t)g * T + tok) * 512 + hh * 64;
#pragma unroll
    for (int q4 = 0; q4 < 4; ++q4) {
        u32x2 w; w.x = pk2(o0[4 * q4] * inv, o0[4 * q4 + 1] * inv); w.y = pk2(o0[4 * q4 + 2] * inv, o0[4 * q4 + 3] * inv);
        *(u32x2*)(ao + 8 * q4 + 4 * hf) = w;
        u32x2 w1; w1.x = pk2(o1[4 * q4] * inv, o1[4 * q4 + 1] * inv); w1.y = pk2(o1[4 * q4 + 2] * inv, o1[4 * q4 + 3] * inv);
        *(u32x2*)(ao + 32 + 8 * q4 + 4 * hf) = w1;
    }
    if (hf == 0) ((float*)(p.ws + WS_LSE))[((size_t)g * T + tok) * 8 + hh] = mrun + __logf(ltot);
    asm volatile("s_waitcnt lgkmcnt(0)" ::: "memory"); __builtin_amdgcn_s_barrier(); asm volatile("" ::: "memory");
  }
}

__device__ __forceinline__ void build_tile_table(const LAS unsigned* lcnt, LAS unsigned char* lds, int tid) {
    LAS int* tbase = (LAS int*)(lds + L_TBASE); LAS unsigned short* tile_e = (LAS unsigned short*)(lds + L_TILEE);
    __syncthreads();
    if (tid < 64) { int n[4], s = 0;
#pragma unroll
        for (int j = 0; j < 4; ++j) { n[j] = ((int)lcnt[4 * tid + j] + 255) >> 8; s += n[j]; }
        int incl = s;
#pragma unroll
        for (int o = 1; o < 64; o <<= 1) { const int v = __shfl_up(incl, o); if (tid >= o) incl += v; }
        int ex = incl - s;
#pragma unroll
        for (int j = 0; j < 4; ++j) { tbase[4 * tid + j] = ex; ex += n[j]; }
        if (tid == 63) { tbase[NE] = incl; tbase[NE + 1] = incl + SH_TILES; } }
    __syncthreads();
    if (tid < NE) { const int a = tbase[tid], bnd = tbase[tid + 1]; for (int i = a; i < bnd; ++i) tile_e[i] = (unsigned short)tid; }
    if (tid < SH_TILES) tile_e[tbase[NE] + tid] = (unsigned short)NE;
    __syncthreads();
}
__device__ __forceinline__ void build_tile_table_g(const Params& p, LAS unsigned char* lds, int tid) {
    LAS unsigned* lc = (LAS unsigned*)(lds + L_LCNT);
    const unsigned* cnt = (const unsigned*)(p.ws + WS_CTL) + CW_CNT;
    if (tid < NE) lc[tid] = cnt[tid];
    build_tile_table(lc, lds, tid);
}

__global__ void __launch_bounds__(512, 2) fwd_kernel(Params p) {
    extern __shared__ __attribute__((aligned(16))) unsigned char lds_raw[];
    LAS unsigned char* lds = (LAS unsigned char*)lds_raw;
    const int tid = threadIdx.x, lane = tid & 63, wave = __builtin_amdgcn_readfirstlane(tid >> 6);
    const int G = gridDim.x, bid = blockIdx.x;
    const int gw = bid * 8 + wave, NGW = G * 8;
    const size_t gtid = (size_t)bid * 512 + tid, NTH = (size_t)G * 512;
    unsigned char* ws = p.ws;
    volatile LAS unsigned* misc = (volatile LAS unsigned*)(lds + L_MISC);
    if (tid < 16) misc[tid] = 0u;
    { LAS float* bt = (LAS float*)(lds + L_BTAB);
      for (int i = tid; i < 3 * 8 * 132; i += 512) { const int g = i / (8 * 132), hh = (i / 132) % 8, rel = i % 132; bt[i] = (rel <= 128) ? p.in[12][(int)p.bucket[g][rel] * 24 + g * 8 + hh] : 0.f; } }
    __syncthreads();
#if N_LAUNCHES == 1
    XcdBarrier bar = xcd_barrier_post((unsigned*)(ws + WS_CTL) + CW_BAR, misc, tid == 0);
#define GRID_BAR() xcd_barrier(bar, wave == 0 && lane_id() == 0)
#else
#define GRID_BAR() do { } while (0)
#endif
    const int lo = p.lo, hi = p.hi;
#define IN(k) (lo <= (k) && (k) < hi)
#define SEAM(k) do { if (IN(k) && IN((k) + 1)) GRID_BAR(); STAMP((k) + 1); } while (0)
#define STAMP(k) do { if (PROBE_PHASE >= 100 && wave == 0 && lane_id() == 0) ((volatile LAS unsigned*)(lds + L_STAMP))[(k)] = (unsigned)__builtin_amdgcn_s_memrealtime(); } while (0)
#ifndef PROBE_PHASE
#define PROBE_PHASE -1
#endif
#define REPS(k) for (int _rep = 0; _rep < ((PROBE_PHASE == (k)) ? 2 : 1); ++_rep)
#define REP_BAR() do { if (_rep) GRID_BAR(); } while (0)
#define PHASE_LOCALS const int lane = lane_id(), tid = wave * 64 + lane; const size_t gtid = (size_t)bid * 512 + tid; (void)lane; (void)gtid;

    STAMP(0);
    if (IN(0)) REPS(0) { REP_BAR(); PHASE_LOCALS
        LAS float* tile = (LAS float*)lds;
        for (int it = bid; it < 720; it += G) {
            int r = it;
            if (r < 544) { tr_matrix_item_fp8(p.in[1], 1024, DIN, ws + WS_WINT, 32.f, r, tile, tid); continue; } r -= 544;
            if (r < 64) { tr_matrix_item_fp8(p.in[10], 1024, 1024, ws + WS_WPRT, 32.f, r, tile, tid); continue; } r -= 64;
            if (r < 32) { tr_matrix_item_fp8(p.in[11], 512, 1024, ws + WS_WPAT, 32.f, r, tile, tid); continue; } r -= 32;
            if (r < 64) { tr_matrix_item_fp8(p.in[13], 1024, 1024, ws + WS_WOT, 32.f, r, tile, tid); continue; } r -= 64;
            tr_matrix_item(p.in[16], 1024, 256, (bf16*)(ws + WS_WRT), r, tile, tid);
        }
        const f32x4* x4 = (const f32x4*)p.in[0]; u32x4* xb = (u32x4*)(ws + WS_XB);
        for (size_t i = gtid; i < (size_t)T * D / 16; i += NTH) { const f32x4 a = x4[4 * i], b = x4[4 * i + 1], c = x4[4 * i + 2], d = x4[4 * i + 3];
            u32x4 o; o.x = pk_fp8x4(a[0], a[1], a[2], a[3]); o.y = pk_fp8x4(b[0], b[1], b[2], b[3]); o.z = pk_fp8x4(c[0], c[1], c[2], c[3]); o.w = pk_fp8x4(d[0], d[1], d[2], d[3]); xb[i] = o; }
    }
    SEAM(0);
    if (IN(1)) REPS(1) { REP_BAR(); PHASE_LOCALS
        pg8::Gemm g{(const bf16*)(ws + WS_XB), (const bf16*)(ws + WS_WINT), 512, 0x7A7A7A7A, 0x7F7F7F7F}; pg8::StaticOrder S; S.init(T, DIN, G, bid);
        pg8::EpiInProj E{(bf16*)(ws + WS_PROJ), p.in[2], 1.0f / 32.0f};
        pg8::gemm_phase<pg8::EpiInProj, pg8::StaticOrder, true, true>(lds, g, S, E, wave);
    }
    SEAM(1);
    if (IN(2)) REPS(2) { REP_BAR(); PHASE_LOCALS
        LAS unsigned char* vt = lds + wave * 14336;
        for (int rr = 0; rr < (PROBE_PHASE == 20 ? 2 : 1); ++rr)
        { RgW W; int hprev = -1;
          for (int it = gw; it < NB * 16 * NCH; it += NGW) { const int h = (it / NCH) % 16; if (h != hprev) { rglru_load_w(p, h, lane, W); hprev = h; } rglru_item<1>(p, it, W, vt, lane); } }
        const LAS float* bt = (const LAS float*)(lds + L_BTAB);
        __syncthreads();
        for (int rr = 0; rr < (PROBE_PHASE == 21 ? 2 : 1); ++rr)
        attn_block_phase(p, lds, bt, wave, lane, bid, G, NB * 24 * 16);
    }
    SEAM(2);
    if (IN(3)) REPS(3) { REP_BAR(); PHASE_LOCALS
        for (int rr = 0; rr < (PROBE_PHASE == 30 ? 2 : 1); ++rr)
        { RgW W; int hprev = -1; LAS unsigned char* xcl = lds + wave * 14336;
          for (int it = gw; it < NB * 16 * NCH; it += NGW) { const int h = (it / NCH) % 16; if (h != hprev) { rglru_load_w(p, h, lane, W); hprev = h; } rglru_item<2>(p, it, W, xcl, lane); } }
        const bf16* ao = (const bf16*)(ws + WS_AO); const float* lse = (const float*)(ws + WS_LSE); bf16* yatt = (bf16*)(ws + WS_YATT);
        for (int rr = 0; rr < (PROBE_PHASE == 31 ? 2 : 1); ++rr)
        for (size_t i = gtid; i < (size_t)T * 64; i += NTH) { const size_t t = i >> 6; const int c8 = (int)(i & 63), hh = c8 >> 3;
            const float l0 = lse[t * 8 + hh], l1 = lse[((size_t)T + t) * 8 + hh], l2 = lse[((size_t)2 * T + t) * 8 + hh];
            const float mx = fmaxf(l0, fmaxf(l1, l2)); float w0 = __expf(l0 - mx), w1 = __expf(l1 - mx), w2 = __expf(l2 - mx); const float inv = 1.0f / (w0 + w1 + w2); w0 *= inv; w1 *= inv; w2 *= inv;
            const u32x4 a = *(const u32x4*)(ao + t * 512 + c8 * 8), bq = *(const u32x4*)(ao + ((size_t)T + t) * 512 + c8 * 8), cq = *(const u32x4*)(ao + ((size_t)2 * T + t) * 512 + c8 * 8);
            float yv[8];
#pragma unroll
            for (int w = 0; w < 4; ++w) { yv[2 * w] = 16.0f * (w0 * bflo(a[w]) + w1 * bflo(bq[w]) + w2 * bflo(cq[w])); yv[2 * w + 1] = 16.0f * (w0 * bfhi(a[w]) + w1 * bfhi(bq[w]) + w2 * bfhi(cq[w])); }
            u32x2 o; o.x = pk_fp8x4(yv[0], yv[1], yv[2], yv[3]); o.y = pk_fp8x4(yv[4], yv[5], yv[6], yv[7]);
            *(u32x2*)((unsigned char*)yatt + t * 512 + c8 * 8) = o; }
    }
    SEAM(3);
    if (IN(4)) REPS(4) { REP_BAR(); PHASE_LOCALS
        pg8::StaticOrder S; S.init(T, D, G, bid);
        { pg8::Gemm g{(const bf16*)(ws + WS_YRNN), (const bf16*)(ws + WS_WPRT), 512, 0, 0};
          pg8::EpiProjRnn E{(const bf16*)(ws + WS_PROJ), p.out, 1.0f / 512.0f};
          pg8::gemm_phase<pg8::EpiProjRnn, pg8::StaticOrder, true, true>(lds, g, S, E, wave); }
        asm volatile("s_waitcnt vmcnt(0)" ::: "memory"); __syncthreads();
        { pg8::Gemm g{(const bf16*)(ws + WS_YATT), (const bf16*)(ws + WS_WPAT), 256, 0, 0};
          pg8::EpiProjAtt E{(const bf16*)(ws + WS_PROJ), p.out, ws + WS_MERGED, 1.0f / 512.0f};
          pg8::gemm_phase<pg8::EpiProjAtt, pg8::StaticOrder, true, true>(lds, g, S, E, wave); }
    }
    SEAM(4);
    if (IN(5)) REPS(5) { REP_BAR(); PHASE_LOCALS
        pg8::Gemm g{(const bf16*)(ws + WS_MERGED), (const bf16*)(ws + WS_WOT), 512, 0, 0}; pg8::StaticOrder S; S.init(T, D, G, bid);
        pg8::EpiF32Res E{p.in[0], (float*)(ws + WS_PRELN), D, ALPHA, 1.0f / 512.0f};
        pg8::gemm_phase<pg8::EpiF32Res, pg8::StaticOrder, true, true>(lds, g, S, E, wave);
    }
    SEAM(5);
    if (IN(6)) REPS(6) { REP_BAR(); PHASE_LOCALS
        const float* preln = (const float*)(ws + WS_PRELN); bf16* x1b = (bf16*)(ws + WS_X1B);
        for (int row = gw; row < T; row += NGW) {
            const f32x4* xr = (const f32x4*)(preln + (size_t)row * D) + lane; f32x4 v[4]; float s = 0.f;
#pragma unroll
            for (int j = 0; j < 4; ++j) { v[j] = xr[64 * j]; s += (v[j][0] + v[j][1]) + (v[j][2] + v[j][3]); }
            const float mean = wave_sum(s) * (1.f / D); float s2 = 0.f;
#pragma unroll
            for (int j = 0; j < 4; ++j) { v[j] = v[j] - mean; s2 += (v[j][0] * v[j][0] + v[j][1] * v[j][1]) + (v[j][2] * v[j][2] + v[j][3] * v[j][3]); }
            const float rstd = 1.f / sqrtf(wave_sum(s2) * (1.f / D) + LN_EPS);
#pragma unroll
            for (int j = 0; j < 4; ++j) { const f32x4 gm = ((const f32x4*)p.in[14])[lane + 64 * j], bt = ((const f32x4*)p.in[15])[lane + 64 * j];
                const f32x4 o = v[j] * rstd * gm + bt;
                ((f32x4*)(p.out + (size_t)row * D))[lane + 64 * j] = o;
                u32x2 w; w.x = pk2(o[0], o[1]); w.y = pk2(o[2], o[3]); ((u32x2*)(x1b + (size_t)row * D))[lane + 64 * j] = w;
                ((unsigned*)(ws + WS_X1B8 + (size_t)row * D))[lane + 64 * j] = pk_fp8x4(o[0], o[1], o[2], o[3]); }
        }
        __syncthreads();
        LAS float* tile = (LAS float*)lds;
        for (int it = bid; it < 257 * 48; it += G) {
            const int e = it / 48, r = it % 48;
            if (r < 32) { const int up = r >> 4, q = r & 15, kb = q >> 1, nbk = q & 1;
                const float* W = (e < NE) ? p.in[up ? 19 : 18] + (size_t)e * 1024 * 256 : p.in[up ? 22 : 21];
                tr128_fp8(W + (size_t)kb * 128 * 256 + nbk * 128, 256, ws + WS_WGU + ((size_t)e * 512 + nbk * 256 + up * 128) * 1024 + kb * 128, 1024, 32.f, tile, tid);
            } else { const int q = r - 32, kb = q >> 3, nb = q & 7;
                const float* W = (e < NE) ? p.in[20] + (size_t)e * 256 * 1024 : p.in[23];
                tr128(W + (size_t)kb * 128 * 1024 + nb * 128, 1024, (bf16*)(ws + WS_WD) + ((size_t)e * 1024 + nb * 128) * 256 + kb * 128, 256, tile, tid); }
        }
    }
    SEAM(6);
    if (IN(7)) REPS(7) { REP_BAR(); PHASE_LOCALS
        pg8::Gemm g{(const bf16*)(ws + WS_X1B), (const bf16*)(ws + WS_WRT), 1024, 0x7F7F7F7F, 0x7F7F7F7F}; pg8::StaticOrder S; S.init(T, NE, G, bid);
        pg8::EpiF32Res E{nullptr, (float*)(ws + WS_LOGITS), NE, 0.f, 1.0f};
        pg8::gemm_phase<pg8::EpiF32Res, pg8::StaticOrder, true>(lds, g, S, E, wave);
      { pg8::Unit ru; const bool has_unit = S.next(0, ru); const int tok0 = has_unit ? ru.pm * 256 : 0;
        const float* logits = (const float*)(ws + WS_LOGITS); LAS unsigned* lcnt = (LAS unsigned*)(lds + L_LCNT);
        __syncthreads(); if (tid < NE) lcnt[tid] = 0u; __syncthreads();
        int* eidx = (int*)(ws + WS_EIDX); float* gatew = (float*)(ws + WS_GATEW); int* rank = (int*)(ws + WS_RANK);
        const int g = lane & 7, tk = lane >> 3;
        float rb[32];
#pragma unroll
        for (int q = 0; q < 8; ++q) { const f32x4 r4 = ((const f32x4*)p.in[17])[g * 8 + q]; rb[4 * q] = r4[0]; rb[4 * q + 1] = r4[1]; rb[4 * q + 2] = r4[2]; rb[4 * q + 3] = r4[3]; }
        for (int task = wave; task < (has_unit ? 32 : 0); task += 8) {
            const int t = tok0 + task * 8 + tk;
            const f32x4* z4 = (const f32x4*)(logits + (size_t)t * NE + g * 32);
            f32x4 zz[8];
#pragma unroll
            for (int q = 0; q < 8; ++q) zz[q] = z4[q];
            float sc[32], sel[32];
#pragma unroll
            for (int j = 0; j < 32; ++j) { sc[j] = 1.0f / (1.0f + __expf(-zz[j >> 2][j & 3])); sel[j] = sc[j] + rb[j]; }
            float m1 = fmaxf(sel[0], sel[1]), m2 = fminf(sel[0], sel[1]);
#pragma unroll
            for (int j = 2; j < 32; ++j) { const float v = sel[j]; m2 = fmaxf(m2, fminf(m1, v)); m1 = fmaxf(m1, v); }
            const float gs = m1 + m2; int rk = 0;
#pragma unroll
            for (int g3 = 0; g3 < 8; ++g3) { const float og = __shfl(gs, (lane & ~7) + g3); rk += (og > gs || (og == gs && g3 < g)) ? 1 : 0; }
            if (rk >= 4) {
#pragma unroll
                for (int j = 0; j < 32; ++j) sel[j] = -INFINITY;
            }
            int me = 0; float ms = 0.f, gsum = 0.f;
#pragma unroll
            for (int k = 0; k < 8; ++k) {
                float bv = sel[0], bs = sc[0]; int bj = 0;
#pragma unroll
                for (int j = 1; j < 32; ++j) { const bool gt = sel[j] > bv; bv = gt ? sel[j] : bv; bs = gt ? sc[j] : bs; bj = gt ? j : bj; }
                int bi = g * 32 + bj;
#pragma unroll
                for (int o = 1; o < 8; o <<= 1) { const float ov = __shfl_xor(bv, o), os = __shfl_xor(bs, o); const int oi = __shfl_xor(bi, o);
                    const bool tk2 = (ov > bv) || (ov == bv && oi < bi); bv = tk2 ? ov : bv; bs = tk2 ? os : bs; bi = tk2 ? oi : bi; }
                const bool own = (bi >> 5) == g; const int jj = bi & 31;
#pragma unroll
                for (int j = 0; j < 32; ++j) sel[j] = (own && j == jj) ? -INFINITY : sel[j];
                gsum += bs; if (g == k) { me = bi; ms = bs; }
            }
            const int rr = (int)__hip_atomic_fetch_add(&lcnt[me], 1u, __ATOMIC_RELAXED, __HIP_MEMORY_SCOPE_WORKGROUP);
            const size_t q = (size_t)t * 8 + g;
            eidx[q] = me; gatew[q] = ms * 2.5f / gsum; rank[q] = rr;
        }
        __syncthreads();
        if (tid < NE) ((unsigned*)(ws + WS_HIST))[(size_t)bid * NE + tid] = lcnt[tid];
      }
    }
    SEAM(7);
    if (IN(9)) REPS(9) { REP_BAR(); PHASE_LOCALS
        LAS unsigned* lcnt = (LAS unsigned*)(lds + L_LCNT); LAS unsigned* bbase = (LAS unsigned*)(lds + L_BBASE);
        __syncthreads();
        { const u32x4* hist4 = (const u32x4*)(ws + WS_HIST); const int e4 = tid & 63, part = tid >> 6; u32x4 tot = (u32x4){0u, 0u, 0u, 0u}, bs = tot;
          const int per = (G + 7) / 8, b0 = part * per, b1 = (b0 + per < G) ? b0 + per : G;
#pragma unroll 8
          for (int b = b0; b < b1; ++b) { const u32x4 v = hist4[(size_t)b * 64 + e4]; tot += v; if (b < bid) bs += v; }
          LAS u32x4* pt = (LAS u32x4*)lds; pt[part * 64 + e4] = tot; pt[512 + part * 64 + e4] = bs; }
        __syncthreads();
        if (tid < NE) { const LAS unsigned* pw = (const LAS unsigned*)lds; unsigned tot = 0u, bs = 0u;
#pragma unroll
            for (int pp = 0; pp < 8; ++pp) { tot += pw[pp * 256 + tid]; bs += pw[2048 + pp * 256 + tid]; }
            lcnt[tid] = tot; bbase[tid] = bs; if (bid == 0) ((unsigned*)(ws + WS_CTL))[CW_CNT + tid] = tot; }
        build_tile_table(lcnt, lds, tid);
        const LAS int* tbase = (const LAS int*)(lds + L_TBASE);
        const int* eidx = (const int*)(ws + WS_EIDX); const float* gatew = (const float*)(ws + WS_GATEW); const int* rank = (const int*)(ws + WS_RANK);
        int* slotof = (int*)(ws + WS_SLOTOF); int* tokslot = (int*)(ws + WS_TOKSLOT); float* wslot = (float*)(ws + WS_WSLOT);
        pg8::StaticOrder RS; RS.init(T, NE, G, bid); pg8::Unit ru; const bool has_unit = RS.next(0, ru);
        for (int task = wave; task < (has_unit ? 32 : 0); task += 8) {
            const int t = ru.pm * 256 + task * 8 + (lane >> 3); const size_t q = (size_t)t * 8 + (lane & 7);
            const int e = eidx[q]; const int slot = tbase[e] * 256 + (int)bbase[e] + rank[q]; tokslot[slot] = t; wslot[slot] = gatew[q]; slotof[q] = slot; }
        for (size_t i = gtid; i < (size_t)NE * 256; i += NTH) { const int e = (int)(i >> 8), j = (int)(i & 255); const int s = (int)lcnt[e] + j; if (s < (tbase[e + 1] - tbase[e]) * 256) { tokslot[tbase[e] * 256 + s] = 0; wslot[tbase[e] * 256 + s] = 0.f; } }
        const int sb = tbase[NE] * 256;
        for (size_t i = gtid; i < (size_t)T; i += NTH) { tokslot[sb + i] = (int)i; }
    }
    SEAM(9);
    if (IN(10)) REPS(10) { REP_BAR(); PHASE_LOCALS
        build_tile_table_g(p, lds, tid);
        const LAS int* tbase = (const LAS int*)(lds + L_TBASE);
        pg8::GroupOrder<true> S; S.nN = 2; S.nwg = tbase[NE + 1] * 2; S.G = G; S.c = bid; S.tile_e = (const LAS unsigned short*)(lds + L_TILEE); S.tok = (const int*)(ws + WS_TOKSLOT); S.rowbytes = 1024u;
        pg8::Gemm g{(const bf16*)(ws + WS_X1B8), (const bf16*)(ws + WS_WGU), 512, 0, 0};
        pg8::EpiGateUp E{(bf16*)(ws + WS_H), 1.0f / 32.0f};
        pg8::gemm_phase<pg8::EpiGateUp, pg8::GroupOrder<true>, true, true>(lds, g, S, E, wave);
    }
    SEAM(10);
    if (IN(11)) REPS(11) { REP_BAR(); PHASE_LOCALS
        build_tile_table_g(p, lds, tid);
        const LAS int* tbase = (const LAS int*)(lds + L_TBASE);
        pg8::GroupOrder<false> S; S.nN = 4; S.nwg = ((PROBE_PHASE == 11 && _rep == 0) ? tbase[NE] : tbase[NE + 1]) * 4; S.G = G; S.c = bid; S.tile_e = (const LAS unsigned short*)(lds + L_TILEE); S.tok = nullptr; S.rowbytes = 0u;
        pg8::Gemm g{(const bf16*)(ws + WS_H), (const bf16*)(ws + WS_WD), 256, 0x7F7F7F7F, 0x7F7F7F7F};
        pg8::EpiDown E{(bf16*)(ws + WS_Y), (const float*)(ws + WS_WSLOT), p.out, tbase[NE]};
        pg8::gemm_phase<pg8::EpiDown, pg8::GroupOrder<false>, true>(lds, g, S, E, wave);
    }
    SEAM(11);
    if (IN(12)) REPS(12) { REP_BAR(); PHASE_LOCALS
        const bf16* Y = (const bf16*)(ws + WS_Y); const int* slotof = (const int*)(ws + WS_SLOTOF);
        for (int t = gw; t < T; t += NGW) {
            float* orow = p.out + (size_t)t * D; float* wrow = (PROBE_PHASE == 12 && _rep == 0) ? (float*)(ws + WS_H) + (size_t)t * D : orow; float v[16];
            { const f32x4 a = *(const f32x4*)(orow + 8 * lane), b = *(const f32x4*)(orow + 8 * lane + 4), c = *(const f32x4*)(orow + 512 + 8 * lane), d = *(const f32x4*)(orow + 512 + 8 * lane + 4);
#pragma unroll
              for (int j = 0; j < 4; ++j) { v[j] = a[j]; v[4 + j] = b[j]; v[8 + j] = c[j]; v[12 + j] = d[j]; } }
            int sl[8];
#pragma unroll
            for (int k = 0; k < 8; ++k) sl[k] = slotof[(size_t)t * 8 + k];
#pragma unroll
            for (int k = 0; k < 8; ++k) { const unsigned char* yr = (const unsigned char*)Y + (size_t)sl[k] * D; const u32x2 a = *(const u32x2*)(yr + 8 * lane), b = *(const u32x2*)(yr + 512 + 8 * lane);
#pragma unroll
                for (int w = 0; w < 2; ++w) {
                    const f32x2 a0 = __builtin_amdgcn_cvt_pk_f32_fp8((int)a[w], false), a1 = __builtin_amdgcn_cvt_pk_f32_fp8((int)a[w], true), b0 = __builtin_amdgcn_cvt_pk_f32_fp8((int)b[w], false), b1 = __builtin_amdgcn_cvt_pk_f32_fp8((int)b[w], true);
                    v[4 * w] += a0[0] * 0.015625f; v[4 * w + 1] += a0[1] * 0.015625f; v[4 * w + 2] += a1[0] * 0.015625f; v[4 * w + 3] += a1[1] * 0.015625f;
                    v[8 + 4 * w] += b0[0] * 0.015625f; v[8 + 4 * w + 1] += b0[1] * 0.015625f; v[8 + 4 * w + 2] += b1[0] * 0.015625f; v[8 + 4 * w + 3] += b1[1] * 0.015625f; } }
            float s = 0.f;
#pragma unroll
            for (int j = 0; j < 16; ++j) s += v[j];
            const float mean = wave_sum(s) * (1.f / D); float s2 = 0.f;
#pragma unroll
            for (int j = 0; j < 16; ++j) { v[j] -= mean; s2 += v[j] * v[j]; }
            const float rstd = 1.f / sqrtf(wave_sum(s2) * (1.f / D) + LN_EPS);
            const float* gm = p.in[24]; const float* bt = p.in[25];
#pragma unroll
            for (int q = 0; q < 4; ++q) { const int c0 = (q >> 1) * 512 + 8 * lane + (q & 1) * 4; const f32x4 g4 = *(const f32x4*)(gm + c0), b4 = *(const f32x4*)(bt + c0); f32x4 o;
#pragma unroll
                for (int j = 0; j < 4; ++j) o[j] = v[4 * q + j] * rstd * g4[j] + b4[j];
                *(f32x4*)(wrow + c0) = o; }
        }
    }
    STAMP(13);
    if (PROBE_PHASE >= 100 && wave == 0 && lane_id() == 0) {
        volatile LAS unsigned* st = (volatile LAS unsigned*)(lds + L_STAMP);
        const unsigned d = (PROBE_PHASE == 200) ? st[13] - st[0] : (PROBE_PHASE == 201) ? st[7] - st[0] : (PROBE_PHASE == 202) ? st[13] - st[7] : st[PROBE_PHASE - 100 + 1] - st[PROBE_PHASE - 100], t0 = (unsigned)__builtin_amdgcn_s_memrealtime();
        while ((unsigned)__builtin_amdgcn_s_memrealtime() - t0 < d) __builtin_amdgcn_s_sleep(8);
    }
#undef IN
#undef SEAM
}

extern "C" void kernel_launch(void* const* d_in, const int* in_sizes, int n_in, void* d_out, int out_size, void* d_ws, size_t ws_size, hipStream_t stream) {
    static int grid = 0;
    if (grid == 0) {
        if (n_in != 26 || in_sizes[0] != T * D || out_size != T * D || ws_size < WS_END) { fprintf(stderr, "kernel_launch: unexpected shapes / workspace (%d inputs, ws %zu < %zu)\n", n_in, ws_size, (size_t)WS_END); grid = -1; return; }
        int dev = 0, cus = 0, per_cu = 0;
        if (hipGetDevice(&dev) != hipSuccess || hipDeviceGetAttribute(&cus, hipDeviceAttributeMultiprocessorCount, dev) != hipSuccess) { grid = -1; return; }
        if (hipFuncSetAttribute((const void*)fwd_kernel, hipFuncAttributeMaxDynamicSharedMemorySize, LDS_BYTES) != hipSuccess) { fprintf(stderr, "kernel_launch: hipFuncSetAttribute failed\n"); grid = -1; return; }
        if (hipOccupancyMaxActiveBlocksPerMultiprocessor(&per_cu, (const void*)fwd_kernel, 512, LDS_BYTES) != hipSuccess || per_cu < 1) { fprintf(stderr, "kernel_launch: occupancy query says %d\n", per_cu); }
        (void)hipGetLastError();
        grid = cus;
    }
    if (grid < 0) return;
    (void)hipMemsetAsync((char*)d_ws + WS_CTL, 0, CTL_BYTES, stream);
    Params p{};
    for (int i = 0; i < 26; ++i) p.in[i] = (const float*)d_in[i];
    p.out = (float*)d_out; p.ws = (unsigned char*)d_ws;
    const int dils[3] = {1, 4, 16};
    for (int g = 0; g < 3; ++g) for (int rel = 0; rel <= 128; ++rel) {
        const long dist = (long)rel * dils[g]; long bk;
        if (dist < 16) bk = dist;
        else { const double dd = (double)(dist < 1 ? 1 : dist); long large = 16 + (long)(std::log(dd / 16.0) / std::log(2048.0 / 16.0) * 16.0); bk = large < 31 ? large : 31; }
        p.bucket[g][rel] = (unsigned char)bk;
    }
#if N_LAUNCHES == 1
    p.lo = 0; p.hi = NPHASE;
    hipLaunchKernelGGL(fwd_kernel, dim3(grid), dim3(512), LDS_BYTES, stream, p);
#else
    for (int k = 0; k < NPHASE; ++k) { p.lo = k; p.hi = k + 1; hipLaunchKernelGGL(fwd_kernel, dim3(grid), dim3(512), LDS_BYTES, stream, p); }
#endif
}
```

```cpp
#include <hip/hip_runtime.h>
#include <cstdio>
#include <cstdint>
#include <cmath>

#ifndef N_LAUNCHES
#define N_LAUNCHES 1
#endif

#define GAS __attribute__((address_space(1)))
#define LAS __attribute__((address_space(3)))
typedef unsigned short bf16;
typedef float f32x2 __attribute__((ext_vector_type(2)));
typedef float f32x4 __attribute__((ext_vector_type(4)));
typedef float f32x16 __attribute__((ext_vector_type(16)));
typedef short bf16x8 __attribute__((ext_vector_type(8)));
typedef short bf16x4 __attribute__((ext_vector_type(4)));
typedef unsigned u32x4 __attribute__((ext_vector_type(4)));
typedef unsigned u32x2 __attribute__((ext_vector_type(2)));

constexpr int NB = 8, SEQ = 4096, T = NB * SEQ, D = 1024, DIN = 8704;
constexpr int C_XR = 0, C_GR = 1024, C_Q = 2048, C_K = 3584, C_V = 5120, C_GRNN = 6656, C_GATT = 7680;
constexpr int NE = 256, TOPK = 8, DE = 256;
constexpr int TCH = 128, NCH = SEQ / TCH;
constexpr int MAXT_R = 1280, SH_TILES = T / 256, MAXT = MAXT_R + SH_TILES;
constexpr float ALPHA = 1.18920711500272f, LN_EPS = 1e-5f;
constexpr int NPHASE = 13;

constexpr size_t MiB = 1u << 20;
constexpr size_t WS_CTL = 0, CTL_BYTES = 1 * MiB;
constexpr size_t WS_WINT = 1 * MiB;
constexpr size_t WS_WPRT = 18 * MiB;
constexpr size_t WS_WPAT = 20 * MiB;
constexpr size_t WS_WOT = 21 * MiB;
constexpr size_t WS_WRT = 23 * MiB;
constexpr size_t WS_HIST = 31 * MiB + 512 * 1024;
constexpr size_t WS_EIDX = 24 * MiB, WS_GATEW = 25 * MiB, WS_RANK = 26 * MiB, WS_SLOTOF = 27 * MiB, WS_TOKSLOT = 28 * MiB, WS_WSLOT = 30 * MiB;
constexpr size_t WS_XB = 32 * MiB;
constexpr size_t WS_YRNN = 32 * MiB;
constexpr size_t WS_HLOC = 96 * MiB;
constexpr size_t WS_MERGED = 96 * MiB;
constexpr size_t WS_CUMA = 160 * MiB;
constexpr size_t WS_AO = 224 * MiB;
constexpr size_t WS_YATT = 320 * MiB;
constexpr size_t WS_SUMA = 352 * MiB, WS_SUMH = 353 * MiB;
constexpr size_t WS_LSE = 354 * MiB;
constexpr size_t WS_PROJ = 360 * MiB;
constexpr size_t WS_PRELN = 788 * MiB;
constexpr size_t WS_WD = 32 * MiB;
constexpr size_t WS_H = 161 * MiB;
constexpr size_t WS_Y = 337 * MiB;
constexpr size_t WS_X1B = 660 * MiB;
constexpr size_t WS_WGU = 852 * MiB;
constexpr size_t WS_X1B8 = 724 * MiB;
constexpr size_t WS_LOGITS = 756 * MiB;
constexpr size_t WS_END = 981 * MiB;
constexpr int CW_BAR = 4096, CW_CNT = 16384;

constexpr int RING_BYTES = 131072;
constexpr int L_TBASE = RING_BYTES;
constexpr int L_TILEE = L_TBASE + 1040;
constexpr int L_BTAB = L_TILEE + 2816;
constexpr int L_MISC = L_BTAB + 12672;
constexpr int L_LCNT = L_MISC + 64;
constexpr int L_BBASE = L_LCNT + 1024;
constexpr int L_STAMP = L_BBASE + 1024;
constexpr int LDS_BYTES = 151552;
static_assert(L_STAMP + 128 <= LDS_BYTES, "LDS map");

__device__ __forceinline__ unsigned f2bf(float f) { unsigned u = __builtin_bit_cast(unsigned, f); return (u + 0x7fffu + ((u >> 16) & 1u)) >> 16; }
__device__ __forceinline__ unsigned pk2(float lo, float hi) { return f2bf(lo) | (f2bf(hi) << 16); }
__device__ __forceinline__ unsigned pk_fp8x4(float a, float b, float c, float d) {
    a = __builtin_amdgcn_fmed3f(a, -448.f, 448.f); b = __builtin_amdgcn_fmed3f(b, -448.f, 448.f); c = __builtin_amdgcn_fmed3f(c, -448.f, 448.f); d = __builtin_amdgcn_fmed3f(d, -448.f, 448.f);
    int w = 0; w = __builtin_amdgcn_cvt_pk_fp8_f32(a, b, w, false); w = __builtin_amdgcn_cvt_pk_fp8_f32(c, d, w, true); return (unsigned)w; }
__device__ __forceinline__ float bflo(unsigned w) { return __builtin_bit_cast(float, w << 16); }
__device__ __forceinline__ float bfhi(unsigned w) { return __builtin_bit_cast(float, w & 0xffff0000u); }
__device__ __forceinline__ float bf1(bf16 h) { return __builtin_bit_cast(float, (unsigned)h << 16); }
__device__ __forceinline__ float sigmoidf_(float x) { return 1.0f / (1.0f + __expf(-x)); }
__device__ __forceinline__ float gelu_tanh(float x) { const float z = 1.5957691216057308f * (x + 0.044715f * x * x * x); return x / (1.0f + __expf(-z)); }
__device__ __forceinline__ float wave_sum(float v) {
#pragma unroll
    for (int o = 1; o < 64; o <<= 1) v += __shfl_xor(v, o);
    return v;
}

__device__ __forceinline__ int lane_id() { return (int)__builtin_amdgcn_mbcnt_hi(~0u, __builtin_amdgcn_mbcnt_lo(~0u, 0u)); }
namespace pg8 {
#define PG8_LAS __attribute__((address_space(3)))
#ifndef PROBE_PHASE
#define PROBE_PHASE -1
#endif
#define PG8_STAMP_OFF (L_STAMP + 64)
typedef unsigned short bf16_t;
constexpr int BM = 256, BK = 64, HALF = 128, HTB = HALF * BK * 2, STAGE_BYTES = 8 * HTB, NXCD = 8, WGM = 8;
__host__ __device__ __forceinline__ int lds_byte(int r, int c) { const int st = (r >> 4) * 2 + (c >> 5), rr = r & 15, cc = c & 31, ob = rr * 64 + cc * 2; return st * 1024 + (ob ^ (((ob >> 9) & 1) << 5)); }
__host__ __device__ __forceinline__ void stage_rc(int b, int& R, int& C) { const int st = b / 1024, sb = b % 1024, swz = sb ^ (((sb >> 9) & 1) << 5); R = (st >> 1) * 16 + swz / 64; C = (st & 1) * 32 + (swz % 64) / 2; }
__host__ __device__ __forceinline__ int perm32(int rho) { const int n = rho >> 4, i = rho & 15; return 8 * (i >> 2) + 4 * n + (i & 3); }

struct Unit { int pm, pn, pb; };
struct Gemm { const bf16_t* A; const bf16_t* Bt; int K; int sw, sa; };

struct StaticOrder {
    static constexpr bool GATHER = false;
    int nM, nN, nwg, G, c;
    __device__ __forceinline__ void init(int M, int N, int G_, int c_) { nM = M / BM; nN = N / BM; nwg = nM * nN; G = G_; c = c_; }
    __device__ __forceinline__ bool next(int i, Unit& u) const {
        const long L = (long)i * G + c; if (L >= nwg) return false;
        int wgid = (int)L; { const int q = nwg / NXCD, r = nwg % NXCD, xcd = wgid % NXCD, off = wgid / NXCD; wgid = (xcd < r ? xcd * (q + 1) : r * (q + 1) + (xcd - r) * q) + off; }
        const int nig = WGM * nN, gid = wgid / nig, fm = gid * WGM, gsz = (nM - fm) < WGM ? (nM - fm) : WGM;
        u.pm = fm + ((wgid % nig) % gsz); u.pn = (wgid % nig) / gsz; u.pb = u.pn; return true;
    }
    __device__ __forceinline__ unsigned arow(int) const { return 0u; }
};
template <bool GATHER_> struct GroupOrder {
    static constexpr bool GATHER = GATHER_;
    int nN, nwg, G, c; const LAS unsigned short* tile_e; const int* tok; unsigned rowbytes;
    __device__ __forceinline__ bool next(int i, Unit& u) const {
        const int v = (G % 8 == 0) ? (c % 8) * (G / 8) + c / 8 : c;
        const long L = (long)i * G + v; if (L >= nwg) return false;
        u.pm = (int)L / nN; u.pn = (int)L % nN; u.pb = __builtin_amdgcn_readfirstlane((int)tile_e[u.pm]) * nN + u.pn; return true;
    }
    __device__ __forceinline__ unsigned arow(int slot) const { return (unsigned)tok[slot] * rowbytes; }
};

__device__ __forceinline__ unsigned cvt_pk_bf16(float lo, float hi) { unsigned r; asm volatile("v_cvt_pk_bf16_f32 %0, %1, %2" : "=v"(r) : "v"(lo), "v"(hi)); return r; }

typedef int i32x4 __attribute__((ext_vector_type(4)));
typedef int i32x8 __attribute__((ext_vector_type(8)));
__device__ __forceinline__ f32x4 mma8(bf16x8 w0, bf16x8 w1, bf16x8 a0, bf16x8 a1, f32x4 c, int sw, int sa) {
    const i32x8 W = __builtin_shufflevector(__builtin_bit_cast(i32x4, w0), __builtin_bit_cast(i32x4, w1), 0, 1, 2, 3, 4, 5, 6, 7);
    const i32x8 A = __builtin_shufflevector(__builtin_bit_cast(i32x4, a0), __builtin_bit_cast(i32x4, a1), 0, 1, 2, 3, 4, 5, 6, 7);
    (void)sw; (void)sa; return __builtin_amdgcn_mfma_scale_f32_16x16x128_f8f6f4(W, A, c, 0, 0, 0, 0, 0, 0);
}
template <class Epi, class Sched, bool ALIGN_EPI = false, bool FP8 = false>
__device__ __forceinline__ void gemm_phase(PG8_LAS unsigned char* lds, const Gemm g, const Sched& S, const Epi& E, int wid) {
    constexpr bool GA = Sched::GATHER;
    int lane_ = lane_id(); asm volatile("" : "+v"(lane_));
    const int lane = lane_, tid = wid * 64 + lane, wr = wid >> 2, wc = wid & 3, fr = lane & 15, fq = lane >> 4;
    const int K = g.K, nt = K / BK;
    unsigned voffA[2], voffA1[2], voffB[2];
#pragma unroll
    for (int i = 0; i < 2; ++i) { int R, C; stage_rc(tid * 16 + i * 8192, R, C); const int Rb = Epi::PERM ? ((R & ~31) + perm32(R & 31)) : R;
        voffA[i] = (unsigned)(R * K + C) * 2u; voffA1[i] = voffA[i]; voffB[i] = (unsigned)(Rb * K + C) * 2u; }
    const size_t kstep = (size_t)(BK * 2);
    const size_t hstep = (size_t)HALF * K * 2;
    const size_t tstep = 2 * hstep;
    const size_t hstepA = GA ? 0 : hstep;
    const unsigned ldsw = (unsigned)wid * 1024u;
    const unsigned ldsbase = (unsigned)(size_t)lds + ldsw;
    const int aoff = lds_byte(wr * 64 + fr, fq * 8), boff = lds_byte(wc * 32 + fr, fq * 8);
    unsigned abase = (unsigned)(size_t)lds + (unsigned)aoff, bbase = (unsigned)(size_t)lds + 65536u + (unsigned)boff;
    asm volatile("" : "+v"(abase), "+v"(bbase));
#define PG8_RDA(off) (*(const PG8_LAS i32x4*)(size_t)(abase + (unsigned)(off)))
#define PG8_RDB(off) (*(const PG8_LAS i32x4*)(size_t)(bbase + (unsigned)((off) - 65536)))
#define PG8_SA(b, h) (((b) * 2 + (h)) * HTB)
#define PG8_SB(b, h) ((4 + (b) * 2 + (h)) * HTB)
#define PG8_STAGE(bufoff, gbase, voff) do { _Pragma("unroll") for (int _i = 0; _i < 2; ++_i) { unsigned _keep; \
        asm volatile("s_mov_b32 %0, m0\n\ts_mov_b32 m0, %3\n\ts_nop 0\n\tglobal_load_lds_dwordx4 %1, %2\n\ts_mov_b32 m0, %0" : "=&s"(_keep) : "v"((voff)[_i]), "s"((const char*)(gbase)), "s"(ldsbase + (unsigned)((bufoff) + _i * 8192)) : "memory"); } } while (0)
#define PG8_LDA(dst, b, h) do { if constexpr (FP8) { _Pragma("unroll") for (int m = 0; m < 4; ++m) dst##8[m] = __builtin_shufflevector(PG8_RDA(PG8_SA(b, h) + m * 2048), PG8_RDA(PG8_SA(b, h) + m * 2048 + 1024), 0, 1, 2, 3, 4, 5, 6, 7); } \
        else { _Pragma("unroll") for (int m = 0; m < 4; ++m) _Pragma("unroll") for (int k = 0; k < 2; ++k) dst[m][k] = __builtin_bit_cast(bf16x8, PG8_RDA(PG8_SA(b, h) + m * 2048 + k * 1024)); } } while (0)
#define PG8_LDB(dst, b, h) do { if constexpr (FP8) { _Pragma("unroll") for (int n = 0; n < 2; ++n) dst##8[n] = __builtin_shufflevector(PG8_RDB(PG8_SB(b, h) + n * 2048), PG8_RDB(PG8_SB(b, h) + n * 2048 + 1024), 0, 1, 2, 3, 4, 5, 6, 7); } \
        else { _Pragma("unroll") for (int n = 0; n < 2; ++n) _Pragma("unroll") for (int k = 0; k < 2; ++k) dst[n][k] = __builtin_bit_cast(bf16x8, PG8_RDB(PG8_SB(b, h) + n * 2048 + k * 1024)); } } while (0)
#define PG8_MMA(ai, bj, At, Bt) do { __builtin_amdgcn_s_setprio(1); \
        if constexpr (FP8) { _Pragma("unroll") for (int m = 0; m < 4; ++m) _Pragma("unroll") for (int n = 0; n < 2; ++n) acc[ai][bj][m][n] = __builtin_amdgcn_mfma_scale_f32_16x16x128_f8f6f4(Bt##8[n], At##8[m], acc[ai][bj][m][n], 0, 0, 0, 0, 0, 0); } \
        else { _Pragma("unroll") for (int m = 0; m < 4; ++m) _Pragma("unroll") for (int n = 0; n < 2; ++n) _Pragma("unroll") for (int k = 0; k < 2; ++k) \
        acc[ai][bj][m][n] = __builtin_amdgcn_mfma_f32_16x16x32_bf16(Bt[n][k], At[m][k], acc[ai][bj][m][n], 0, 0, 0); } __builtin_amdgcn_s_setprio(0); } while (0)
#define PG8_WAIT_V(n) asm volatile("s_waitcnt vmcnt(" #n ")" ::: "memory")
#define PG8_WAIT_L(n) asm volatile("s_waitcnt lgkmcnt(" #n ")" ::: "memory")
#define PG8_BAR __builtin_amdgcn_s_barrier()
#define PG8_SCHED __builtin_amdgcn_sched_barrier(0)
    Unit cur, nxt; int ui = 0;
    if (!S.next(0, cur)) return;
    f32x4 acc[2][2][4][2];
#pragma unroll
    for (int a = 0; a < 2; ++a)
#pragma unroll
        for (int b = 0; b < 2; ++b)
#pragma unroll
            for (int m = 0; m < 4; ++m)
#pragma unroll
                for (int n = 0; n < 2; ++n) acc[a][b][m][n] = (f32x4){0.f, 0.f, 0.f, 0.f};
    bf16x8 At[4][2], B0[2][2], B1[2][2]; i32x8 At8[4], B08[2], B18[2]; (void)At; (void)B0; (void)B1; (void)At8; (void)B08; (void)B18;
    const char* cA = GA ? (const char*)g.A : (const char*)g.A + (size_t)cur.pm * tstep; const char* cB = (const char*)g.Bt + (size_t)cur.pb * tstep;
#define PG8_GATHER_OFFS(pm_) do { int _ln = lane_id(); asm volatile("" : "+v"(_ln)); int _R, _C; stage_rc((wid * 64 + _ln) * 16, _R, _C); \
        _Pragma("unroll") for (int _i = 0; _i < 2; ++_i) { voffA[_i] = S.arow((pm_) * BM + _R + 64 * _i) + (unsigned)(_C * 2); voffA1[_i] = S.arow((pm_) * BM + HALF + _R + 64 * _i) + (unsigned)(_C * 2); } } while (0)
    if constexpr (GA) PG8_GATHER_OFFS(cur.pm);
    PG8_STAGE(PG8_SB(0, 0), cB, voffB); PG8_STAGE(PG8_SB(0, 1), cB + hstep, voffB); PG8_STAGE(PG8_SA(0, 0), cA, voffA); PG8_STAGE(PG8_SA(0, 1), cA + hstepA, voffA1);
    if (wr == 1) PG8_BAR;
    PG8_WAIT_V(2); PG8_BAR;
    PG8_STAGE(PG8_SB(1, 0), cB + kstep, voffB); PG8_STAGE(PG8_SA(1, 0), cA + kstep, voffA); PG8_STAGE(PG8_SB(1, 1), cB + hstep + kstep, voffB);
    PG8_WAIT_V(6); PG8_BAR;
    unsigned tm_loop = 0u, tm_epi = 0u, tm0 = 0u; (void)tm_loop; (void)tm_epi; (void)tm0;
    for (;;) {
        if (PROBE_PHASE >= 300) tm0 = (unsigned)__builtin_amdgcn_s_memrealtime();
        const bool has_next = S.next(ui + 1, nxt);
        const char* nA = GA ? (const char*)g.A : (has_next ? (const char*)g.A + (size_t)nxt.pm * tstep : cA);
        const char* nB = has_next ? (const char*)g.Bt + (size_t)nxt.pb * tstep : cB;
#pragma clang loop unroll(disable)
        for (int t = 0; t < nt; t += 2) {
            const bool last = (t == nt - 2);
            const char* a1 = cA + (size_t)(t + 1) * kstep;
            const char* a2 = last ? nA : cA + (size_t)(t + 2) * kstep; const char* b2 = last ? nB : cB + (size_t)(t + 2) * kstep;
            const char* a3 = a2 + kstep; const char* b3 = b2 + kstep;
            PG8_LDB(B0, 0, 0); PG8_LDB(B1, 0, 1); PG8_SCHED; PG8_LDA(At, 0, 0); PG8_STAGE(PG8_SA(1, 1), a1 + hstepA, voffA1);
            if constexpr (GA) { if (last && has_next) PG8_GATHER_OFFS(nxt.pm); }
            PG8_WAIT_V(8); PG8_WAIT_L(0); PG8_BAR; PG8_MMA(0, 0, At, B0); PG8_MMA(0, 1, At, B1); PG8_BAR; PG8_SCHED;
            PG8_LDA(At, 0, 1); PG8_STAGE(PG8_SB(0, 0), b2, voffB); PG8_STAGE(PG8_SB(0, 1), b2 + hstep, voffB); PG8_STAGE(PG8_SA(0, 0), a2, voffA);
            PG8_WAIT_V(8); PG8_WAIT_L(0); PG8_BAR; PG8_MMA(1, 0, At, B0); PG8_MMA(1, 1, At, B1); PG8_BAR; PG8_SCHED;
            PG8_LDB(B0, 1, 0); PG8_LDB(B1, 1, 1); PG8_SCHED; PG8_LDA(At, 1, 0); PG8_STAGE(PG8_SA(0, 1), a2 + hstepA, voffA1);
            PG8_WAIT_V(8); PG8_WAIT_L(0); PG8_BAR; PG8_MMA(0, 0, At, B0); PG8_MMA(0, 1, At, B1); PG8_BAR; PG8_SCHED;
            PG8_LDA(At, 1, 1); PG8_STAGE(PG8_SB(1, 0), b3, voffB); PG8_STAGE(PG8_SB(1, 1), b3 + hstep, voffB); PG8_STAGE(PG8_SA(1, 0), a3, voffA);
            PG8_WAIT_V(8); PG8_WAIT_L(0); PG8_BAR; PG8_MMA(1, 0, At, B0); PG8_MMA(1, 1, At, B1); PG8_BAR; PG8_SCHED;
        }
        if constexpr (ALIGN_EPI) { if (wr == 0) PG8_BAR; }
        if (PROBE_PHASE >= 300) { const unsigned t1 = (unsigned)__builtin_amdgcn_s_memrealtime(); tm_loop += t1 - tm0; tm0 = t1; }
        { Unit eu = cur; int efr = fr, efq = fq;
          asm volatile("" : "+s"(eu.pm), "+s"(eu.pn), "+s"(eu.pb)); asm volatile("" : "+v"(efr), "+v"(efq));
          E(acc, eu, wr, wc, efr, efq); }
        if (PROBE_PHASE >= 300) { asm volatile("s_waitcnt vmcnt(0)" ::: "memory"); const unsigned t1 = (unsigned)__builtin_amdgcn_s_memrealtime(); tm_epi += t1 - tm0; }
        if (!has_next) break;
#pragma unroll
        for (int a = 0; a < 2; ++a)
#pragma unroll
            for (int b = 0; b < 2; ++b)
#pragma unroll
                for (int m = 0; m < 4; ++m)
#pragma unroll
                    for (int n = 0; n < 2; ++n) acc[a][b][m][n] = (f32x4){0.f, 0.f, 0.f, 0.f};
        cur = nxt; cA = nA; cB = nB; ++ui;
        if constexpr (ALIGN_EPI) { if (wr == 1) PG8_BAR; }
    }
    PG8_WAIT_V(0);
    if constexpr (!ALIGN_EPI) { if (wr == 0) PG8_BAR; }
    PG8_BAR;
    if (PROBE_PHASE >= 300 && wid == 0 && lane == 0) { volatile PG8_LAS unsigned* st = (volatile PG8_LAS unsigned*)(lds + PG8_STAMP_OFF); st[0] += tm_loop; st[1] += tm_epi; }
#undef PG8_SA
#undef PG8_SB
#undef PG8_STAGE
#undef PG8_LDA
#undef PG8_LDB
#undef PG8_GATHER_OFFS
#undef PG8_RDA
#undef PG8_RDB
#undef PG8_MMA
#undef PG8_WAIT_V
#undef PG8_WAIT_L
#undef PG8_BAR
#undef PG8_SCHED
}

typedef const f32x4 (&AccRef)[2][2][4][2];

struct EpiInProj {
    static constexpr bool PERM = true;
    bf16_t* O; const float* bias; float os;
    __device__ __forceinline__ void operator()(AccRef acc, const Unit& u, int wr, int wc, int fr, int fq) const {
        const int row0 = u.pm * BM + wr * 64 + fr, col0 = u.pn * BM + wc * 32 + 8 * fq;
        const int kind = u.pn < 4 ? 0 : (u.pn < 8 ? 1 : (u.pn < 14 ? 2 : (u.pn < 26 ? 0 : 3)));
        f32x4 bv[2][2];
#pragma unroll
        for (int bj = 0; bj < 2; ++bj)
#pragma unroll
            for (int n = 0; n < 2; ++n) bv[bj][n] = *(const f32x4*)(bias + col0 + bj * HALF + 4 * n);
#pragma unroll
        for (int ai = 0; ai < 2; ++ai)
#pragma unroll
            for (int m = 0; m < 4; ++m) { bf16_t* rowp = O + (size_t)(row0 + ai * HALF + m * 16) * DIN + col0;
#pragma unroll
                for (int bj = 0; bj < 2; ++bj) { f32x4 v0 = acc[ai][bj][m][0] * os + bv[bj][0], v1 = acc[ai][bj][m][1] * os + bv[bj][1];
                    if (kind == 1) {
#pragma unroll
                        for (int j = 0; j < 4; ++j) { v0[j] = gelu_tanh(v0[j]); v1[j] = gelu_tanh(v1[j]); }
                    } else if (kind == 2) { v0 = v0 * 0.125f; v1 = v1 * 0.125f; }
                    else if (kind == 3) {
#pragma unroll
                        for (int j = 0; j < 4; ++j) { v0[j] = sigmoidf_(v0[j]); v1[j] = sigmoidf_(v1[j]); }
                    }
                    u32x4 w; w.x = cvt_pk_bf16(v0[0], v0[1]); w.y = cvt_pk_bf16(v0[2], v0[3]); w.z = cvt_pk_bf16(v1[0], v1[1]); w.w = cvt_pk_bf16(v1[2], v1[3]);
                    *(u32x4*)(rowp + bj * HALF) = w; } }
    }
};
struct EpiProjRnn {
    static constexpr bool PERM = true;
    const bf16_t* proj; float* part; float os;
    __device__ __forceinline__ void operator()(AccRef acc, const Unit& u, int wr, int wc, int fr, int fq) const {
        const int row0 = u.pm * BM + wr * 64 + fr, col0 = u.pn * BM + wc * 32 + 8 * fq;
#pragma unroll
        for (int ai = 0; ai < 2; ++ai)
#pragma unroll
            for (int m = 0; m < 4; ++m) { const size_t row = (size_t)(row0 + ai * HALF + m * 16);
#pragma unroll
                for (int bj = 0; bj < 2; ++bj) { const int c = col0 + bj * HALF;
                    const u32x4 gw = *(const u32x4*)(proj + row * DIN + C_GRNN + c);
                    const f32x4 g0 = (f32x4){bflo(gw.x), bfhi(gw.x), bflo(gw.y), bfhi(gw.y)} * os, g1 = (f32x4){bflo(gw.z), bfhi(gw.z), bflo(gw.w), bfhi(gw.w)} * os;
                    *(f32x4*)(part + row * D + c) = g0 * acc[ai][bj][m][0]; *(f32x4*)(part + row * D + c + 4) = g1 * acc[ai][bj][m][1]; } }
    }
};
struct EpiProjAtt {
    static constexpr bool PERM = true;
    const bf16_t* proj; const float* part; unsigned char* merged; float os;
    __device__ __forceinline__ void operator()(AccRef acc, const Unit& u, int wr, int wc, int fr, int fq) const {
        const int row0 = u.pm * BM + wr * 64 + fr, col0 = u.pn * BM + wc * 32 + 8 * fq;
#pragma unroll
        for (int ai = 0; ai < 2; ++ai)
#pragma unroll
            for (int m = 0; m < 4; ++m) { const size_t row = (size_t)(row0 + ai * HALF + m * 16);
#pragma unroll
                for (int bj = 0; bj < 2; ++bj) { const int c = col0 + bj * HALF;
                    const u32x4 gw = *(const u32x4*)(proj + row * DIN + C_GATT + c);
                    const f32x4 g0 = (f32x4){bflo(gw.x), bfhi(gw.x), bflo(gw.y), bfhi(gw.y)} * os, g1 = (f32x4){bflo(gw.z), bfhi(gw.z), bflo(gw.w), bfhi(gw.w)} * os;
                    const f32x4 v0 = (*(const f32x4*)(part + row * D + c) + g0 * acc[ai][bj][m][0]) * 16.0f, v1 = (*(const f32x4*)(part + row * D + c + 4) + g1 * acc[ai][bj][m][1]) * 16.0f;
                    u32x2 w; w.x = pk_fp8x4(v0[0], v0[1], v0[2], v0[3]); w.y = pk_fp8x4(v1[0], v1[1], v1[2], v1[3]);
                    *(u32x2*)(merged + row * D + c) = w; } }
    }
};
struct EpiF32Res {
    static constexpr bool PERM = false;
    const float* base; float* out; int ldc; float scale; float os;
    __device__ __forceinline__ void operator()(AccRef acc, const Unit& u, int wr, int wc, int fr, int fq) const {
        const int row0 = u.pm * BM + wr * 64 + fr, col0 = u.pn * BM + wc * 32 + 4 * fq;
#pragma unroll
        for (int ai = 0; ai < 2; ++ai)
#pragma unroll
            for (int m = 0; m < 4; ++m) { const size_t off = (size_t)(row0 + ai * HALF + m * 16) * ldc + col0;
#pragma unroll
                for (int bj = 0; bj < 2; ++bj)
#pragma unroll
                    for (int n = 0; n < 2; ++n) { f32x4 v = acc[ai][bj][m][n] * os;
                        if (base) v = v + *(const f32x4*)(base + off + bj * HALF + n * 16) * scale;
                        *(f32x4*)(out + off + bj * HALF + n * 16) = v; } }
    }
};
struct EpiBf16Res {
    static constexpr bool PERM = true;
    const float* base; bf16_t* out; float scale; float os;
    __device__ __forceinline__ void operator()(AccRef acc, const Unit& u, int wr, int wc, int fr, int fq) const {
        const int row0 = u.pm * BM + wr * 64 + fr, col0 = u.pn * BM + wc * 32 + 8 * fq;
#pragma unroll
        for (int ai = 0; ai < 2; ++ai)
#pragma unroll
            for (int m = 0; m < 4; ++m) { const size_t off = (size_t)(row0 + ai * HALF + m * 16) * D + col0;
#pragma unroll
                for (int bj = 0; bj < 2; ++bj) { const f32x4 v0 = acc[ai][bj][m][0] * os + *(const f32x4*)(base + off + bj * HALF) * scale, v1 = acc[ai][bj][m][1] * os + *(const f32x4*)(base + off + bj * HALF + 4) * scale;
                    u32x4 w; w.x = cvt_pk_bf16(v0[0], v0[1]); w.y = cvt_pk_bf16(v0[2], v0[3]); w.z = cvt_pk_bf16(v1[0], v1[1]); w.w = cvt_pk_bf16(v1[2], v1[3]);
                    *(u32x4*)(out + off + bj * HALF) = w; } }
    }
};
struct EpiGateUp {
    static constexpr bool PERM = true;
    bf16_t* H; float os;
    __device__ __forceinline__ void operator()(AccRef acc, const Unit& u, int wr, int wc, int fr, int fq) const {
        const int row0 = u.pm * BM + wr * 64 + fr, col0 = u.pn * HALF + wc * 32 + 8 * fq;
#pragma unroll
        for (int ai = 0; ai < 2; ++ai)
#pragma unroll
            for (int m = 0; m < 4; ++m) { unsigned char* rowp = (unsigned char*)H + (size_t)(row0 + ai * HALF + m * 16) * DE + col0;
                f32x4 o[2];
#pragma unroll
                for (int n = 0; n < 2; ++n) { const f32x4 gt = acc[ai][0][m][n] * os, up = acc[ai][1][m][n] * os;
#pragma unroll
                    for (int j = 0; j < 4; ++j) o[n][j] = gt[j] / (1.0f + __expf(-gt[j])) * up[j] * 16.0f; }
                u32x2 w; w.x = pk_fp8x4(o[0][0], o[0][1], o[0][2], o[0][3]); w.y = pk_fp8x4(o[1][0], o[1][1], o[1][2], o[1][3]);
                *(u32x2*)rowp = w; }
    }
};
struct EpiDown {
    static constexpr bool PERM = true;
    bf16_t* Y; const float* wslot; float* out; int mt_r; const bf16_t* x1b; float os;
    __device__ __forceinline__ void operator()(AccRef acc, const Unit& u, int wr, int wc, int fr, int fq) const {
        const int col0 = u.pn * BM + wc * 32 + 8 * fq;
        if (u.pm < mt_r) {
            const int row0 = u.pm * BM + wr * 64 + fr;
#pragma unroll
            for (int ai = 0; ai < 2; ++ai)
#pragma unroll
                for (int m = 0; m < 4; ++m) { const size_t row = (size_t)(row0 + ai * HALF + m * 16); const float w8 = wslot[row] * 64.0f * os; unsigned char* rowp = (unsigned char*)Y + row * D + col0;
#pragma unroll
                    for (int bj = 0; bj < 2; ++bj) { const f32x4 v0 = acc[ai][bj][m][0] * w8, v1 = acc[ai][bj][m][1] * w8;
                        u32x2 w; w.x = pk_fp8x4(v0[0], v0[1], v0[2], v0[3]); w.y = pk_fp8x4(v1[0], v1[1], v1[2], v1[3]);
                        *(u32x2*)(rowp + bj * HALF) = w; } }
        } else {
            const int row0 = (u.pm - mt_r) * BM + wr * 64 + fr;
#pragma unroll
            for (int ai = 0; ai < 2; ++ai)
#pragma unroll
                for (int m = 0; m < 4; ++m) { const size_t off = (size_t)(row0 + ai * HALF + m * 16) * D + col0;
#pragma unroll
                    for (int bj = 0; bj < 2; ++bj) { const u32x4 xw = *(const u32x4*)(x1b + off + bj * HALF);
                        *(f32x4*)(out + off + bj * HALF) = (f32x4){bflo(xw.x), bfhi(xw.x), bflo(xw.y), bfhi(xw.y)} * ALPHA + acc[ai][bj][m][0] * os;
                        *(f32x4*)(out + off + bj * HALF + 4) = (f32x4){bflo(xw.z), bfhi(xw.z), bflo(xw.w), bfhi(xw.w)} * ALPHA + acc[ai][bj][m][1] * os; } }
        }
    }
};
}

#define XB_TMO      128
#define XB_XCNT(j)  (256  + 64 * (j))
#define XB_XSUB(j)  (1280 + 64 * (j))
#define XB_XGEN(j)  (2304 + 64 * (j))
#define XB_TOP      3328
#define XB_TOPGEN   3392
#define XCD_BAR_WORDS 3456
#define XB_SPIN_CAP (1u << 18)
__device__ __forceinline__ unsigned xb_ld(unsigned* p)              { return __hip_atomic_load(p, __ATOMIC_RELAXED, __HIP_MEMORY_SCOPE_AGENT); }
__device__ __forceinline__ unsigned xb_add(unsigned* p, unsigned v) { return __hip_atomic_fetch_add(p, v, __ATOMIC_RELAXED, __HIP_MEMORY_SCOPE_AGENT); }
__device__ __forceinline__ unsigned xb_xcc_id() { return (unsigned)__builtin_amdgcn_s_getreg((3 << 11) | 20) & 0xFu; }
#define XB_SPIN(cond, bar) do { unsigned _sp = 0; while (cond) { __builtin_amdgcn_s_sleep(1); \
    if ((++_sp & 255u) == 0u) { if (xb_ld(&(bar)[XB_TMO])) break; if (_sp > XB_SPIN_CAP) { atomicAdd(&(bar)[XB_TMO], 1u); break; } } } } while (0)
struct XcdBarrier { unsigned* bar; unsigned x; volatile LAS unsigned* st; };
__device__ __forceinline__ XcdBarrier xcd_barrier_post(unsigned* bar, volatile LAS unsigned* st, bool t0) {
    XcdBarrier b; b.bar = bar; b.x = xb_xcc_id(); b.st = st;
    if (t0) (void)xb_add(&bar[XB_XCNT(b.x)], 1u);
    return b;
}
__device__ __forceinline__ void xcd_barrier_complete(unsigned* bar, unsigned x, unsigned& nloc, unsigned& nx) {
    const unsigned G = gridDim.x * gridDim.y * gridDim.z;
    unsigned sum, cnt, mine, sp = 0u;
    for (;;) {
        sum = 0u; cnt = 0u; mine = 0u;
#pragma unroll
        for (unsigned j = 0; j < 16; ++j) { const unsigned c = xb_ld(&bar[XB_XCNT(j)]); sum += c; cnt += (c > 0u) ? 1u : 0u; mine = (j == x) ? c : mine; }
        if (sum == G) break;
        __builtin_amdgcn_s_sleep(1);
        if ((++sp & 255u) == 0u) { if (xb_ld(&bar[XB_TMO])) break; if (sp > XB_SPIN_CAP) { atomicAdd(&bar[XB_TMO], 1u); break; } }
    }
    nloc = mine > 0u ? mine : 1u; nx = cnt > 0u ? cnt : 1u;
}
__device__ __forceinline__ void xcd_barrier(const XcdBarrier& b, bool t0) {
    asm volatile("s_waitcnt vmcnt(0)" ::: "memory");
    __syncthreads();
    if (t0) {
        unsigned* bar = b.bar;
        __builtin_amdgcn_s_waitcnt(0);
        unsigned nloc = b.st[0], nx = b.st[1];
        if (nloc == 0u) { xcd_barrier_complete(bar, b.x, nloc, nx); b.st[0] = nloc; b.st[1] = nx; }
        const unsigned old = xb_add(&bar[XB_XSUB(b.x)], 1u);
        const unsigned gen = old / nloc;
        if (old + 1u == (gen + 1u) * nloc) {
            __builtin_amdgcn_fence(__ATOMIC_RELEASE, "agent");
            asm volatile("s_waitcnt vmcnt(0)" ::: "memory");
            const unsigned og = xb_add(&bar[XB_TOP], 1u);
            const unsigned tg = og / nx;
            if (og + 1u == (tg + 1u) * nx) xb_add(&bar[XB_TOPGEN], 1u);
            else XB_SPIN(xb_ld(&bar[XB_TOPGEN]) == tg, bar);
            __builtin_amdgcn_fence(__ATOMIC_ACQUIRE, "agent");
            xb_add(&bar[XB_XGEN(b.x)], 1u);
            asm volatile("s_waitcnt vmcnt(0)" ::: "memory");
        } else {
            XB_SPIN(xb_ld(&bar[XB_XGEN(b.x)]) == gen, bar);
            __builtin_amdgcn_fence(__ATOMIC_ACQUIRE, "agent");
            asm volatile("s_waitcnt vmcnt(0)" ::: "memory");
        }
    }
    __syncthreads();
}

struct Params { const float* in[26]; float* out; unsigned char* ws; int lo, hi; unsigned char bucket[3][136]; };
static_assert(sizeof(Params) == 26 * 8 + 8 + 8 + 8 + 408, "Params has no padding holes");

__device__ __forceinline__ void tr128(const float* src, int ld_src, bf16* dst, int ld_dst, LAS float* tile, int tid) {
    f32x4 v[8];
#pragma unroll
    for (int it = 0; it < 8; ++it) { const int id = it * 512 + tid, k = id >> 5, c4 = id & 31; v[it] = *(const f32x4*)(src + (size_t)k * ld_src + c4 * 4); }
#pragma unroll
    for (int it = 0; it < 8; ++it) { const int id = it * 512 + tid, k = id >> 5, c4 = id & 31; LAS float* p = tile + k * 129 + c4 * 4; p[0] = v[it][0]; p[1] = v[it][1]; p[2] = v[it][2]; p[3] = v[it][3]; }
    __syncthreads();
#pragma unroll
    for (int it = 0; it < 4; ++it) { const int id = it * 512 + tid, n = id >> 4, kc = id & 15; const LAS float* s = tile + (kc * 8) * 129 + n;
        u32x4 o; o.x = pk2(s[0], s[129]); o.y = pk2(s[2 * 129], s[3 * 129]); o.z = pk2(s[4 * 129], s[5 * 129]); o.w = pk2(s[6 * 129], s[7 * 129]);
        *(u32x4*)(dst + (size_t)n * ld_dst + kc * 8) = o; }
    __syncthreads();
}
__device__ __forceinline__ void tr_matrix_item(const float* W, int K, int N, bf16* WT, int item, LAS float* tile, int tid) {
    const int nbn = N / 128, kb = item / nbn, nb = item % nbn;
    tr128(W + (size_t)kb * 128 * N + nb * 128, N, WT + (size_t)nb * 128 * K + kb * 128, K, tile, tid);
}

__device__ __forceinline__ void tr128_fp8(const float* src, int ld_src, unsigned char* dst, int ld_dst, float scale, LAS float* tile, int tid) {
    f32x4 v[8];
#pragma unroll
    for (int it = 0; it < 8; ++it) { const int id = it * 512 + tid, k = id >> 5, c4 = id & 31; v[it] = *(const f32x4*)(src + (size_t)k * ld_src + c4 * 4); }
#pragma unroll
    for (int it = 0; it < 8; ++it) { const int id = it * 512 + tid, k = id >> 5, c4 = id & 31; LAS float* p = tile + k * 129 + c4 * 4; p[0] = v[it][0]; p[1] = v[it][1]; p[2] = v[it][2]; p[3] = v[it][3]; }
    __syncthreads();
#pragma unroll
    for (int it = 0; it < 2; ++it) { const int id = it * 512 + tid, n = id >> 3, kc = id & 7; const LAS float* s = tile + (kc * 16) * 129 + n;
        u32x4 o;
#pragma unroll
        for (int w = 0; w < 4; ++w) o[w] = pk_fp8x4(s[(4 * w) * 129] * scale, s[(4 * w + 1) * 129] * scale, s[(4 * w + 2) * 129] * scale, s[(4 * w + 3) * 129] * scale);
        *(u32x4*)(dst + (size_t)n * ld_dst + kc * 16) = o; }
    __syncthreads();
}
__device__ __forceinline__ void tr_matrix_item_fp8(const float* W, int K, int N, unsigned char* WT, float scale, int item, LAS float* tile, int tid) {
    const int nbn = N / 128, kb = item / nbn, nb = item % nbn;
    tr128_fp8(W + (size_t)kb * 128 * N + nb * 128, N, WT + (size_t)nb * 128 * K + kb * 128, K, scale, tile, tid);
}

struct RgW { bf16x8 f[2][2][4]; };
__device__ __forceinline__ void rglru_load_w(const Params& p, int h, int lane, RgW& W) {
    const int r = lane & 31, hf = lane >> 5; const unsigned loff = (unsigned)(8 * hf * 64 + r);
#pragma unroll
    for (int gt = 0; gt < 2; ++gt) { const float* w = p.in[gt ? 7 : 5] + (size_t)h * 4096;
#pragma unroll
        for (int nn = 0; nn < 2; ++nn)
#pragma unroll
            for (int s = 0; s < 4; ++s) { float v[8];
#pragma unroll
                for (int j = 0; j < 8; ++j) v[j] = (w + (16 * s + j) * 64 + 32 * nn)[loff];
                u32x4 pk; pk.x = pk2(v[0], v[1]); pk.y = pk2(v[2], v[3]); pk.z = pk2(v[4], v[5]); pk.w = pk2(v[6], v[7]);
                W.f[gt][nn][s] = __builtin_bit_cast(bf16x8, pk); } }
}
template <int PASS>
__device__ __forceinline__ void rglru_item(const Params& p, int item, const RgW& W, LAS unsigned char* xcl, int lane) {
    const bf16* proj = (const bf16*)(p.ws + WS_PROJ);
    float* sumA = (float*)(p.ws + WS_SUMA); float* sumH = (float*)(p.ws + WS_SUMH);
    const int c = item % NCH, h = (item / NCH) % 16, b = item / (NCH * 16);
    const int r = lane & 31, hf = lane >> 5;
    const int chn = h * 64 + lane;
    const float cw0 = p.in[3][chn], cw1 = p.in[3][1024 + chn], cw2 = p.in[3][2048 + chn], cw3 = p.in[3][3072 + chn], cb = p.in[4][chn];
    float ba[2], bi[2], sp8[2], C[2], PT[2];
#pragma unroll
    for (int nn = 0; nn < 2; ++nn) { const int ch = h * 64 + 32 * nn + r; ba[nn] = p.in[6][ch]; bi[nn] = p.in[8][ch]; sp8[nn] = 8.0f * log1pf(expf(-p.in[9][ch])); C[nn] = 0.f; PT[nn] = 1.f; }
    if (PASS == 2) {
        for (int k = 0; k < c; ++k)
#pragma unroll
            for (int nn = 0; nn < 2; ++nn) { const size_t o = (size_t)(b * NCH + k) * D + h * 64 + 32 * nn + r; C[nn] = sumA[o] * C[nn] + sumH[o]; }
    }
    const int t0 = c * TCH;
    const bf16* xrb = proj + (size_t)(b * SEQ) * DIN + C_XR + h * 64;
    const bf16* grb = proj + (size_t)(b * SEQ) * DIN + C_GR + h * 64;
    LAS unsigned char* XR = xcl + 4608; LAS unsigned char* GR = xcl + 9216; LAS unsigned char* Y8 = XR;
    float xm3 = 0.f, xm2 = 0.f, xm1 = 0.f;
    if (t0 > 0) { xm3 = bf1((xrb + (size_t)(t0 - 3) * DIN)[lane]); xm2 = bf1((xrb + (size_t)(t0 - 2) * DIN)[lane]); xm1 = bf1((xrb + (size_t)(t0 - 1) * DIN)[lane]); }
    const unsigned lrow = (unsigned)(lane >> 3), lch = (unsigned)(lane & 7);
    u32x4 xrq[4], grq[4];
#pragma unroll
    for (int it = 0; it < 4; ++it) { xrq[it] = *(const u32x4*)(xrb + (size_t)(t0 + 8 * it) * DIN + lrow * DIN + lch * 8);
        if (PASS == 2) grq[it] = *(const u32x4*)(grb + (size_t)(t0 + 8 * it) * DIN + lrow * DIN + lch * 8); }
    for (int tile = 0; tile < TCH / 32; ++tile) {
        const int tt0 = t0 + tile * 32;
#pragma unroll
        for (int it = 0; it < 4; ++it) { *(LAS u32x4*)(XR + (8 * it + lrow) * 144 + lch * 16) = xrq[it]; if (PASS == 2) *(LAS u32x4*)(GR + (8 * it + lrow) * 144 + lch * 16) = grq[it]; }
        if (tile + 1 < TCH / 32) {
#pragma unroll
            for (int it = 0; it < 4; ++it) { xrq[it] = *(const u32x4*)(xrb + (size_t)(tt0 + 32 + 8 * it) * DIN + lrow * DIN + lch * 8);
                if (PASS == 2) grq[it] = *(const u32x4*)(grb + (size_t)(tt0 + 32 + 8 * it) * DIN + lrow * DIN + lch * 8); }
        }
        asm volatile("s_waitcnt lgkmcnt(0)" ::: "memory");
#pragma unroll
        for (int j = 0; j < 32; ++j) { const float x = bf1(*(const LAS bf16*)(XR + j * 144 + lane * 2)); const float xc = cb + cw0 * xm3 + cw1 * xm2 + cw2 * xm1 + cw3 * x; xm3 = xm2; xm2 = xm1; xm1 = x;
            *(LAS bf16*)(xcl + j * 144 + lane * 2) = (bf16)f2bf(xc); }
        asm volatile("s_waitcnt lgkmcnt(0)" ::: "memory");
        bf16x8 af[4];
#pragma unroll
        for (int s = 0; s < 4; ++s) af[s] = *(const LAS bf16x8*)(xcl + r * 144 + (16 * s + 8 * hf) * 2);
#pragma unroll
        for (int nn = 0; nn < 2; ++nn) {
            f32x16 ra, ri, xq;
#pragma unroll
            for (int i = 0; i < 16; ++i) { ra[i] = 0.f; ri[i] = 0.f; xq[i] = 0.f; }
#pragma unroll
            for (int s = 0; s < 4; ++s) { ra = __builtin_amdgcn_mfma_f32_32x32x16_bf16(af[s], W.f[0][nn][s], ra, 0, 0, 0); ri = __builtin_amdgcn_mfma_f32_32x32x16_bf16(af[s], W.f[1][nn][s], ri, 0, 0, 0); }
#pragma unroll
            for (int s2 = 0; s2 < 2; ++s2) { const int s = 2 * nn + s2; bf16x8 idf;
#pragma unroll
                for (int j = 0; j < 8; ++j) idf[j] = (16 * s + 8 * hf + j == 32 * nn + r) ? (short)0x3F80 : (short)0;
                xq = __builtin_amdgcn_mfma_f32_32x32x16_bf16(af[s], idf, xq, 0, 0, 0); }
            float av[16], uv[16];
#pragma unroll
            for (int i = 0; i < 16; ++i) {
                const float rg = 1.0f / (1.0f + __expf(-(ra[i] + ba[nn]))), ig = 1.0f / (1.0f + __expf(-(ri[i] + bi[nn])));
                const float la = -sp8[nn] * rg, a = __expf(la), x2 = 2.0f * la;
                const float om = (x2 > -0.06f) ? -x2 * (1.0f + x2 * (0.5f + x2 * (0.16666667f + x2 * 0.041666668f))) : 1.0f - __expf(x2);
                av[i] = a; uv[i] = sqrtf(om) * (ig * xq[i]); }
            float hl[16], pl[16];
#pragma unroll
            for (int q = 0; q < 4; ++q) { hl[4 * q] = uv[4 * q]; pl[4 * q] = av[4 * q];
#pragma unroll
                for (int j = 1; j < 4; ++j) { hl[4 * q + j] = av[4 * q + j] * hl[4 * q + j - 1] + uv[4 * q + j]; pl[4 * q + j] = pl[4 * q + j - 1] * av[4 * q + j]; } }
            float cin[4]; float Cc = C[nn];
#pragma unroll
            for (int s8 = 0; s8 < 8; ++s8) { const int q = s8 >> 1;
                const float cn = pl[4 * q + 3] * Cc + hl[4 * q + 3];
                if ((s8 & 1) == 0) { if (hf == 0) cin[q] = Cc; } else { if (hf == 1) cin[q] = Cc; }
                const unsigned cu = __builtin_bit_cast(unsigned, cn);
                auto sw = __builtin_amdgcn_permlane32_swap(cu, cu, false, false);
                Cc = __builtin_bit_cast(float, (s8 & 1) ? sw[1] : sw[0]); }
            C[nn] = Cc;
            if (PASS == 1) { float pp = pl[3] * pl[7] * pl[11] * pl[15]; const unsigned pu = __builtin_bit_cast(unsigned, pp);
                auto sw = __builtin_amdgcn_permlane32_swap(pu, pu, false, false); PT[nn] *= __builtin_bit_cast(float, sw[0]) * __builtin_bit_cast(float, sw[1]); }
            if (PASS == 2) {
#pragma unroll
                for (int i = 0; i < 16; ++i) { const int tok = (i & 3) + 8 * (i >> 2) + 4 * hf; const float hv = hl[i] + pl[i] * cin[i >> 2];
                    const float gg = bf1(*(const LAS bf16*)(GR + tok * 144 + (32 * nn + r) * 2));
                    const float yv = __builtin_amdgcn_fmed3f(hv * gg * 16.0f, -448.f, 448.f);
                    *(LAS unsigned char*)(Y8 + tok * 80 + 32 * nn + r) = (unsigned char)__builtin_amdgcn_cvt_pk_fp8_f32(yv, 0.f, 0, false); }
            }
        }
        if (PASS == 2) {
            asm volatile("s_waitcnt lgkmcnt(0)" ::: "memory");
            unsigned char* yb = p.ws + WS_YRNN + (size_t)(b * SEQ + tt0) * D + h * 64;
#pragma unroll
            for (int it = 0; it < 2; ++it) { const int row = (lane >> 2) + 16 * it; *(u32x4*)(yb + (size_t)row * D + (lane & 3) * 16) = *(const LAS u32x4*)(Y8 + row * 80 + (lane & 3) * 16); }
        }
        asm volatile("s_waitcnt lgkmcnt(0)" ::: "memory");
    }
    if (PASS == 1 && hf == 0) {
#pragma unroll
        for (int nn = 0; nn < 2; ++nn) { const size_t o = (size_t)(b * NCH + c) * D + h * 64 + 32 * nn + r; sumA[o] = PT[nn]; sumH[o] = C[nn]; }
    }
}

__device__ __forceinline__ void attn_item(const Params& p, int item, LAS unsigned char* vt, const LAS float* btab_all, int lane) {
    const bf16* proj = (const bf16*)(p.ws + WS_PROJ);
    const int rq = item & 127, bh = item >> 7, head = bh % 24, b = bh / 24;
    const int g = head >> 3, hh = head & 7, dil = (g == 0) ? 1 : (g == 1 ? 4 : 16), nqb = 128 / dil;
    const int res = rq / nqb, qb = rq % nqb, l0 = qb * 32;
    const int r = lane & 31, hf = lane >> 5;
    const LAS float* btab = btab_all + (g * 8 + hh) * 132;
    const size_t tokbase = (size_t)b * SEQ;
    bf16x8 qf[4];
    { const bf16* qp = proj + (tokbase + (size_t)(l0 + r) * dil + res) * DIN + C_Q + head * 64 + 8 * hf;
#pragma unroll
      for (int s = 0; s < 4; ++s) qf[s] = *(const bf16x8*)(qp + 16 * s); }
    f32x16 o0, o1;
#pragma unroll
    for (int i = 0; i < 16; ++i) { o0[i] = 0.f; o1[i] = 0.f; }
    float mrun = -1e30f, lrun = 0.f;
    const bf16* kvb = proj + (tokbase + res) * DIN + head * 64;
    const unsigned lk = (unsigned)(r * dil * DIN + C_K + 8 * hf);
    const unsigned lv0 = (unsigned)((2 * (lane >> 3)) * dil * DIN + C_V + 8 * (lane & 7));
    const int kt_first = (l0 >= 128) ? 0 : (128 - l0) / 32;
    bf16x8 kf[4], kfn[4]; u32x4 va[2][2], van[2][2];
    { const bf16* tb = kvb + (size_t)(l0 - 128 + 32 * kt_first) * dil * DIN;
#pragma unroll
      for (int s = 0; s < 4; ++s) kfn[s] = *(const bf16x8*)(tb + lk + 16 * s);
#pragma unroll
      for (int it = 0; it < 2; ++it)
#pragma unroll
          for (int e = 0; e < 2; ++e) van[it][e] = *(const u32x4*)(tb + (size_t)(16 * it + e) * dil * DIN + lv0); }
    for (int kt = kt_first; kt < 5; ++kt) {
        const int k0 = l0 - 128 + 32 * kt;
#pragma unroll
        for (int s = 0; s < 4; ++s) { kf[s] = kfn[s]; asm volatile("" : "+v"(kf[s])); }
#pragma unroll
        for (int it = 0; it < 2; ++it)
#pragma unroll
            for (int e = 0; e < 2; ++e) { va[it][e] = van[it][e]; asm volatile("" : "+v"(va[it][e])); }
        if (kt < 4) { const bf16* tb = kvb + (size_t)(k0 + 32) * dil * DIN;
#pragma unroll
            for (int s = 0; s < 4; ++s) kfn[s] = *(const bf16x8*)(tb + lk + 16 * s);
#pragma unroll
            for (int it = 0; it < 2; ++it)
#pragma unroll
                for (int e = 0; e < 2; ++e) van[it][e] = *(const u32x4*)(tb + (size_t)(16 * it + e) * dil * DIN + lv0); }
        f32x16 st;
#pragma unroll
        for (int i = 0; i < 16; ++i) st[i] = 0.f;
#pragma unroll
        for (int s = 0; s < 4; ++s) st = __builtin_amdgcn_mfma_f32_32x32x16_bf16(kf[s], qf[s], st, 0, 0, 0);
#pragma unroll
        for (int it = 0; it < 2; ++it) { const int kp2 = (lane >> 3) + 8 * it, dc = lane & 7;
#pragma unroll
            for (int w = 0; w < 4; ++w) { const unsigned a0 = va[it][0][w], a1 = va[it][1][w];
                *(LAS unsigned*)(vt + (8 * dc + 2 * w) * 72 + 4 * kp2) = (a0 & 0xffffu) | (a1 << 16);
                *(LAS unsigned*)(vt + (8 * dc + 2 * w + 1) * 72 + 4 * kp2) = (a0 >> 16) | (a1 & 0xffff0000u); } }
        float sv[16]; float mt = -1e30f;
        const int relb = (l0 + r) - k0 - 4 * hf;
        float bsv[16];
#pragma unroll
        for (int i = 0; i < 16; ++i) bsv[i] = btab[relb - ((i & 3) + 8 * (i >> 2))];
#pragma unroll
        for (int i = 0; i < 16; ++i) { const int rel = relb - ((i & 3) + 8 * (i >> 2));
            const bool ok = (unsigned)rel <= 128u;
            sv[i] = ok ? st[i] + bsv[i] : -1e30f; mt = fmaxf(mt, sv[i]); }
        mt = fmaxf(mt, __shfl_xor(mt, 32));
        const float mnew = fmaxf(mrun, mt), al = __expf(mrun - mnew);
        float ps = 0.f; float pv[16];
#pragma unroll
        for (int i = 0; i < 16; ++i) { pv[i] = __expf(sv[i] - mnew); ps += pv[i]; }
        lrun = lrun * al + ps; mrun = mnew;
#pragma unroll
        for (int i = 0; i < 16; ++i) { o0[i] *= al; o1[i] *= al; }
        bf16x8 pf[2];
#pragma unroll
        for (int s = 0; s < 2; ++s) { u32x4 w; w.x = pg8::cvt_pk_bf16(pv[8 * s], pv[8 * s + 1]); w.y = pg8::cvt_pk_bf16(pv[8 * s + 2], pv[8 * s + 3]); w.z = pg8::cvt_pk_bf16(pv[8 * s + 4], pv[8 * s + 5]); w.w = pg8::cvt_pk_bf16(pv[8 * s + 6], pv[8 * s + 7]);
            pf[s] = __builtin_bit_cast(bf16x8, w); }
        asm volatile("s_waitcnt lgkmcnt(0)" ::: "memory");
#pragma unroll
        for (int s = 0; s < 2; ++s) {
            { const LAS unsigned char* q = vt + (r) * 72 + (16 * s + 4 * hf) * 2; u32x4 w; const u32x2 lo = *(const LAS u32x2*)q, hi = *(const LAS u32x2*)(q + 16); w.x = lo.x; w.y = lo.y; w.z = hi.x; w.w = hi.y;
              o0 = __builtin_amdgcn_mfma_f32_32x32x16_bf16(__builtin_bit_cast(bf16x8, w), pf[s], o0, 0, 0, 0); }
            { const LAS unsigned char* q = vt + (32 + r) * 72 + (16 * s + 4 * hf) * 2; u32x4 w; const u32x2 lo = *(const LAS u32x2*)q, hi = *(const LAS u32x2*)(q + 16); w.x = lo.x; w.y = lo.y; w.z = hi.x; w.w = hi.y;
              o1 = __builtin_amdgcn_mfma_f32_32x32x16_bf16(__builtin_bit_cast(bf16x8, w), pf[s], o1, 0, 0, 0); }
        }
        asm volatile("s_waitcnt lgkmcnt(0)" ::: "memory");
    }
    const float ltot = lrun + __shfl_xor(lrun, 32), inv = 1.0f / ltot;
    const size_t tok = tokbase + (size_t)(l0 + r) * dil + res;
    bf16* ao = (bf16*)(p.ws + WS_AO) + ((size_t)g * T + tok) * 512 + hh * 64;
#pragma unroll
    for (int q4 = 0; q4 < 4; ++q4) {
        u32x2 w; w.x = pk2(o0[4 * q4] * inv, o0[4 * q4 + 1] * inv); w.y = pk2(o0[4 * q4 + 2] * inv, o0[4 * q4 + 3] * inv);
        *(u32x2*)(ao + 8 * q4 + 4 * hf) = w;
        u32x2 w1; w1.x = pk2(o1[4 * q4] * inv, o1[4 * q4 + 1] * inv); w1.y = pk2(o1[4 * q4 + 2] * inv, o1[4 * q4 + 3] * inv);
        *(u32x2*)(ao + 32 + 8 * q4 + 4 * hf) = w1;
    }
    if (hf == 0) ((float*)(p.ws + WS_LSE))[((size_t)g * T + tok) * 8 + hh] = mrun + __logf(ltot);
}

constexpr int AT_KPITCH = 144, AT_VPITCH = 776, AT_VOFF = 12 * 32 * AT_KPITCH;
struct AtItem { int head, b, g, hh, dil, res, l0g, jmin; };
__device__ __forceinline__ AtItem at_decode(int item) {
    AtItem a; const int bh = item >> 4, grp = ((item & 15) + 5 * (bh >> 4) + bh) & 15; a.head = bh % 24; a.b = bh / 24; a.g = a.head >> 3; a.hh = a.head & 7; a.dil = (a.g == 0) ? 1 : (a.g == 1 ? 4 : 16);
    const int nqb = 128 / a.dil, rq0 = grp * 8; a.res = rq0 / nqb; a.l0g = (rq0 % nqb) * 32; a.jmin = (a.l0g >= 128) ? 0 : (128 - a.l0g) / 32; return a;
}
__device__ __forceinline__ void at_load(const Params& p, const AtItem& a, int wave, int lane, u32x4 (&kq)[2][4], u32x4 (&vq)[2][4]) {
    const bf16* kvb = (const bf16*)(p.ws + WS_PROJ) + ((size_t)a.b * SEQ + a.res) * DIN + a.head * 64;
    const unsigned lk = (unsigned)((lane >> 3) * a.dil * DIN + C_K + 8 * (lane & 7));
    const unsigned lv0 = (unsigned)((2 * (lane >> 3)) * a.dil * DIN + C_V + 8 * (lane & 7));
#pragma unroll
    for (int tt = 0; tt < 2; ++tt) { const int j = wave + 8 * tt;
        if (j < 12 && j >= a.jmin) { const bf16* tb = kvb + (size_t)(a.l0g - 128 + 32 * j) * a.dil * DIN;
#pragma unroll
            for (int it = 0; it < 4; ++it) kq[tt][it] = *(const u32x4*)(tb + (size_t)(8 * it) * a.dil * DIN + lk);
#pragma unroll
            for (int it = 0; it < 2; ++it)
#pragma unroll
                for (int e = 0; e < 2; ++e) vq[tt][2 * it + e] = *(const u32x4*)(tb + (size_t)(16 * it + e) * a.dil * DIN + lv0); } }
}
__device__ __forceinline__ void at_write(const AtItem& a, int wave, int lane, LAS unsigned char* Kl, LAS unsigned char* Vl, const u32x4 (&kq)[2][4], const u32x4 (&vq)[2][4]) {
#pragma unroll
    for (int tt = 0; tt < 2; ++tt) { const int j = wave + 8 * tt;
        if (j < 12 && j >= a.jmin) {
#pragma unroll
            for (int it = 0; it < 4; ++it) *(LAS u32x4*)(Kl + (32 * j + 8 * it + (lane >> 3)) * AT_KPITCH + (lane & 7) * 16) = kq[tt][it];
#pragma unroll
            for (int it = 0; it < 2; ++it) { const int kp2 = (lane >> 3) + 8 * it, dc = lane & 7;
#pragma unroll
                for (int w = 0; w < 4; ++w) { const unsigned a0 = vq[tt][2 * it][w], a1 = vq[tt][2 * it + 1][w];
                    *(LAS unsigned*)(Vl + (8 * dc + 2 * w) * AT_VPITCH + (32 * j + 2 * kp2) * 2) = (a0 & 0xffffu) | (a1 << 16);
                    *(LAS unsigned*)(Vl + (8 * dc + 2 * w + 1) * AT_VPITCH + (32 * j + 2 * kp2) * 2) = (a0 >> 16) | (a1 & 0xffff0000u); } } } }
}
__device__ __forceinline__ void attn_block_phase(const Params& p, LAS unsigned char* lds, const LAS float* btab_all, int wave, int lane, int bid, int G, int nitems) {
  const bf16* proj = (const bf16*)(p.ws + WS_PROJ);
  LAS unsigned char* Kl = lds; LAS unsigned char* Vl = lds + AT_VOFF;
  const int r = lane & 31, hf = lane >> 5;
  u32x4 kq[2][4], vq[2][4]; bf16x8 qn[4];
#define AT_LOADQ(a_) do { const bf16* _qp = proj + ((size_t)(a_).b * SEQ + (size_t)((a_).l0g + 32 * wave + r) * (a_).dil + (a_).res) * DIN + C_Q + (a_).head * 64 + 8 * hf; \
        _Pragma("unroll") for (int _s = 0; _s < 4; ++_s) qn[_s] = *(const bf16x8*)(_qp + 16 * _s); } while (0)
  if (bid < nitems) { const AtItem a0 = at_decode(bid); AT_LOADQ(a0); at_load(p, a0, wave, lane, kq, vq); }
  for (int item = bid; item < nitems; item += G) {
    const AtItem a = at_decode(item);
    const int head = a.head, g = a.g, hh = a.hh, dil = a.dil, res = a.res, l0g = a.l0g;
    const LAS float* btab = btab_all + (g * 8 + hh) * 132;
    const size_t tokbase = (size_t)a.b * SEQ;
    at_write(a, wave, lane, Kl, Vl, kq, vq);
    const int l0 = l0g + 32 * wave;
    bf16x8 qf[4];
#pragma unroll
    for (int s = 0; s < 4; ++s) { qf[s] = qn[s]; asm volatile("" : "+v"(qf[s])); }
    if (item + G < nitems) { const AtItem an = at_decode(item + G); AT_LOADQ(an); at_load(p, an, wave, lane, kq, vq); }
    asm volatile("s_waitcnt lgkmcnt(0)" ::: "memory"); __builtin_amdgcn_s_barrier(); asm volatile("" ::: "memory");
    f32x16 o0, o1;
#pragma unroll
    for (int i = 0; i < 16; ++i) { o0[i] = 0.f; o1[i] = 0.f; }
    float mrun = -1e30f, lrun = 0.f;
    const int kt_first = (l0 >= 128) ? 0 : (128 - l0) / 32;
    for (int kt = kt_first; kt < 5; ++kt) {
        const int j = wave + kt, k0 = l0 - 128 + 32 * kt;
        bf16x8 kf[4];
#pragma unroll
        for (int s = 0; s < 4; ++s) kf[s] = *(const LAS bf16x8*)(Kl + (32 * j + r) * AT_KPITCH + (16 * s + 8 * hf) * 2);
        const int relb = (l0 + r) - k0 - 4 * hf;
        float bsv[16];
#pragma unroll
        for (int i = 0; i < 16; ++i) bsv[i] = btab[relb - ((i & 3) + 8 * (i >> 2))];
        f32x16 st;
#pragma unroll
        for (int i = 0; i < 16; ++i) st[i] = 0.f;
#pragma unroll
        for (int s = 0; s < 4; ++s) st = __builtin_amdgcn_mfma_f32_32x32x16_bf16(kf[s], qf[s], st, 0, 0, 0);
        u32x4 vf[2][2];
#pragma unroll
        for (int s = 0; s < 2; ++s)
#pragma unroll
            for (int dt = 0; dt < 2; ++dt) { const LAS unsigned char* q = Vl + (32 * dt + r) * AT_VPITCH + (32 * j + 16 * s + 4 * hf) * 2; const u32x2 lo = *(const LAS u32x2*)q, hi = *(const LAS u32x2*)(q + 16);
                vf[s][dt] = (u32x4){lo.x, lo.y, hi.x, hi.y}; }
        float sv[16]; float mt = -1e30f;
#pragma unroll
        for (int i = 0; i < 16; ++i) { const int rel = relb - ((i & 3) + 8 * (i >> 2)); const bool ok = (unsigned)rel <= 128u; sv[i] = ok ? st[i] + bsv[i] : -1e30f; mt = fmaxf(mt, sv[i]); }
        mt = fmaxf(mt, __shfl_xor(mt, 32));
        const float mnew = fmaxf(mrun, mt), al = __expf(mrun - mnew);
        float ps = 0.f; float pv[16];
#pragma unroll
        for (int i = 0; i < 16; ++i) { pv[i] = __expf(sv[i] - mnew); ps += pv[i]; }
        lrun = lrun * al + ps; mrun = mnew;
#pragma unroll
        for (int i = 0; i < 16; ++i) { o0[i] *= al; o1[i] *= al; }
#pragma unroll
        for (int s = 0; s < 2; ++s) { u32x4 w; w.x = pg8::cvt_pk_bf16(pv[8 * s], pv[8 * s + 1]); w.y = pg8::cvt_pk_bf16(pv[8 * s + 2], pv[8 * s + 3]); w.z = pg8::cvt_pk_bf16(pv[8 * s + 4], pv[8 * s + 5]); w.w = pg8::cvt_pk_bf16(pv[8 * s + 6], pv[8 * s + 7]);
            const bf16x8 pf = __builtin_bit_cast(bf16x8, w);
            o0 = __builtin_amdgcn_mfma_f32_32x32x16_bf16(__builtin_bit_cast(bf16x8, vf[s][0]), pf, o0, 0, 0, 0);
            o1 = __builtin_amdgcn_mfma_f32_32x32x16_bf16(__builtin_bit_cast(bf16x8, vf[s][1]), pf, o1, 0, 0, 0); }
    }
    const float ltot = lrun + __shfl_xor(lrun, 32), inv = 1.0f / ltot;
    const size_t tok = tokbase + (size_t)(l0 + r) * dil + res;
    bf16* ao = (bf16*)(p.ws + WS_AO) + ((size_t)g * T + tok) * 512 + hh * 64;
#pragma unroll
    for (int q4 = 0; q4 < 4; ++q4) {
        u32x2 w; w.x = pk2(o0[4 * q4] * inv, o0[4 * q4 + 1] * inv); w.y = pk2(o0[4 * q4 + 2] * inv, o0[4 * q4 + 3] * inv);
        *(u32x2*)(ao + 8 * q4 + 4 * hf) = w;
        u32x2 w1; w1.x = pk2(o1[4 * q4] * inv, o1[4 * q4 + 1] * inv); w1.y = pk2(o1[4 * q4 + 2] * inv, o1[4 * q4 + 3] * inv);
        *(u32x2*)(ao + 32 + 8 * q4 + 4 * hf) = w1;
    }
    if (hf == 0) ((float*)(p.ws + WS_LSE))[((size_t)g * T + tok) * 8 + hh] = mrun + __logf(ltot);
    asm volatile("s_waitcnt lgkmcnt(0)" ::: "memory"); __builtin_amdgcn_s_barrier(); asm volatile("" ::: "memory");
  }
}

__device__ __forceinline__ void build_tile_table(const LAS unsigned* lcnt, LAS unsigned char* lds, int tid) {
    LAS int* tbase = (LAS int*)(lds + L_TBASE); LAS unsigned short* tile_e = (LAS unsigned short*)(lds + L_TILEE);
    __syncthreads();
    if (tid < 64) { int n[4], s = 0;
#pragma unroll
        for (int j = 0; j < 4; ++j) { n[j] = ((int)lcnt[4 * tid + j] + 255) >> 8; s += n[j]; }
        int incl = s;
#pragma unroll
        for (int o = 1; o < 64; o <<= 1) { const int v = __shfl_up(incl, o); if (tid >= o) incl += v; }
        int ex = incl - s;
#pragma unroll
        for (int j = 0; j < 4; ++j) { tbase[4 * tid + j] = ex; ex += n[j]; }
        if (tid == 63) { tbase[NE] = incl; tbase[NE + 1] = incl + SH_TILES; } }
    __syncthreads();
    if (tid < NE) { const int a = tbase[tid], bnd = tbase[tid + 1]; for (int i = a; i < bnd; ++i) tile_e[i] = (unsigned short)tid; }
    if (tid < SH_TILES) tile_e[tbase[NE] + tid] = (unsigned short)NE;
    __syncthreads();
}
__device__ __forceinline__ void build_tile_table_g(const Params& p, LAS unsigned char* lds, int tid) {
    LAS unsigned* lc = (LAS unsigned*)(lds + L_LCNT);
    const unsigned* cnt = (const unsigned*)(p.ws + WS_CTL) + CW_CNT;
    if (tid < NE) lc[tid] = cnt[tid];
    build_tile_table(lc, lds, tid);
}

__global__ void __launch_bounds__(512, 2) fwd_kernel(Params p) {
    extern __shared__ __attribute__((aligned(16))) unsigned char lds_raw[];
    LAS unsigned char* lds = (LAS unsigned char*)lds_raw;
    const int tid = threadIdx.x, lane = tid & 63, wave = __builtin_amdgcn_readfirstlane(tid >> 6);
    const int G = gridDim.x, bid = blockIdx.x;
    const int gw = bid * 8 + wave, NGW = G * 8;
    const size_t gtid = (size_t)bid * 512 + tid, NTH = (size_t)G * 512;
    unsigned char* ws = p.ws;
    volatile LAS unsigned* misc = (volatile LAS unsigned*)(lds + L_MISC);
    if (tid < 16) misc[tid] = 0u;
    { LAS float* bt = (LAS float*)(lds + L_BTAB);
      for (int i = tid; i < 3 * 8 * 132; i += 512) { const int g = i / (8 * 132), hh = (i / 132) % 8, rel = i % 132; bt[i] = (rel <= 128) ? p.in[12][(int)p.bucket[g][rel] * 24 + g * 8 + hh] : 0.f; } }
    __syncthreads();
#if N_LAUNCHES == 1
    XcdBarrier bar = xcd_barrier_post((unsigned*)(ws + WS_CTL) + CW_BAR, misc, tid == 0);
#define GRID_BAR() xcd_barrier(bar, wave == 0 && lane_id() == 0)
#else
#define GRID_BAR() do { } while (0)
#endif
    const int lo = p.lo, hi = p.hi;
#define IN(k) (lo <= (k) && (k) < hi)
#define SEAM(k) do { if (IN(k) && IN((k) + 1)) GRID_BAR(); STAMP((k) + 1); } while (0)
#define STAMP(k) do { if (PROBE_PHASE >= 100 && wave == 0 && lane_id() == 0) { volatile LAS unsigned* _st = (volatile LAS unsigned*)(lds + L_STAMP); _st[(k)] = (unsigned)__builtin_amdgcn_s_memrealtime(); \
        if (PROBE_PHASE >= 300 && (PROBE_PHASE - 300) / 2 == (k)) { _st[16] = 0u; _st[17] = 0u; }                   \
        if (PROBE_PHASE >= 300 && (PROBE_PHASE - 300) / 2 + 1 == (k)) { _st[18] = _st[16]; _st[19] = _st[17]; } } } while (0)
#ifndef PROBE_PHASE
#define PROBE_PHASE -1
#endif
#define REPS(k) for (int _rep = 0; _rep < ((PROBE_PHASE == (k)) ? 2 : 1); ++_rep)
#define REP_BAR() do { if (_rep) GRID_BAR(); } while (0)
#define PHASE_LOCALS const int lane = lane_id(), tid = wave * 64 + lane; const size_t gtid = (size_t)bid * 512 + tid; (void)lane; (void)gtid;

    if (PROBE_PHASE >= 300 && wave == 0 && lane_id() == 0) { ((volatile LAS unsigned*)(lds + L_STAMP))[16] = 0u; ((volatile LAS unsigned*)(lds + L_STAMP))[17] = 0u; }
    STAMP(0);
    if (IN(0)) REPS(0) { REP_BAR(); PHASE_LOCALS
        LAS float* tile = (LAS float*)lds;
        for (int it = bid; it < 720; it += G) {
            int r = it;
            if (r < 544) { tr_matrix_item_fp8(p.in[1], 1024, DIN, ws + WS_WINT, 32.f, r, tile, tid); continue; } r -= 544;
            if (r < 64) { tr_matrix_item_fp8(p.in[10], 1024, 1024, ws + WS_WPRT, 32.f, r, tile, tid); continue; } r -= 64;
            if (r < 32) { tr_matrix_item_fp8(p.in[11], 512, 1024, ws + WS_WPAT, 32.f, r, tile, tid); continue; } r -= 32;
            if (r < 64) { tr_matrix_item_fp8(p.in[13], 1024, 1024, ws + WS_WOT, 32.f, r, tile, tid); continue; } r -= 64;
            tr_matrix_item(p.in[16], 1024, 256, (bf16*)(ws + WS_WRT), r, tile, tid);
        }
        const f32x4* x4 = (const f32x4*)p.in[0]; u32x4* xb = (u32x4*)(ws + WS_XB);
        for (size_t i = gtid; i < (size_t)T * D / 16; i += NTH) { const f32x4 a = x4[4 * i], b = x4[4 * i + 1], c = x4[4 * i + 2], d = x4[4 * i + 3];
            u32x4 o; o.x = pk_fp8x4(a[0], a[1], a[2], a[3]); o.y = pk_fp8x4(b[0], b[1], b[2], b[3]); o.z = pk_fp8x4(c[0], c[1], c[2], c[3]); o.w = pk_fp8x4(d[0], d[1], d[2], d[3]); xb[i] = o; }
    }
    SEAM(0);
    if (IN(1)) REPS(1) { REP_BAR(); PHASE_LOCALS
        pg8::Gemm g{(const bf16*)(ws + WS_XB), (const bf16*)(ws + WS_WINT), 512, 0x7A7A7A7A, 0x7F7F7F7F}; pg8::StaticOrder S; S.init(T, DIN, G, bid);
        pg8::EpiInProj E{(bf16*)(ws + WS_PROJ), p.in[2], 1.0f / 32.0f};
        pg8::gemm_phase<pg8::EpiInProj, pg8::StaticOrder, true, true>(lds, g, S, E, wave);
    }
    SEAM(1);
    if (IN(2)) REPS(2) { REP_BAR(); PHASE_LOCALS
        LAS unsigned char* vt = lds + wave * 14336;
        for (int rr = 0; rr < (PROBE_PHASE == 20 ? 2 : 1); ++rr)
        { RgW W; int hprev = -1;
          for (int it = gw; it < NB * 16 * NCH; it += NGW) { const int h = (it / NCH) % 16; if (h != hprev) { rglru_load_w(p, h, lane, W); hprev = h; } rglru_item<1>(p, it, W, vt, lane); } }
        const LAS float* bt = (const LAS float*)(lds + L_BTAB);
        if (PROBE_PHASE >= 400 && wave == 0 && lane_id() == 0) ((volatile LAS unsigned*)(lds + L_STAMP))[20] = (unsigned)__builtin_amdgcn_s_memrealtime();
        __syncthreads();
        for (int rr = 0; rr < (PROBE_PHASE == 21 ? 2 : 1); ++rr)
        attn_block_phase(p, lds, bt, wave, lane, bid, G, NB * 24 * 16);
        if (PROBE_PHASE >= 400 && wave == 0 && lane_id() == 0) ((volatile LAS unsigned*)(lds + L_STAMP))[21] = (unsigned)__builtin_amdgcn_s_memrealtime();
    }
    SEAM(2);
    if (IN(3)) REPS(3) { REP_BAR(); PHASE_LOCALS
        for (int rr = 0; rr < (PROBE_PHASE == 30 ? 2 : 1); ++rr)
        { RgW W; int hprev = -1; LAS unsigned char* xcl = lds + wave * 14336;
          for (int it = gw; it < NB * 16 * NCH; it += NGW) { const int h = (it / NCH) % 16; if (h != hprev) { rglru_load_w(p, h, lane, W); hprev = h; } rglru_item<2>(p, it, W, xcl, lane); } }
        const bf16* ao = (const bf16*)(ws + WS_AO); const float* lse = (const float*)(ws + WS_LSE); bf16* yatt = (bf16*)(ws + WS_YATT);
        for (int rr = 0; rr < (PROBE_PHASE == 31 ? 2 : 1); ++rr)
        for (size_t i = gtid; i < (size_t)T * 64; i += NTH) { const size_t t = i >> 6; const int c8 = (int)(i & 63), hh = c8 >> 3;
            const float l0 = lse[t * 8 + hh], l1 = lse[((size_t)T + t) * 8 + hh], l2 = lse[((size_t)2 * T + t) * 8 + hh];
            const float mx = fmaxf(l0, fmaxf(l1, l2)); float w0 = __expf(l0 - mx), w1 = __expf(l1 - mx), w2 = __expf(l2 - mx); const float inv = 1.0f / (w0 + w1 + w2); w0 *= inv; w1 *= inv; w2 *= inv;
            const u32x4 a = *(const u32x4*)(ao + t * 512 + c8 * 8), bq = *(const u32x4*)(ao + ((size_t)T + t) * 512 + c8 * 8), cq = *(const u32x4*)(ao + ((size_t)2 * T + t) * 512 + c8 * 8);
            float yv[8];
#pragma unroll
            for (int w = 0; w < 4; ++w) { yv[2 * w] = 16.0f * (w0 * bflo(a[w]) + w1 * bflo(bq[w]) + w2 * bflo(cq[w])); yv[2 * w + 1] = 16.0f * (w0 * bfhi(a[w]) + w1 * bfhi(bq[w]) + w2 * bfhi(cq[w])); }
            u32x2 o; o.x = pk_fp8x4(yv[0], yv[1], yv[2], yv[3]); o.y = pk_fp8x4(yv[4], yv[5], yv[6], yv[7]);
            *(u32x2*)((unsigned char*)yatt + t * 512 + c8 * 8) = o; }
    }
    SEAM(3);
    if (IN(4)) REPS(4) { REP_BAR(); PHASE_LOCALS
        pg8::StaticOrder S; S.init(T, D, G, bid);
        { pg8::Gemm g{(const bf16*)(ws + WS_YRNN), (const bf16*)(ws + WS_WPRT), 512, 0, 0};
          pg8::EpiProjRnn E{(const bf16*)(ws + WS_PROJ), p.out, 1.0f / 512.0f};
          pg8::gemm_phase<pg8::EpiProjRnn, pg8::StaticOrder, true, true>(lds, g, S, E, wave); }
        asm volatile("s_waitcnt vmcnt(0)" ::: "memory"); __syncthreads();
        { pg8::Gemm g{(const bf16*)(ws + WS_YATT), (const bf16*)(ws + WS_WPAT), 256, 0, 0};
          pg8::EpiProjAtt E{(const bf16*)(ws + WS_PROJ), p.out, ws + WS_MERGED, 1.0f / 512.0f};
          pg8::gemm_phase<pg8::EpiProjAtt, pg8::StaticOrder, true, true>(lds, g, S, E, wave); }
    }
    SEAM(4);
    if (IN(5)) REPS(5) { REP_BAR(); PHASE_LOCALS
        pg8::Gemm g{(const bf16*)(ws + WS_MERGED), (const bf16*)(ws + WS_WOT), 512, 0, 0}; pg8::StaticOrder S; S.init(T, D, G, bid);
        pg8::EpiBf16Res E{p.in[0], (bf16*)(ws + WS_PRELN), ALPHA, 1.0f / 512.0f};
        pg8::gemm_phase<pg8::EpiBf16Res, pg8::StaticOrder, true, true>(lds, g, S, E, wave);
    }
    SEAM(5);
    if (IN(6)) REPS(6) { REP_BAR(); PHASE_LOCALS
        const bf16* preln = (const bf16*)(ws + WS_PRELN); bf16* x1b = (bf16*)(ws + WS_X1B);
        for (int row = gw; row < T; row += NGW) {
            const u32x4 pa = *(const u32x4*)(preln + (size_t)row * D + 8 * lane), pb = *(const u32x4*)(preln + (size_t)row * D + 512 + 8 * lane);
            float v[16]; float s = 0.f;
#pragma unroll
            for (int w = 0; w < 4; ++w) { v[2 * w] = bflo(pa[w]); v[2 * w + 1] = bfhi(pa[w]); v[8 + 2 * w] = bflo(pb[w]); v[8 + 2 * w + 1] = bfhi(pb[w]); }
#pragma unroll
            for (int j = 0; j < 16; ++j) s += v[j];
            const float mean = wave_sum(s) * (1.f / D); float s2 = 0.f;
#pragma unroll
            for (int j = 0; j < 16; ++j) { v[j] -= mean; s2 += v[j] * v[j]; }
            const float rstd = 1.f / sqrtf(wave_sum(s2) * (1.f / D) + LN_EPS);
#pragma unroll
            for (int hlf = 0; hlf < 2; ++hlf) { const int c0 = hlf * 512 + 8 * lane;
                const f32x4 g0 = *(const f32x4*)(p.in[14] + c0), g1 = *(const f32x4*)(p.in[14] + c0 + 4), b0 = *(const f32x4*)(p.in[15] + c0), b1 = *(const f32x4*)(p.in[15] + c0 + 4);
                float o[8];
#pragma unroll
                for (int j = 0; j < 4; ++j) { o[j] = v[8 * hlf + j] * rstd * g0[j] + b0[j]; o[4 + j] = v[8 * hlf + 4 + j] * rstd * g1[j] + b1[j]; }
                u32x4 w; w.x = pk2(o[0], o[1]); w.y = pk2(o[2], o[3]); w.z = pk2(o[4], o[5]); w.w = pk2(o[6], o[7]);
                *(u32x4*)(x1b + (size_t)row * D + c0) = w;
                u32x2 w8; w8.x = pk_fp8x4(o[0], o[1], o[2], o[3]); w8.y = pk_fp8x4(o[4], o[5], o[6], o[7]);
                *(u32x2*)(ws + WS_X1B8 + (size_t)row * D + c0) = w8; }
        }
        __syncthreads();
        LAS float* tile = (LAS float*)lds;
        for (int it = bid; it < 257 * 48; it += G) {
            const int e = it / 48, r = it % 48;
            if (r < 32) { const int up = r >> 4, q = r & 15, kb = q >> 1, nbk = q & 1;
                const float* W = (e < NE) ? p.in[up ? 19 : 18] + (size_t)e * 1024 * 256 : p.in[up ? 22 : 21];
                tr128_fp8(W + (size_t)kb * 128 * 256 + nbk * 128, 256, ws + WS_WGU + ((size_t)e * 512 + nbk * 256 + up * 128) * 1024 + kb * 128, 1024, 32.f, tile, tid);
            } else { const int q = r - 32, kb = q >> 3, nb = q & 7;
                const float* W = (e < NE) ? p.in[20] + (size_t)e * 256 * 1024 : p.in[23];
                tr128_fp8(W + (size_t)kb * 128 * 1024 + nb * 128, 1024, ws + WS_WD + ((size_t)e * 1024 + nb * 128) * 256 + kb * 128, 256, 32.f, tile, tid); }
        }
    }
    SEAM(6);
    if (IN(7)) REPS(7) { REP_BAR(); PHASE_LOCALS
        pg8::Gemm g{(const bf16*)(ws + WS_X1B), (const bf16*)(ws + WS_WRT), 1024, 0x7F7F7F7F, 0x7F7F7F7F}; pg8::StaticOrder S; S.init(T, NE, G, bid);
        pg8::EpiF32Res E{nullptr, (float*)(ws + WS_LOGITS), NE, 0.f, 1.0f};
        pg8::gemm_phase<pg8::EpiF32Res, pg8::StaticOrder, true>(lds, g, S, E, wave);
      { pg8::Unit ru; const bool has_unit = S.next(0, ru); const int tok0 = has_unit ? ru.pm * 256 : 0;
        const float* logits = (const float*)(ws + WS_LOGITS); LAS unsigned* lcnt = (LAS unsigned*)(lds + L_LCNT);
        __syncthreads(); if (tid < NE) lcnt[tid] = 0u; __syncthreads();
        int* eidx = (int*)(ws + WS_EIDX); float* gatew = (float*)(ws + WS_GATEW); int* rank = (int*)(ws + WS_RANK);
        const int g = lane & 7, tk = lane >> 3;
        float rb[32];
#pragma unroll
        for (int q = 0; q < 8; ++q) { const f32x4 r4 = ((const f32x4*)p.in[17])[g * 8 + q]; rb[4 * q] = r4[0]; rb[4 * q + 1] = r4[1]; rb[4 * q + 2] = r4[2]; rb[4 * q + 3] = r4[3]; }
        for (int task = wave; task < (has_unit ? 32 : 0); task += 8) {
            const int t = tok0 + task * 8 + tk;
            const f32x4* z4 = (const f32x4*)(logits + (size_t)t * NE + g * 32);
            f32x4 zz[8];
#pragma unroll
            for (int q = 0; q < 8; ++q) zz[q] = z4[q];
            float sc[32], sel[32];
#pragma unroll
            for (int j = 0; j < 32; ++j) { sc[j] = 1.0f / (1.0f + __expf(-zz[j >> 2][j & 3])); sel[j] = sc[j] + rb[j]; }
            float m1 = fmaxf(sel[0], sel[1]), m2 = fminf(sel[0], sel[1]);
#pragma unroll
            for (int j = 2; j < 32; ++j) { const float v = sel[j]; m2 = fmaxf(m2, fminf(m1, v)); m1 = fmaxf(m1, v); }
            const float gs = m1 + m2; int rk = 0;
#pragma unroll
            for (int g3 = 0; g3 < 8; ++g3) { const float og = __shfl(gs, (lane & ~7) + g3); rk += (og > gs || (og == gs && g3 < g)) ? 1 : 0; }
            if (rk >= 4) {
#pragma unroll
                for (int j = 0; j < 32; ++j) sel[j] = -INFINITY;
            }
            int me = 0; float ms = 0.f, gsum = 0.f;
#pragma unroll
            for (int k = 0; k < 8; ++k) {
                float bv = sel[0], bs = sc[0]; int bj = 0;
#pragma unroll
                for (int j = 1; j < 32; ++j) { const bool gt = sel[j] > bv; bv = gt ? sel[j] : bv; bs = gt ? sc[j] : bs; bj = gt ? j : bj; }
                int bi = g * 32 + bj;
#pragma unroll
                for (int o = 1; o < 8; o <<= 1) { const float ov = __shfl_xor(bv, o), os = __shfl_xor(bs, o); const int oi = __shfl_xor(bi, o);
                    const bool tk2 = (ov > bv) || (ov == bv && oi < bi); bv = tk2 ? ov : bv; bs = tk2 ? os : bs; bi = tk2 ? oi : bi; }
                const bool own = (bi >> 5) == g; const int jj = bi & 31;
#pragma unroll
                for (int j = 0; j < 32; ++j) sel[j] = (own && j == jj) ? -INFINITY : sel[j];
                gsum += bs; if (g == k) { me = bi; ms = bs; }
            }
            const int rr = (int)__hip_atomic_fetch_add(&lcnt[me], 1u, __ATOMIC_RELAXED, __HIP_MEMORY_SCOPE_WORKGROUP);
            const size_t q = (size_t)t * 8 + g;
            eidx[q] = me; gatew[q] = ms * 2.5f / gsum; rank[q] = rr;
        }
        __syncthreads();
        if (tid < NE) ((unsigned*)(ws + WS_HIST))[(size_t)bid * NE + tid] = lcnt[tid];
      }
    }
    SEAM(7);
    if (IN(9)) REPS(9) { REP_BAR(); PHASE_LOCALS
        LAS unsigned* lcnt = (LAS unsigned*)(lds + L_LCNT); LAS unsigned* bbase = (LAS unsigned*)(lds + L_BBASE);
        __syncthreads();
        { const u32x4* hist4 = (const u32x4*)(ws + WS_HIST); const int e4 = tid & 63, part = tid >> 6; u32x4 tot = (u32x4){0u, 0u, 0u, 0u}, bs = tot;
          const int per = (G + 7) / 8, b0 = part * per, b1 = (b0 + per < G) ? b0 + per : G;
#pragma unroll 8
          for (int b = b0; b < b1; ++b) { const u32x4 v = hist4[(size_t)b * 64 + e4]; tot += v; if (b < bid) bs += v; }
          LAS u32x4* pt = (LAS u32x4*)lds; pt[part * 64 + e4] = tot; pt[512 + part * 64 + e4] = bs; }
        __syncthreads();
        if (tid < NE) { const LAS unsigned* pw = (const LAS unsigned*)lds; unsigned tot = 0u, bs = 0u;
#pragma unroll
            for (int pp = 0; pp < 8; ++pp) { tot += pw[pp * 256 + tid]; bs += pw[2048 + pp * 256 + tid]; }
            lcnt[tid] = tot; bbase[tid] = bs; if (bid == 0) ((unsigned*)(ws + WS_CTL))[CW_CNT + tid] = tot; }
        build_tile_table(lcnt, lds, tid);
        const LAS int* tbase = (const LAS int*)(lds + L_TBASE);
        const int* eidx = (const int*)(ws + WS_EIDX); const float* gatew = (const float*)(ws + WS_GATEW); const int* rank = (const int*)(ws + WS_RANK);
        int* slotof = (int*)(ws + WS_SLOTOF); int* tokslot = (int*)(ws + WS_TOKSLOT); float* wslot = (float*)(ws + WS_WSLOT);
        pg8::StaticOrder RS; RS.init(T, NE, G, bid); pg8::Unit ru; const bool has_unit = RS.next(0, ru);
        for (int task = wave; task < (has_unit ? 32 : 0); task += 8) {
            const int t = ru.pm * 256 + task * 8 + (lane >> 3); const size_t q = (size_t)t * 8 + (lane & 7);
            const int e = eidx[q]; const int slot = tbase[e] * 256 + (int)bbase[e] + rank[q]; tokslot[slot] = t; wslot[slot] = gatew[q]; slotof[q] = slot; }
        for (size_t i = gtid; i < (size_t)NE * 256; i += NTH) { const int e = (int)(i >> 8), j = (int)(i & 255); const int s = (int)lcnt[e] + j; if (s < (tbase[e + 1] - tbase[e]) * 256) { tokslot[tbase[e] * 256 + s] = 0; wslot[tbase[e] * 256 + s] = 0.f; } }
        const int sb = tbase[NE] * 256;
        for (size_t i = gtid; i < (size_t)T; i += NTH) { tokslot[sb + i] = (int)i; }
    }
    SEAM(9);
    if (IN(10)) REPS(10) { REP_BAR(); PHASE_LOCALS
        build_tile_table_g(p, lds, tid);
        const LAS int* tbase = (const LAS int*)(lds + L_TBASE);
        pg8::GroupOrder<true> S; S.nN = 2; S.nwg = tbase[NE + 1] * 2; S.G = G; S.c = bid; S.tile_e = (const LAS unsigned short*)(lds + L_TILEE); S.tok = (const int*)(ws + WS_TOKSLOT); S.rowbytes = 1024u;
        pg8::Gemm g{(const bf16*)(ws + WS_X1B8), (const bf16*)(ws + WS_WGU), 512, 0, 0};
        pg8::EpiGateUp E{(bf16*)(ws + WS_H), 1.0f / 32.0f};
        pg8::gemm_phase<pg8::EpiGateUp, pg8::GroupOrder<true>, true, true>(lds, g, S, E, wave);
    }
    SEAM(10);
    if (IN(11)) REPS(11) { REP_BAR(); PHASE_LOCALS
        build_tile_table_g(p, lds, tid);
        const LAS int* tbase = (const LAS int*)(lds + L_TBASE);
        pg8::GroupOrder<false> S; S.nN = 4; S.nwg = ((PROBE_PHASE == 11 && _rep == 0) ? tbase[NE] : tbase[NE + 1]) * 4; S.G = G; S.c = bid; S.tile_e = (const LAS unsigned short*)(lds + L_TILEE); S.tok = nullptr; S.rowbytes = 0u;
        pg8::Gemm g{(const bf16*)(ws + WS_H), (const bf16*)(ws + WS_WD), 128, 0, 0};
        pg8::EpiDown E{(bf16*)(ws + WS_Y), (const float*)(ws + WS_WSLOT), p.out, tbase[NE], (const bf16*)(ws + WS_X1B), 1.0f / 512.0f};
        pg8::gemm_phase<pg8::EpiDown, pg8::GroupOrder<false>, true, true>(lds, g, S, E, wave);
    }
    SEAM(11);
    if (IN(12)) REPS(12) { REP_BAR(); PHASE_LOCALS
        const bf16* Y = (const bf16*)(ws + WS_Y); const int* slotof = (const int*)(ws + WS_SLOTOF);
        for (int t = gw; t < T; t += NGW) {
            float* orow = p.out + (size_t)t * D; float* wrow = (PROBE_PHASE == 12 && _rep == 0) ? (float*)(ws + WS_H) + (size_t)t * D : orow; float v[16];
            { const f32x4 a = *(const f32x4*)(orow + 8 * lane), b = *(const f32x4*)(orow + 8 * lane + 4), c = *(const f32x4*)(orow + 512 + 8 * lane), d = *(const f32x4*)(orow + 512 + 8 * lane + 4);
#pragma unroll
              for (int j = 0; j < 4; ++j) { v[j] = a[j]; v[4 + j] = b[j]; v[8 + j] = c[j]; v[12 + j] = d[j]; } }
            int sl[8];
#pragma unroll
            for (int k = 0; k < 8; ++k) sl[k] = slotof[(size_t)t * 8 + k];
#pragma unroll
            for (int k = 0; k < 8; ++k) { const unsigned char* yr = (const unsigned char*)Y + (size_t)sl[k] * D; const u32x2 a = *(const u32x2*)(yr + 8 * lane), b = *(const u32x2*)(yr + 512 + 8 * lane);
#pragma unroll
                for (int w = 0; w < 2; ++w) {
                    const f32x2 a0 = __builtin_amdgcn_cvt_pk_f32_fp8((int)a[w], false), a1 = __builtin_amdgcn_cvt_pk_f32_fp8((int)a[w], true), b0 = __builtin_amdgcn_cvt_pk_f32_fp8((int)b[w], false), b1 = __builtin_amdgcn_cvt_pk_f32_fp8((int)b[w], true);
                    v[4 * w] += a0[0] * 0.015625f; v[4 * w + 1] += a0[1] * 0.015625f; v[4 * w + 2] += a1[0] * 0.015625f; v[4 * w + 3] += a1[1] * 0.015625f;
                    v[8 + 4 * w] += b0[0] * 0.015625f; v[8 + 4 * w + 1] += b0[1] * 0.015625f; v[8 + 4 * w + 2] += b1[0] * 0.015625f; v[8 + 4 * w + 3] += b1[1] * 0.015625f; } }
            float s = 0.f;
#pragma unroll
            for (int j = 0; j < 16; ++j) s += v[j];
            const float mean = wave_sum(s) * (1.f / D); float s2 = 0.f;
#pragma unroll
            for (int j = 0; j < 16; ++j) { v[j] -= mean; s2 += v[j] * v[j]; }
            const float rstd = 1.f / sqrtf(wave_sum(s2) * (1.f / D) + LN_EPS);
            const float* gm = p.in[24]; const float* bt = p.in[25];
#pragma unroll
            for (int q = 0; q < 4; ++q) { const int c0 = (q >> 1) * 512 + 8 * lane + (q & 1) * 4; const f32x4 g4 = *(const f32x4*)(gm + c0), b4 = *(const f32x4*)(bt + c0); f32x4 o;
#pragma unroll
                for (int j = 0; j < 4; ++j) o[j] = v[4 * q + j] * rstd * g4[j] + b4[j];
                *(f32x4*)(wrow + c0) = o; }
        }
    }
    STAMP(13);
    if (PROBE_PHASE >= 100 && wave == 0 && lane_id() == 0) {
        volatile LAS unsigned* st = (volatile LAS unsigned*)(lds + L_STAMP);
        const unsigned d = (PROBE_PHASE == 400) ? st[20] - st[2] : (PROBE_PHASE == 401) ? st[21] - st[20] : (PROBE_PHASE == 402) ? st[3] - st[21] : (PROBE_PHASE >= 300) ? st[18 + (PROBE_PHASE & 1)] : (PROBE_PHASE == 200) ? st[13] - st[0] : (PROBE_PHASE == 201) ? st[7] - st[0] : (PROBE_PHASE == 202) ? st[13] - st[7] : st[PROBE_PHASE - 100 + 1] - st[PROBE_PHASE - 100], t0 = (unsigned)__builtin_amdgcn_s_memrealtime();
        while ((unsigned)__builtin_amdgcn_s_memrealtime() - t0 < d) __builtin_amdgcn_s_sleep(8);
    }
#undef IN
#undef SEAM
}

extern "C" void kernel_launch(void* const* d_in, const int* in_sizes, int n_in, void* d_out, int out_size, void* d_ws, size_t ws_size, hipStream_t stream) {
    static int grid = 0;
    if (grid == 0) {
        if (n_in != 26 || in_sizes[0] != T * D || out_size != T * D || ws_size < WS_END) { fprintf(stderr, "kernel_launch: unexpected shapes / workspace (%d inputs, ws %zu < %zu)\n", n_in, ws_size, (size_t)WS_END); grid = -1; return; }
        int dev = 0, cus = 0, per_cu = 0;
        if (hipGetDevice(&dev) != hipSuccess || hipDeviceGetAttribute(&cus, hipDeviceAttributeMultiprocessorCount, dev) != hipSuccess) { grid = -1; return; }
        if (hipFuncSetAttribute((const void*)fwd_kernel, hipFuncAttributeMaxDynamicSharedMemorySize, LDS_BYTES) != hipSuccess) { fprintf(stderr, "kernel_launch: hipFuncSetAttribute failed\n"); grid = -1; return; }
        if (hipOccupancyMaxActiveBlocksPerMultiprocessor(&per_cu, (const void*)fwd_kernel, 512, LDS_BYTES) != hipSuccess || per_cu < 1) { fprintf(stderr, "kernel_launch: occupancy query says %d\n", per_cu); }
        (void)hipGetLastError();
        grid = cus;
    }
    if (grid < 0) return;
    (void)hipMemsetAsync((char*)d_ws + WS_CTL, 0, CTL_BYTES, stream);
    Params p{};
    for (int i = 0; i < 26; ++i) p.in[i] = (const float*)d_in[i];
    p.out = (float*)d_out; p.ws = (unsigned char*)d_ws;
    const int dils[3] = {1, 4, 16};
    for (int g = 0; g < 3; ++g) for (int rel = 0; rel <= 128; ++rel) {
        const long dist = (long)rel * dils[g]; long bk;
        if (dist < 16) bk = dist;
        else { const double dd = (double)(dist < 1 ? 1 : dist); long large = 16 + (long)(std::log(dd / 16.0) / std::log(2048.0 / 16.0) * 16.0); bk = large < 31 ? large : 31; }
        p.bucket[g][rel] = (unsigned char)bk;
    }
#if N_LAUNCHES == 1
    p.lo = 0; p.hi = NPHASE;
    hipLaunchKernelGGL(fwd_kernel, dim3(grid), dim3(512), LDS_BYTES, stream, p);
#else
    for (int k = 0; k < NPHASE; ++k) { p.lo = k; p.hi = k + 1; hipLaunchKernelGGL(fwd_kernel, dim3(grid), dim3(512), LDS_BYTES, stream, p); }
#endif
}
```
